# Optimizing an MI355X kernel written in HIP

```python
import math
import jax, jax.numpy as jnp
from jax import lax
import numpy as np

D_MODEL = 1024
BATCH = 4
SEQ = 8192
DEPTH = 2

N_MEM = 256
D_HYENA = 256
RW_HEADS = 6
RW_HEAD_DIM = 64
D_RWKV = RW_HEADS * RW_HEAD_DIM
GDN_HEADS = 6
GDN_HEAD_DIM = 64
D_GDN = GDN_HEADS * GDN_HEAD_DIM
D_MIX = D_HYENA + D_RWKV + D_GDN
HY_SHORT = 3
HY_BANDS = 16
HY_EMB = 1 + 2 * HY_BANDS
HY_FFN = 64
HY_FAST_DECAY = 0.3
HY_SLOW_DECAY = 1.5
HY_TARGET = 1e-2
RW_LORA_W = 64
RW_LORA_A = 64
RW_LORA_G = 128
RW_DECAY_SCALE = 0.606531
RW_GN_EPS = 64e-5
GDN_SHORT = 3
GDN_CHUNK = 64
XA_HEADS = 4
XA_HEAD_DIM = D_MODEL // XA_HEADS
D_FF = 2816
NORM_EPS = 1e-6
HY_COLS = 3 * D_HYENA
RW_COLS = 3 * D_RWKV + 2 * RW_LORA_W + 2 * RW_LORA_A + RW_LORA_G
GDN_COLS = 4 * D_GDN + 4 * GDN_HEADS
IN_COLS = HY_COLS + RW_COLS + GDN_COLS

kernel_name = "hybrid_hyena_rwkv7_gdn_encoder"


def _split(t, sizes):
    return jnp.split(t, np.cumsum(sizes)[:-1].tolist(), axis=-1)


def rmsnorm(x, g, eps=NORM_EPS):
    xf = x.astype(jnp.float32)
    y = xf * lax.rsqrt(jnp.mean(xf * xf, axis=-1, keepdims=True) + eps)
    return (y * g.astype(jnp.float32)).astype(x.dtype)


def l2norm_heads(t, heads, eps=1e-6):
    B_, L, D = t.shape
    th = t.reshape(B_, L, heads, D // heads)
    th = th * lax.rsqrt(jnp.sum(th * th, axis=-1, keepdims=True) + eps)
    return th.reshape(B_, L, D)


def swiglu(x, w1, w3, w2):
    return (jax.nn.silu(x @ w1) * (x @ w3)) @ w2


def depthwise_conv(u, w):
    K = w.shape[0]
    return lax.conv_general_dilated(u, w[:, None, :].astype(u.dtype), window_strides=(1,),
                                    padding=[(K // 2, K // 2)],
                                    dimension_numbers=("NWC", "WIO", "NWC"),
                                    feature_group_count=u.shape[-1])


def token_shift(u, mu_prev, mu_next):
    prev = jnp.pad(u, ((0, 0), (1, 0), (0, 0)))[:, :-1]
    nxt = jnp.pad(u, ((0, 0), (0, 1), (0, 0)))[:, 1:]
    return u + mu_prev * (prev - u) + mu_next * (nxt - u)


def hyena_positional_features(L):
    t = jnp.linspace(0.0, 1.0, L, dtype=jnp.float32)[:, None]
    ang = 2.0 * math.pi * jnp.arange(L, dtype=jnp.float32)[:, None] / L
    bands = jnp.linspace(1e-4, HY_BANDS - 1, HY_BANDS, dtype=jnp.float32)[None, :]
    z = jnp.concatenate([t, jnp.cos(bands * ang), -jnp.sin(bands * ang)], axis=-1)
    return z, t


def hyena_filter(z, t, freq, w1, b1, w2, b2, w3, decay):
    f32 = jnp.float32
    freq = freq.astype(f32)
    h = jnp.sin(freq * (z @ w1.astype(f32) + b1.astype(f32)))
    h = jnp.sin(freq * (h @ w2.astype(f32) + b2.astype(f32)))
    h = (h @ w3.astype(f32)) * jnp.exp(-t * decay.astype(f32))
    h_fwd, h_bwd = h[:, :D_HYENA], h[:, D_HYENA:]
    kern = jnp.concatenate([h_fwd, jnp.zeros_like(h_fwd[:1]), h_bwd[:0:-1]], axis=0)
    return kern / jnp.sum(jnp.abs(kern), axis=0, keepdims=True)


def two_sided_long_conv(u, kern):
    L = u.shape[1]
    uf = jnp.fft.rfft(u.astype(jnp.float32), n=2 * L, axis=1)
    kf = jnp.fft.rfft(kern, n=2 * L, axis=0)
    return jnp.fft.irfft(uf * kf[None], n=2 * L, axis=1)[:, :L]


def hyena_mixer(p, kern, conv_w, conv_b, bias):
    p = depthwise_conv(p, conv_w) + conv_b
    x0, x1, v = _split(p, (D_HYENA, D_HYENA, D_HYENA))
    u = x1 * v
    y = two_sided_long_conv(u, kern).astype(u.dtype) + bias * u
    return x0 * y


def rwkv7_scan(r, w, k, v, a, b, reverse):
    B_, L, D = r.shape

    def to_heads(t):
        return t.reshape(B_, L, RW_HEADS, RW_HEAD_DIM).transpose(1, 0, 2, 3)

    def step(S, inp):
        r_t, w_t, k_t, v_t, a_t, b_t = inp
        sa = jnp.einsum("bhij,bhj->bhi", S, a_t)
        S = S * w_t[:, :, None, :] + sa[..., None] * b_t[:, :, None, :] + v_t[..., None] * k_t[:, :, None, :]
        return S, jnp.einsum("bhij,bhj->bhi", S, r_t)

    S0 = jnp.zeros((B_, RW_HEADS, RW_HEAD_DIM, RW_HEAD_DIM), jnp.float32)
    _, ys = lax.scan(step, S0, tuple(to_heads(t) for t in (r, w, k, v, a, b)), reverse=reverse)
    return ys.transpose(1, 0, 2, 3).reshape(B_, L, D)


def head_groupnorm(y, w, b, heads, eps):
    B_, L, D = y.shape
    yh = y.reshape(B_, L, heads, D // heads)
    mu = jnp.mean(yh, axis=-1, keepdims=True)
    var = jnp.mean(jnp.square(yh - mu), axis=-1, keepdims=True)
    return ((yh - mu) * lax.rsqrt(var + eps)).reshape(B_, L, D) * w + b


def rwkv7_mixer(p, mu_prev, mu_next, w_lora, w0, a_lora, a0, g_lora, k_k, k_a, r_k, gn_w, gn_b):
    f32 = jnp.float32
    p = token_shift(p, mu_prev, mu_next).astype(f32)
    r, k, v, lw_f, lw_b, la_f, la_b, lg = _split(
        p, (D_RWKV, D_RWKV, D_RWKV, RW_LORA_W, RW_LORA_W, RW_LORA_A, RW_LORA_A, RW_LORA_G))
    gate = jax.nn.sigmoid(lg) @ g_lora.astype(f32)
    kk = l2norm_heads(k * k_k, RW_HEADS)
    y = 0.0
    for d, (lw, la, rev) in enumerate(((lw_f, la_f, False), (lw_b, la_b, True))):
        log_w = -RW_DECAY_SCALE * jax.nn.sigmoid(w0[d] + jnp.tanh(lw) @ w_lora[d].astype(f32))
        a = jax.nn.sigmoid(a0[d] + la @ a_lora[d].astype(f32))
        k_d = k * (1.0 + (a - 1.0) * k_a)
        y = y + rwkv7_scan(r, jnp.exp(log_w), k_d, v, -kk, kk * a, rev)
    y = head_groupnorm(y, gn_w, gn_b, RW_HEADS, RW_GN_EPS)
    B_, L, _ = r.shape
    bonus = jnp.sum((r * k * r_k).reshape(B_, L, RW_HEADS, RW_HEAD_DIM), axis=-1, keepdims=True)
    y = y + (bonus * v.reshape(B_, L, RW_HEADS, RW_HEAD_DIM)).reshape(B_, L, D_RWKV)
    return y * gate


def chunk_gated_delta(q, k, v, g, beta):
    B_, L, H, N = q.shape
    C = GDN_CHUNK
    n = L // C

    def chunks(t):
        return t.reshape(B_, n, C, H, -1).transpose(0, 3, 1, 2, 4)

    def chunks_s(t):
        return t.reshape(B_, n, C, H).transpose(0, 3, 1, 2)

    qc, kc, vc = chunks(q), chunks(k), chunks(v)
    gc = jnp.cumsum(chunks_s(g), axis=-1)
    bc = chunks_s(beta)
    idx = jnp.arange(C)
    causal = idx[:, None] >= idx[None, :]
    decay = jnp.exp(jnp.where(causal, gc[..., :, None] - gc[..., None, :], -jnp.inf))
    kb = kc * bc[..., None]
    lower = jnp.einsum("bhncd,bhnsd->bhncs", kb, kc) * decay
    rhs = jnp.concatenate([vc * bc[..., None], kb * jnp.exp(gc)[..., None]], axis=-1)
    sol = lax.linalg.triangular_solve(lower, rhs, left_side=True, lower=True, unit_diagonal=True)
    u_c, w_c = sol[..., :N], sol[..., N:]
    attn = jnp.einsum("bhncd,bhnsd->bhncs", qc, kc) * decay
    q_dec = qc * jnp.exp(gc)[..., None]
    g_last = gc[..., -1]
    k_end = kc * jnp.exp(g_last[..., None] - gc)[..., None]

    def step(S, inp):
        u_i, w_i, attn_i, q_i, k_i, gl = inp
        v_new = u_i - jnp.einsum("bhcd,bhde->bhce", w_i, S)
        o_i = jnp.einsum("bhcd,bhde->bhce", q_i, S) + jnp.einsum("bhcs,bhse->bhce", attn_i, v_new)
        S = S * jnp.exp(gl)[..., None, None] + jnp.einsum("bhcd,bhce->bhde", k_i, v_new)
        return S, o_i

    xs = tuple(jnp.moveaxis(t, 2, 0) for t in (u_c, w_c, attn, q_dec, k_end, g_last))
    S0 = jnp.zeros((B_, H, N, N), jnp.float32)
    _, o = lax.scan(step, S0, xs)
    return o.transpose(1, 0, 3, 2, 4).reshape(B_, L, H, N)


def gdn_mixer(p, conv_w, a_log, dt_bias, norm_w):
    f32 = jnp.float32
    qkv, zg, a_f, a_b, b_f, b_b = _split(
        p, (3 * D_GDN, D_GDN, GDN_HEADS, GDN_HEADS, GDN_HEADS, GDN_HEADS))
    qkv = jax.nn.silu(depthwise_conv(qkv, conv_w)).astype(f32)
    q, k, v = _split(qkv, (D_GDN, D_GDN, D_GDN))
    B_, L, _ = q.shape
    q = l2norm_heads(q, GDN_HEADS) * (GDN_HEAD_DIM ** -0.5)
    k = l2norm_heads(k, GDN_HEADS)
    hd = lambda t: t.reshape(B_, L, GDN_HEADS, GDN_HEAD_DIM)
    q, k, v = hd(q), hd(k), hd(v)
    o = 0.0
    for d, (ag, bg, rev) in enumerate(((a_f, b_f, False), (a_b, b_b, True))):
        g = -jnp.exp(a_log[d].astype(f32)) * jax.nn.softplus(ag.astype(f32) + dt_bias[d])
        beta = jax.nn.sigmoid(bg.astype(f32))
        if rev:
            o_d = chunk_gated_delta(q[:, ::-1], k[:, ::-1], v[:, ::-1], g[:, ::-1], beta[:, ::-1])[:, ::-1]
        else:
            o_d = chunk_gated_delta(q, k, v, g, beta)
        o = o + o_d
    o = o * lax.rsqrt(jnp.mean(o * o, axis=-1, keepdims=True) + NORM_EPS) * norm_w
    o = o * jax.nn.silu(hd(zg.astype(f32)))
    return o.reshape(B_, L, D_GDN)


def memory_cross_attention(h, mem_n, wq, wk, wv, wo):
    B_, L, _ = h.shape
    M = mem_n.shape[1]
    q = (h @ wq).reshape(B_, L, XA_HEADS, XA_HEAD_DIM)
    k = (mem_n @ wk).reshape(B_, M, XA_HEADS, XA_HEAD_DIM)
    v = (mem_n @ wv).reshape(B_, M, XA_HEADS, XA_HEAD_DIM)
    s = jnp.einsum("blhd,bmhd->bhlm", q, k).astype(jnp.float32) * (XA_HEAD_DIM ** -0.5)
    pr = jax.nn.softmax(s, axis=-1).astype(v.dtype)
    o = jnp.einsum("bhlm,bmhd->blhd", pr, v).reshape(B_, L, D_MODEL)
    return o @ wo


def setup_inputs(seed: int = 0) -> dict:
    key = jax.random.key(seed)
    ks = iter(jax.random.split(key, 96))
    f32 = jnp.float32

    def nrm(shape, scale):
        return scale * jax.random.normal(next(ks), shape, f32)

    def gain(shape):
        return 1.0 + 0.05 * jax.random.normal(next(ks), shape, f32)

    def unif(shape, lo, hi):
        return jax.random.uniform(next(ks), shape, f32, minval=lo, maxval=hi)

    hy_rates = jnp.tile(jnp.linspace(-math.log(HY_TARGET) / HY_SLOW_DECAY,
                                     -math.log(HY_TARGET) / HY_FAST_DECAY, D_HYENA, dtype=f32), 2)
    dt = jnp.exp(unif((DEPTH, 2, GDN_HEADS), math.log(1e-3), math.log(1e-1)))
    return {
        "x": nrm((BATCH, SEQ, D_MODEL), 1.0),
        "mem": nrm((BATCH, N_MEM, D_MODEL), 1.0),
        "norm_ffn1": gain((DEPTH, D_MODEL)),
        "ffn1_w1": nrm((DEPTH, D_MODEL, D_FF), D_MODEL ** -0.5),
        "ffn1_w3": nrm((DEPTH, D_MODEL, D_FF), D_MODEL ** -0.5),
        "ffn1_w2": nrm((DEPTH, D_FF, D_MODEL), D_FF ** -0.5),
        "norm_mix": gain((DEPTH, D_MODEL)),
        "w_in": nrm((DEPTH, D_MODEL, IN_COLS), D_MODEL ** -0.5),
        "w_out": nrm((DEPTH, D_MIX, D_MODEL), D_MIX ** -0.5),
        "hy_conv_w": nrm((DEPTH, HY_SHORT, HY_COLS), HY_SHORT ** -0.5),
        "hy_conv_b": nrm((DEPTH, HY_COLS), 0.02),
        "hy_freq": gain((DEPTH, HY_FFN)),
        "hy_w1": nrm((DEPTH, HY_EMB, HY_FFN), HY_EMB ** -0.5),
        "hy_b1": nrm((DEPTH, HY_FFN), 0.1),
        "hy_w2": nrm((DEPTH, HY_FFN, HY_FFN), HY_FFN ** -0.5),
        "hy_b2": nrm((DEPTH, HY_FFN), 0.1),
        "hy_w3": nrm((DEPTH, HY_FFN, 2 * D_HYENA), HY_FFN ** -0.5),
        "hy_decay": hy_rates * gain((DEPTH, 2 * D_HYENA)),
        "hy_bias": nrm((DEPTH, D_HYENA), 1.0),
        "rw_mu_prev": unif((DEPTH, RW_COLS), 0.0, 0.5),
        "rw_mu_next": unif((DEPTH, RW_COLS), 0.0, 0.5),
        "rw_w_lora": nrm((DEPTH, 2, RW_LORA_W, D_RWKV), 0.5 * RW_LORA_W ** -0.5),
        "rw_w0": jnp.linspace(-5.0, -0.5, D_RWKV, dtype=f32) + nrm((DEPTH, 2, D_RWKV), 0.1),
        "rw_a_lora": nrm((DEPTH, 2, RW_LORA_A, D_RWKV), 0.5 * RW_LORA_A ** -0.5),
        "rw_a0": nrm((DEPTH, 2, D_RWKV), 0.1),
        "rw_g_lora": nrm((DEPTH, RW_LORA_G, D_RWKV), RW_LORA_G ** -0.5),
        "rw_k_k": 0.85 + nrm((DEPTH, D_RWKV), 0.05),
        "rw_k_a": gain((DEPTH, D_RWKV)),
        "rw_r_k": nrm((DEPTH, D_RWKV), 0.1),
        "rw_gn_w": gain((DEPTH, D_RWKV)),
        "rw_gn_b": nrm((DEPTH, D_RWKV), 0.02),
        "gdn_conv_w": nrm((DEPTH, GDN_SHORT, 3 * D_GDN), GDN_SHORT ** -0.5),
        "gdn_a_log": jnp.log(unif((DEPTH, 2, GDN_HEADS), 1.0, 16.0)),
        "gdn_dt_bias": dt + jnp.log(-jnp.expm1(-dt)),
        "gdn_norm_w": gain((DEPTH, GDN_HEAD_DIM)),
        "norm_xattn": gain((DEPTH, D_MODEL)),
        "xa_wq": nrm((DEPTH, D_MODEL, D_MODEL), D_MODEL ** -0.5),
        "xa_wk": nrm((DEPTH, D_MODEL, D_MODEL), D_MODEL ** -0.5),
        "xa_wv": nrm((DEPTH, D_MODEL, D_MODEL), D_MODEL ** -0.5),
        "xa_wo": nrm((DEPTH, D_MODEL, D_MODEL), D_MODEL ** -0.5),
        "mem_norm": gain((D_MODEL,)),
        "norm_ffn2": gain((DEPTH, D_MODEL)),
        "ffn2_w1": nrm((DEPTH, D_MODEL, D_FF), D_MODEL ** -0.5),
        "ffn2_w3": nrm((DEPTH, D_MODEL, D_FF), D_MODEL ** -0.5),
        "ffn2_w2": nrm((DEPTH, D_FF, D_MODEL), D_FF ** -0.5),
        "norm_final": gain((D_MODEL,)),
    }


def reference(x, mem, norm_ffn1, ffn1_w1, ffn1_w3, ffn1_w2, norm_mix, w_in, w_out,
              hy_conv_w, hy_conv_b, hy_freq, hy_w1, hy_b1, hy_w2, hy_b2, hy_w3, hy_decay, hy_bias,
              rw_mu_prev, rw_mu_next, rw_w_lora, rw_w0, rw_a_lora, rw_a0, rw_g_lora,
              rw_k_k, rw_k_a, rw_r_k, rw_gn_w, rw_gn_b,
              gdn_conv_w, gdn_a_log, gdn_dt_bias, gdn_norm_w,
              norm_xattn, xa_wq, xa_wk, xa_wv, xa_wo, mem_norm,
              norm_ffn2, ffn2_w1, ffn2_w3, ffn2_w2, norm_final):
    L = x.shape[1]
    z_pos, t_pos = hyena_positional_features(L)
    mem_n = rmsnorm(mem, mem_norm)
    for l in range(DEPTH):
        x = x + 0.5 * swiglu(rmsnorm(x, norm_ffn1[l]), ffn1_w1[l], ffn1_w3[l], ffn1_w2[l])
        h = rmsnorm(x, norm_mix[l])
        p_hy, p_rw, p_gdn = _split(h @ w_in[l], (HY_COLS, RW_COLS, GDN_COLS))
        kern = hyena_filter(z_pos, t_pos, hy_freq[l], hy_w1[l], hy_b1[l], hy_w2[l], hy_b2[l],
                            hy_w3[l], hy_decay[l])
        y_hy = hyena_mixer(p_hy, kern, hy_conv_w[l], hy_conv_b[l], hy_bias[l])
        y_rw = rwkv7_mixer(p_rw, rw_mu_prev[l], rw_mu_next[l], rw_w_lora[l], rw_w0[l], rw_a_lora[l],
                           rw_a0[l], rw_g_lora[l], rw_k_k[l], rw_k_a[l], rw_r_k[l], rw_gn_w[l], rw_gn_b[l])
        y_gdn = gdn_mixer(p_gdn, gdn_conv_w[l], gdn_a_log[l], gdn_dt_bias[l], gdn_norm_w[l])
        y = jnp.concatenate([y_hy.astype(x.dtype), y_rw.astype(x.dtype), y_gdn.astype(x.dtype)], axis=-1)
        x = x + y @ w_out[l]
        x = x + memory_cross_attention(rmsnorm(x, norm_xattn[l]), mem_n, xa_wq[l], xa_wk[l], xa_wv[l], xa_wo[l])
        x = x + 0.5 * swiglu(rmsnorm(x, norm_ffn2[l]), ffn2_w1[l], ffn2_w3[l], ffn2_w2[l])
    return rmsnorm(x, norm_final)
```

```cpp
#include <hip/hip_runtime.h>
#include <hip/hip_bf16.h>
#include <hip/hip_cooperative_groups.h>
#include <cstdio>
namespace cg = cooperative_groups;

typedef unsigned short u16;
using bf16x8 = __attribute__((ext_vector_type(8))) short;
using f32x4 = __attribute__((ext_vector_type(4))) float;

#define DEVI __device__ __forceinline__

constexpr int T_ = 32768, L_ = 8192, NB_ = 4, DM = 1024, DFF = 2816, INC = 3864, INCP = 4096;
constexpr int NTHR = 512, NWV = NTHR / 64;

constexpr size_t OFF_WA = 0;
constexpr size_t OFF_WB = OFF_WA + 11534336;
constexpr size_t OFF_WKV = OFF_WB + 5767168;
constexpr size_t OFF_MEMN = OFF_WKV + 8388608;
constexpr size_t OFF_KM = OFF_MEMN + 2097152;
constexpr size_t OFF_VT = OFF_KM + 4194304;
constexpr size_t OFF_RK = OFF_VT + 4194304;
constexpr size_t OFF_UB = OFF_RK + 16777216;
constexpr size_t OFF_YC = OFF_UB + 20971520;
constexpr size_t OFF_HN = OFF_YC + 16777216;
constexpr size_t OFF_YRW = OFF_HN + 67108864;
constexpr size_t OFF_YGD = OFF_YRW + 50331648;
constexpr size_t OFF_BIG = OFF_YGD + 50331648;
constexpr size_t OFF_BAR = OFF_BIG + 253231104;
constexpr size_t OFF_X0 = OFF_BAR + 16384;
constexpr int UBS = 10240;
constexpr int SCAN_SMEM = 75776;
constexpr int SMEM_BYTES = 2 * SCAN_SMEM;

struct Params {
  const float* in[46];
  float* out;
  char* ws;
};

typedef const __attribute__((address_space(4))) Params* KP;
DEVI KP opqk(KP k) { asm volatile("" : "+s"(k)); return k; }

enum {
  I_X = 0, I_MEM, I_NFFN1, I_F1W1, I_F1W3, I_F1W2, I_NMIX, I_WIN, I_WOUT, I_HYCW, I_HYCB, I_HYFREQ, I_HYW1, I_HYB1,
  I_HYW2, I_HYB2, I_HYW3, I_HYDEC, I_HYBIAS, I_MUP, I_MUN, I_WLORA, I_W0, I_ALORA, I_A0, I_GLORA, I_KK, I_KA, I_RK,
  I_GNW, I_GNB, I_GCW, I_GALOG, I_GDT, I_GNORM, I_NXA, I_WQ, I_WK, I_WV, I_WO, I_MEMNORM, I_NFFN2, I_F2W1, I_F2W3,
  I_F2W2, I_NFINAL
};

typedef __bf16 bf16x2_t __attribute__((ext_vector_type(2)));
DEVI unsigned cvtpk(float lo, float hi) { bf16x2_t v = {(__bf16)lo, (__bf16)hi}; return __builtin_bit_cast(unsigned, v); }
DEVI u16 f2bf(float f) { return (u16)(cvtpk(f, 0.f) & 0xffffu); }
DEVI float frcp(float x) { return __builtin_amdgcn_rcpf(x); }
DEVI float bf2f(u16 h) { return __uint_as_float(((unsigned)h) << 16); }
DEVI float bflo(unsigned v) { return __uint_as_float(v << 16); }
DEVI float bfhi(unsigned v) { return __uint_as_float(v & 0xffff0000u); }
DEVI unsigned pack2(float a, float b) { return cvtpk(a, b); }
DEVI float sigm(float x) { return frcp(1.f + __expf(-x)); }
DEVI float siluf(float x) { return x * frcp(1.f + __expf(-x)); }

DEVI void unpack8(uint4 v, float* f) {
  f[0] = bflo(v.x); f[1] = bfhi(v.x); f[2] = bflo(v.y); f[3] = bfhi(v.y);
  f[4] = bflo(v.z); f[5] = bfhi(v.z); f[6] = bflo(v.w); f[7] = bfhi(v.w);
}
DEVI uint4 pack8(const float* f) {
  uint4 v; v.x = pack2(f[0], f[1]); v.y = pack2(f[2], f[3]); v.z = pack2(f[4], f[5]); v.w = pack2(f[6], f[7]);
  return v;
}

template <int CTRL> DEVI float dppf(float x) {
  return __int_as_float(__builtin_amdgcn_update_dpp(0, __float_as_int(x), CTRL, 0xf, 0xf, true));
}
DEVI float allsum16(float x) {
  x += dppf<0xB1>(x);
  x += dppf<0x4E>(x);
  x += dppf<0x141>(x);
  x += dppf<0x140>(x);
  return x;
}
DEVI float allsum8(float x) {
  x += dppf<0xB1>(x);
  x += dppf<0x4E>(x);
  x += dppf<0x141>(x);
  return x;
}
DEVI int otid() { int t = threadIdx.x; asm volatile("" : "+v"(t)); return t; }
template <class Tp> DEVI const Tp* opq(const Tp* p) { asm volatile("" : "+v"(p)); return p; }
typedef float f32x2 __attribute__((ext_vector_type(2)));
DEVI float dot4(float s0, float s1, float s2, float s3, const float4& k) {
  f32x2 t = f32x2{s0, s1} * f32x2{k.x, k.y};
  t = __builtin_elementwise_fma(f32x2{s2, s3}, f32x2{k.z, k.w}, t);
  return t.x + t.y;
}
DEVI float wavesum(float x) {
  for (int o = 32; o > 0; o >>= 1) x += __shfl_xor(x, o, 64);
  return x;
}

DEVI void convert_phase(const float* __restrict__ W0, const float* __restrict__ W1, int K, int N, int Npad,
                              u16* __restrict__ Wt, char* smem, int bid, int nb) {
  float* tile = (float*)smem;
  const int tid = otid();
  const int kt = K / 64;
  const int ntiles = (Npad / 64) * kt;
  const int NW = W1 ? N / 2 : N;
  for (int t = bid; t < ntiles; t += nb) {
    const int n0 = (t / kt) * 64, k0 = (t % kt) * 64;
#pragma unroll 4
    for (int i = 0; i < 64 / NWV; ++i) {
      int kk = i * NWV + (tid >> 6), nn = tid & 63, R = n0 + nn;
      float v = 0.f;
      if (R < N) {
        if (W1) {
          int g = R >> 5, wi = R & 31;
          const float* src = (wi < 16) ? W0 : W1;
          v = src[(size_t)(k0 + kk) * NW + g * 16 + (wi & 15)];
        } else {
          v = W0[(size_t)(k0 + kk) * NW + R];
        }
      }
      tile[kk * 65 + nn] = v;
    }
    __syncthreads();
#pragma unroll 4
    for (int i = 0; i < 64 / NWV; ++i) {
      int nn = i * NWV + (tid >> 6), kk = tid & 63;
      Wt[(size_t)(n0 + nn) * K + k0 + kk] = f2bf(tile[kk * 65 + nn]);
    }
    __syncthreads();
  }
}

template <bool OUT_F32>
DEVI void rmsnorm_phase(const float* __restrict__ x, const float* __restrict__ g, void* outp, int rows, int bid,
                              int nb) {
  const int tid_ = otid();
  const int lane = tid_ & 63, wv = tid_ >> 6;
  const bool sliced = (rows == T_ && nb == 256);
  const int r0_ = sliced ? ((bid & 7) * 4096 + (bid >> 3) * 128 + wv) : (bid * NWV + wv);
  const int rend_ = sliced ? ((bid & 7) * 4096 + (bid >> 3) * 128 + 128) : rows;
  const int rstep_ = sliced ? NWV : nb * NWV;
  for (int r = r0_; r < rend_; r += rstep_) {
    const float* xr = x + (size_t)r * DM;
    float4 v[4];
    float ss = 0.f;
#pragma unroll
    for (int i = 0; i < 4; ++i) {
      v[i] = *(const float4*)(xr + i * 256 + lane * 4);
      ss += v[i].x * v[i].x + v[i].y * v[i].y + v[i].z * v[i].z + v[i].w * v[i].w;
    }
    ss = wavesum(ss);
    const float sc = rsqrtf(ss * (1.f / DM) + 1e-6f);
#pragma unroll
    for (int i = 0; i < 4; ++i) {
      float4 gg = *(const float4*)(g + i * 256 + lane * 4);
      float a = v[i].x * sc * gg.x, b = v[i].y * sc * gg.y, c = v[i].z * sc * gg.z, d = v[i].w * sc * gg.w;
      if (OUT_F32) {
        *(float4*)((float*)outp + (size_t)r * DM + i * 256 + lane * 4) = make_float4(a, b, c, d);
      } else {
        uint2 o; o.x = pack2(a, b); o.y = pack2(c, d);
        *(uint2*)((u16*)outp + (size_t)r * DM + i * 256 + lane * 4) = o;
      }
    }
  }
}

namespace pg8 {
#define PG8_LAS __attribute__((address_space(3)))
typedef unsigned u32x4 __attribute__((ext_vector_type(4)));
constexpr int BM = 256, BK = 64, HALF = 128, HTB = HALF * BK * 2, NXCD = 8, WGM = 8;
DEVI int lds_byte(int r, int c) { const int st = (r >> 4) * 2 + (c >> 5), rr = r & 15, cc = c & 31, ob = rr * 64 + cc * 2; return st * 1024 + (ob ^ (((ob >> 9) & 1) << 5)); }
DEVI void stage_rc(int b, int& R, int& C) { const int st = b / 1024, sb = b % 1024, swz = sb ^ (((sb >> 9) & 1) << 5); R = (st >> 1) * 16 + swz / 64; C = (st & 1) * 32 + (swz % 64) / 2; }
DEVI int perm32(int rho) { const int n = rho >> 4, i = rho & 15; return 8 * (i >> 2) + 4 * n + (i & 3); }
struct Unit { int pm, pn; };
struct Gemm { const u16* A; const u16* Bt; int M, N, K; };
struct StaticOrder {
  int nM, nN, nwg, G, c;
  DEVI void init(int M, int N, int G_, int c_) { nM = M / BM; nN = N / BM; nwg = nM * nN; G = G_; c = c_; }
  DEVI bool next(int i, Unit& u) const {
    const long L = (long)i * G + c; if (L >= nwg) return false;
    int wgid = (int)L; { const int q = nwg / NXCD, r = nwg % NXCD, xcd = wgid % NXCD, off = wgid / NXCD; wgid = (xcd < r ? xcd * (q + 1) : r * (q + 1) + (xcd - r) * q) + off; }
    const int nig = WGM * nN, gid = wgid / nig, fm = gid * WGM, gsz = (nM - fm) < WGM ? (nM - fm) : WGM;
    u.pm = fm + ((wgid % nig) % gsz); u.pn = (wgid % nig) / gsz; return true;
  }
};
DEVI unsigned cvt_pk_bf16(float lo, float hi) { return cvtpk(lo, hi); }

struct EpiBf16 {
  static constexpr bool PERM = true;
  u16* O; int ldc; int N;
  DEVI void operator()(const f32x4 (&acc)[2][2][4][2], const Unit& u, int wr, int wc, int fr, int fq) const {
    const int row0 = u.pm * BM + wr * 64 + fr, col0 = u.pn * BM + wc * 32 + 8 * fq;
#pragma unroll
    for (int ai = 0; ai < 2; ++ai)
#pragma unroll
      for (int m = 0; m < 4; ++m) {
        u16* rowp = O + (size_t)(row0 + ai * HALF + m * 16) * ldc + col0;
#pragma unroll
        for (int bj = 0; bj < 2; ++bj) {
          const f32x4 v0 = acc[ai][bj][m][0], v1 = acc[ai][bj][m][1];
          u32x4 w; w.x = cvt_pk_bf16(v0[0], v0[1]); w.y = cvt_pk_bf16(v0[2], v0[3]); w.z = cvt_pk_bf16(v1[0], v1[1]); w.w = cvt_pk_bf16(v1[2], v1[3]);
          if (col0 + bj * HALF < N) *(u32x4*)(rowp + bj * HALF) = w;
        }
      }
  }
};
struct EpiSwiglu {
  static constexpr bool PERM = false;
  u16* U; int ldu;
  DEVI void operator()(const f32x4 (&acc)[2][2][4][2], const Unit& u, int wr, int wc, int fr, int fq) const {
    const int row0 = u.pm * BM + wr * 64 + fr;
#pragma unroll
    for (int ai = 0; ai < 2; ++ai)
#pragma unroll
      for (int m = 0; m < 4; ++m) {
        u16* rowp = U + (size_t)(row0 + ai * HALF + m * 16) * ldu;
#pragma unroll
        for (int bj = 0; bj < 2; ++bj) {
          const int g32 = (u.pn * BM + bj * HALF + wc * 32) >> 5;
          const f32x4 a = acc[ai][bj][m][0], b = acc[ai][bj][m][1];
          uint2 w;
          w.x = cvt_pk_bf16(siluf(a[0]) * b[0], siluf(a[1]) * b[1]);
          w.y = cvt_pk_bf16(siluf(a[2]) * b[2], siluf(a[3]) * b[3]);
          *(uint2*)(rowp + g32 * 16 + 4 * fq) = w;
        }
      }
  }
};
struct EpiResid {
  static constexpr bool PERM = false;
  float* X; const float* Xin; float scale;
  DEVI void operator()(const f32x4 (&acc)[2][2][4][2], const Unit& u, int wr, int wc, int fr, int fq) const {
    const int row0 = u.pm * BM + wr * 64 + fr, col0 = u.pn * BM + wc * 32 + 4 * fq;
#pragma unroll
    for (int ai = 0; ai < 2; ++ai)
#pragma unroll
      for (int m = 0; m < 4; ++m) {
        const size_t ro = (size_t)(row0 + ai * HALF + m * 16) * DM + col0;
#pragma unroll
        for (int bj = 0; bj < 2; ++bj)
#pragma unroll
          for (int n = 0; n < 2; ++n) {
            const f32x4 xi = *(const f32x4*)(Xin + ro + bj * HALF + n * 16);
            *(f32x4*)(X + ro + bj * HALF + n * 16) = xi + acc[ai][bj][m][n] * scale;
          }
      }
  }
};

template <class Epi>
DEVI void gemm_phase(PG8_LAS unsigned char* lds, const Gemm g, const StaticOrder& S, const Epi& E) {
  const int tid = otid(), wid = __builtin_amdgcn_readfirstlane(tid >> 6), lane = tid & 63, wr = wid >> 2, wc = wid & 3, fr = lane & 15, fq = lane >> 4;
  const int K = g.K, nt = K / BK;
  unsigned voffA[2], voffB[2];
#pragma unroll
  for (int i = 0; i < 2; ++i) { int R, C; stage_rc(tid * 16 + i * 8192, R, C); const int Rb = Epi::PERM ? ((R & ~31) + perm32(R & 31)) : R;
    voffA[i] = (unsigned)(R * K + C) * 2u; voffB[i] = (unsigned)(Rb * K + C) * 2u; }
  const size_t kstep = (size_t)(BK * 2);
  const size_t hstep = (size_t)HALF * K * 2;
  const size_t tstep = 2 * hstep;
  const unsigned ldsw = (unsigned)wid * 1024u;
  const int aoff = lds_byte(wr * 64 + fr, fq * 8), boff = lds_byte(wc * 32 + fr, fq * 8);
#define PG8_SA(b, h) (((b) * 2 + (h)) * HTB)
#define PG8_SB(b, h) ((4 + (b) * 2 + (h)) * HTB)
#define PG8_STAGE(bufoff, gbase, voff) do { _Pragma("unroll") for (int _i = 0; _i < 2; ++_i) \
    __builtin_amdgcn_global_load_lds((const unsigned*)((const char*)(gbase) + (voff)[_i]), (PG8_LAS unsigned*)(lds + (bufoff) + ldsw + _i * 8192), 16, 0, 0); } while (0)
#define PG8_LDA(dst, b, h) do { _Pragma("unroll") for (int m = 0; m < 4; ++m) _Pragma("unroll") for (int k = 0; k < 2; ++k) dst[m][k] = *(const PG8_LAS bf16x8*)(lds + PG8_SA(b, h) + aoff + m * 2048 + k * 1024); } while (0)
#define PG8_LDB(dst, b, h) do { _Pragma("unroll") for (int n = 0; n < 2; ++n) _Pragma("unroll") for (int k = 0; k < 2; ++k) dst[n][k] = *(const PG8_LAS bf16x8*)(lds + PG8_SB(b, h) + boff + n * 2048 + k * 1024); } while (0)
#define PG8_MMA(ai, bj, At, Bt) do { __builtin_amdgcn_s_setprio(1); _Pragma("unroll") for (int m = 0; m < 4; ++m) _Pragma("unroll") for (int n = 0; n < 2; ++n) _Pragma("unroll") for (int k = 0; k < 2; ++k) \
    acc[ai][bj][m][n] = __builtin_amdgcn_mfma_f32_16x16x32_bf16(Bt[n][k], At[m][k], acc[ai][bj][m][n], 0, 0, 0); __builtin_amdgcn_s_setprio(0); } while (0)
#define PG8_WAIT_V(n) asm volatile("s_waitcnt vmcnt(" #n ")" ::: "memory")
#define PG8_WAIT_L(n) asm volatile("s_waitcnt lgkmcnt(" #n ")" ::: "memory")
#define PG8_BAR __builtin_amdgcn_s_barrier()
#define PG8_SCHED __builtin_amdgcn_sched_barrier(0)
  Unit cur, nxt; int ui = 0;
  if (!S.next(0, cur)) return;
  f32x4 acc[2][2][4][2];
#pragma unroll
  for (int a = 0; a < 2; ++a)
#pragma unroll
    for (int b = 0; b < 2; ++b)
#pragma unroll
      for (int m = 0; m < 4; ++m)
#pragma unroll
        for (int n = 0; n < 2; ++n) acc[a][b][m][n] = (f32x4){0.f, 0.f, 0.f, 0.f};
  bf16x8 At[4][2], B0[2][2], B1[2][2];
  const char* cA = (const char*)g.A + (size_t)cur.pm * tstep; const char* cB = (const char*)g.Bt + (size_t)cur.pn * tstep;
  PG8_STAGE(PG8_SB(0, 0), cB, voffB); PG8_STAGE(PG8_SA(0, 0), cA, voffA); PG8_STAGE(PG8_SB(0, 1), cB + hstep, voffB); PG8_STAGE(PG8_SA(0, 1), cA + hstep, voffA);
  if (wr == 1) PG8_BAR;
  PG8_WAIT_V(4); PG8_BAR;
  PG8_STAGE(PG8_SB(1, 0), cB + kstep, voffB); PG8_STAGE(PG8_SA(1, 0), cA + kstep, voffA); PG8_STAGE(PG8_SB(1, 1), cB + hstep + kstep, voffB);
  PG8_WAIT_V(6); PG8_BAR;
  for (;;) {
    const bool has_next = S.next(ui + 1, nxt);
    const char* nA = has_next ? (const char*)g.A + (size_t)nxt.pm * tstep : cA; const char* nB = has_next ? (const char*)g.Bt + (size_t)nxt.pn * tstep : cB;
    for (int t = 0; t < nt; t += 2) {
      const bool last = (t == nt - 2);
      const char* a1 = cA + (size_t)(t + 1) * kstep;
      const char* a2 = last ? nA : cA + (size_t)(t + 2) * kstep; const char* b2 = last ? nB : cB + (size_t)(t + 2) * kstep;
      const char* a3 = a2 + kstep; const char* b3 = b2 + kstep;
      PG8_LDB(B0, 0, 0); PG8_SCHED; PG8_LDA(At, 0, 0); PG8_STAGE(PG8_SA(1, 1), a1 + hstep, voffA);
      PG8_WAIT_L(8); PG8_BAR; PG8_WAIT_L(0); PG8_MMA(0, 0, At, B0); PG8_BAR; PG8_SCHED;
      PG8_LDB(B1, 0, 1); PG8_STAGE(PG8_SB(0, 0), b2, voffB);
      PG8_BAR; PG8_WAIT_L(0); PG8_MMA(0, 1, At, B1); PG8_BAR;
      PG8_LDA(At, 0, 1); PG8_STAGE(PG8_SA(0, 0), a2, voffA);
      PG8_BAR; PG8_WAIT_L(0); PG8_MMA(1, 0, At, B0); PG8_BAR; PG8_SCHED;
      PG8_STAGE(PG8_SB(0, 1), b2 + hstep, voffB);
      PG8_WAIT_V(6); PG8_BAR; PG8_MMA(1, 1, At, B1); PG8_BAR;
      PG8_LDB(B0, 1, 0); PG8_SCHED; PG8_LDA(At, 1, 0); PG8_STAGE(PG8_SA(0, 1), a2 + hstep, voffA);
      PG8_WAIT_L(8); PG8_BAR; PG8_WAIT_L(0); PG8_MMA(0, 0, At, B0); PG8_BAR; PG8_SCHED;
      PG8_LDB(B1, 1, 1); PG8_STAGE(PG8_SB(1, 0), b3, voffB);
      PG8_BAR; PG8_WAIT_L(0); PG8_MMA(0, 1, At, B1); PG8_BAR;
      PG8_LDA(At, 1, 1); PG8_STAGE(PG8_SA(1, 0), a3, voffA);
      PG8_BAR; PG8_WAIT_L(0); PG8_MMA(1, 0, At, B0); PG8_BAR; PG8_SCHED;
      PG8_STAGE(PG8_SB(1, 1), b3 + hstep, voffB);
      PG8_WAIT_V(6); PG8_BAR; PG8_MMA(1, 1, At, B1); PG8_BAR;
    }
    E(acc, cur, wr, wc, fr, fq);
    if (!has_next) break;
#pragma unroll
    for (int a = 0; a < 2; ++a)
#pragma unroll
      for (int b = 0; b < 2; ++b)
#pragma unroll
        for (int m = 0; m < 4; ++m)
#pragma unroll
          for (int n = 0; n < 2; ++n) acc[a][b][m][n] = (f32x4){0.f, 0.f, 0.f, 0.f};
    cur = nxt; cA = nA; cB = nB; ++ui;
  }
  PG8_WAIT_V(0);
  if (wr == 0) PG8_BAR;
  PG8_BAR;
#undef PG8_SA
#undef PG8_SB
#undef PG8_STAGE
#undef PG8_LDA
#undef PG8_LDB
#undef PG8_MMA
#undef PG8_WAIT_V
#undef PG8_WAIT_L
#undef PG8_BAR
#undef PG8_SCHED
}
}

template <class Epi>
DEVI void run_gemm(char* smem, const u16* A, const u16* Bt, int M, int N, int K, const Epi& E, int bid, int b0, int G) {
  pg8::StaticOrder S;
  const int c = (bid >= b0 && bid < b0 + G) ? (bid - b0) : (1 << 28);
  S.init(M, N, G, c);
  pg8::Gemm g{A, Bt, M, N, K};
  pg8::gemm_phase<Epi>((PG8_LAS unsigned char*)smem, g, S, E);
}

DEVI void hyfilter_phase(KP p, char* smem, int bid, int nb) {
  float* z = (float*)smem;
  float* h1 = z + 16 * 33;
  float* h2 = h1 + 16 * 64;
  float* HRAW = (float*)(p->ws + OFF_YRW);
  const int tid = otid();
  for (int it = bid; it < 2 * 512; it += nb) {
    const int l = it >> 9, t0 = (it & 511) * 16;
    const float* freq = p->in[I_HYFREQ] + l * 64;
    const float* w1 = p->in[I_HYW1] + l * 33 * 64;
    const float* b1 = p->in[I_HYB1] + l * 64;
    const float* w2 = p->in[I_HYW2] + l * 64 * 64;
    const float* b2 = p->in[I_HYB2] + l * 64;
    const float* w3 = p->in[I_HYW3] + l * 64 * 512;
    const float* dec = p->in[I_HYDEC] + l * 512;
    for (int e = tid; e < 16 * 33; e += NTHR) {
      int pos = e / 33, f = e % 33;
      int i = t0 + pos;
      float v;
      if (f == 0) {
        v = (float)i / (float)(L_ - 1);
      } else {
        int m = (f - 1) & 15;
        float band = 1e-4f + (float)m * ((15.f - 1e-4f) / 15.f);
        float ang = 6.283185307179586f * (float)i / (float)L_;
        float a = band * ang;
        v = (f <= 16) ? cosf(a) : -sinf(a);
      }
      z[pos * 33 + f] = v;
    }
    __syncthreads();
    {
      const int o = tid & 63;
      const float fo = freq[o], bo = b1[o];
#pragma unroll
      for (int i = 0; i < 16 / NWV; ++i) {
        int pos = (tid >> 6) + NWV * i;
        float s = bo;
#pragma unroll 11
        for (int f = 0; f < 33; ++f) s += z[pos * 33 + f] * w1[f * 64 + o];
        h1[pos * 64 + o] = sinf(fo * s);
      }
    }
    __syncthreads();
    {
      const int o = tid & 63;
      const float fo = freq[o], bo = b2[o];
#pragma unroll
      for (int i = 0; i < 16 / NWV; ++i) {
        int pos = (tid >> 6) + NWV * i;
        float s = bo;
#pragma unroll 16
        for (int f = 0; f < 64; ++f) s += h1[pos * 64 + f] * w2[f * 64 + o];
        h2[pos * 64 + o] = sinf(fo * s);
      }
    }
    __syncthreads();
#pragma unroll 1
    for (int cc = 0; cc < 512 / NTHR; ++cc) {
      const int ch = tid + NTHR * cc;
      float acc[16];
#pragma unroll
      for (int q = 0; q < 16; ++q) acc[q] = 0.f;
#pragma unroll 8
      for (int o = 0; o < 64; ++o) {
        float w = w3[o * 512 + ch];
#pragma unroll
        for (int q = 0; q < 16; ++q) acc[q] += h2[q * 64 + o] * w;
      }
      const float dc = dec[ch];
      float* dst = HRAW + ((size_t)(l * 512 + ch)) * L_ + t0;
#pragma unroll
      for (int q = 0; q < 16; ++q) {
        float tp = (float)(t0 + q) / (float)(L_ - 1);
        dst[q] = acc[q] * __expf(-tp * dc);
      }
    }
    __syncthreads();
  }
}

DEVI void hynorm_phase(KP p, char* smem, int bid, int nb) {
  float* red = (float*)smem;
  const float* HRAW = (const float*)(p->ws + OFF_YRW);
  u16* RK = (u16*)(p->ws + OFF_RK);
  const int tid = otid();
  for (int it = bid; it < 512; it += nb) {
    const int l = it >> 8, c = it & 255;
    const float* hf = HRAW + ((size_t)(l * 512 + c)) * L_;
    const float* hb = HRAW + ((size_t)(l * 512 + 256 + c)) * L_;
    float s = 0.f;
    for (int t = tid; t < L_; t += NTHR) {
      s += fabsf(hf[t]);
      if (t > 0) s += fabsf(hb[t]);
    }
    s = wavesum(s);
    if ((tid & 63) == 0) red[tid >> 6] = s;
    __syncthreads();
    float tot = 0.f;
    for (int w = 0; w < NWV; ++w) tot += red[w];
    const float inv = 1.f / tot;
    u16* dst = RK + (size_t)it * 16384;
    for (int i = tid; i < 16384; i += NTHR) {
      int m = i - 8192;
      float v;
      if (m == -8192) v = 0.f;
      else if (m <= 0) v = hf[-m] * inv;
      else v = hb[m] * inv;
      dst[i] = f2bf(v);
    }
    __syncthreads();
  }
}

DEVI float ldP(const u16* P, int b, int t, int col) {
  return (t >= 0 && t < L_) ? bf2f(P[((size_t)(b * L_ + t)) * INC + col]) : 0.f;
}
DEVI uint4 ldrow8(const u16* P, int b, int t, int col);
DEVI void ld8f(const float* __restrict__ g, float* o);
DEVI void hyprep_phase(KP p, int l, char* smem, int bid, int nb) {
  float* tileU = (float*)smem;
  float* tileX = tileU + 64 * 65;
  const u16* P = (const u16*)(p->ws + OFF_BIG);
  u16* UB = (u16*)(p->ws + OFF_UB);
  u16* X0 = (u16*)(p->ws + OFF_X0);
  const float* cw = p->in[I_HYCW] + l * 3 * 768;
  const float* cb = p->in[I_HYCB] + l * 768;
  const int tid = otid();
  for (int it = bid; it < 2048; it += nb) {
    const int ct = it & 3, tt = (it >> 2) & 127, b = it >> 9;
    const int c0 = ct * 64, t0 = tt * 64;
    {
      const int tl = tid >> 3, cg = tid & 7, t = t0 + tl, c = c0 + cg * 8;
      float xs[3][8];
#pragma unroll
      for (int a3 = 0; a3 < 3; ++a3) {
        float pm[8], p0[8], pp[8], w0[8], w1[8], w2[8], bb[8];
        unpack8(ldrow8(P, b, t - 1, a3 * 256 + c), pm);
        unpack8(ldrow8(P, b, t, a3 * 256 + c), p0);
        unpack8(ldrow8(P, b, t + 1, a3 * 256 + c), pp);
        ld8f(cw + a3 * 256 + c, w0); ld8f(cw + 768 + a3 * 256 + c, w1); ld8f(cw + 1536 + a3 * 256 + c, w2);
        ld8f(cb + a3 * 256 + c, bb);
#pragma unroll
        for (int e = 0; e < 8; ++e) xs[a3][e] = w0[e] * pm[e] + w1[e] * p0[e] + w2[e] * pp[e] + bb[e];
      }
#pragma unroll
      for (int e = 0; e < 8; ++e) {
        tileU[tl * 65 + cg * 8 + e] = xs[1][e] * xs[2][e];
        tileX[tl * 65 + cg * 8 + e] = xs[0][e];
      }
    }
    __syncthreads();
    {
      const int cc = tid >> 3, tq = tid & 7;
      float u8[8], x8[8];
#pragma unroll
      for (int e = 0; e < 8; ++e) { u8[e] = tileU[(tq * 8 + e) * 65 + cc]; x8[e] = tileX[(tq * 8 + e) * 65 + cc]; }
      *(uint4*)(UB + ((size_t)((c0 + cc) * 4 + b)) * UBS + 1024 + t0 + tq * 8) = pack8(u8);
      *(uint4*)(X0 + ((size_t)((c0 + cc) * 4 + b)) * L_ + t0 + tq * 8) = pack8(x8);
    }
    if (tt == 0 || tt == 127) {
      const int poff = (tt == 0) ? 0 : (1024 + L_);
      for (int e = tid; e < 64 * 128; e += NTHR) {
        int cc = e >> 7, q = e & 127;
        *(uint4*)(UB + ((size_t)((c0 + cc) * 4 + b)) * UBS + poff + q * 8) = make_uint4(0, 0, 0, 0);
      }
    }
    __syncthreads();
  }
}

DEVI void hyconv_item(KP p, int l, int item, char* smem) {
  const int tid_ = otid();
  const int lane = tid_ & 63, wv = tid_ >> 6;
  const int fr = lane & 15, fq = lane >> 4;
  const int c = item, it32 = wv;
  const int a = it32 * 32;
  u16* sU = (u16*)smem;
  unsigned* sK = (unsigned*)(smem + 4 * UBS * 2);
  {
    const uint4* gu = (const uint4*)((const u16*)(p->ws + OFF_UB) + (size_t)(c * 4) * UBS);
    const uint4* gk = (const uint4*)((const u16*)(p->ws + OFF_RK) + (size_t)(l * 256 + c) * 16384);
    __syncthreads();
    for (int i = tid_; i < 4 * UBS / 8; i += NTHR) ((uint4*)sU)[i] = gu[i];
    for (int i = tid_; i < 16384 / 8; i += NTHR) ((uint4*)sK)[i] = gk[i];
    __syncthreads();
  }
  f32x4 acc[2][8];
#pragma unroll
  for (int m = 0; m < 2; ++m)
#pragma unroll
    for (int n = 0; n < 8; ++n) acc[m][n] = f32x4{0.f, 0.f, 0.f, 0.f};
#pragma unroll 1
  for (int D = a + 31; D >= a - 255; --D) {
    bf16x8 af[2];
#pragma unroll
    for (int mt = 0; mt < 2; ++mt) {
      int idx = fq * 8 - (mt * 16 + fr) - 32 * D + 8192;
      int bd = idx >> 1;
      unsigned sh = (idx & 1) * 16;
      unsigned d0 = sK[bd], d1 = sK[bd + 1], d2 = sK[bd + 2], d3 = sK[bd + 3], d4 = sK[bd + 4];
      union { unsigned u[4]; bf16x8 v; } cv;
      cv.u[0] = __builtin_amdgcn_alignbit(d1, d0, sh);
      cv.u[1] = __builtin_amdgcn_alignbit(d2, d1, sh);
      cv.u[2] = __builtin_amdgcn_alignbit(d3, d2, sh);
      cv.u[3] = __builtin_amdgcn_alignbit(d4, d3, sh);
      af[mt] = cv.v;
    }
#pragma unroll
    for (int n = 0; n < 8; ++n) {
      const int b = n >> 1, ct = n & 1;
      const int i1 = a + ct * 16 + fr;
      bf16x8 bf = *(const bf16x8*)(sU + b * UBS + 1024 + (i1 - D) * 32 + fq * 8);
      acc[0][n] = __builtin_amdgcn_mfma_f32_16x16x32_bf16(af[0], bf, acc[0][n], 0, 0, 0);
      acc[1][n] = __builtin_amdgcn_mfma_f32_16x16x32_bf16(af[1], bf, acc[1][n], 0, 0, 0);
    }
  }
  const u16* X0 = (const u16*)(p->ws + OFF_X0) + (size_t)(c * 4) * L_;
  u16* Yo = (u16*)(p->ws + OFF_HN);
  const float bias = p->in[I_HYBIAS][l * 256 + c];
#pragma unroll
  for (int n = 0; n < 8; ++n) {
    const int b = n >> 1, ct = n & 1;
    const int i1 = a + ct * 16 + fr;
#pragma unroll
    for (int mt = 0; mt < 2; ++mt) {
      const int t = i1 * 32 + mt * 16 + fq * 4;
      const uint2 xr = *(const uint2*)(X0 + (size_t)b * L_ + t);
      const uint2 ur = *(const uint2*)(sU + b * UBS + 1024 + t);
      const float x0[4] = {bflo(xr.x), bfhi(xr.x), bflo(xr.y), bfhi(xr.y)};
      const float uu[4] = {bflo(ur.x), bfhi(ur.x), bflo(ur.y), bfhi(ur.y)};
#pragma unroll
      for (int j = 0; j < 4; ++j)
        Yo[((size_t)(b * L_ + t + j)) * DM + c] = f2bf(x0[j] * (acc[mt][n][j] + bias * uu[j]));
    }
  }
}

DEVI uint4 ldrow8(const u16* P, int b, int t, int col) {
  if (t < 0 || t >= L_) return make_uint4(0, 0, 0, 0);
  return *(const uint4*)(P + ((size_t)(b * L_ + t)) * INC + col);
}
DEVI void shift8(uint4 pm, uint4 p0, uint4 pp, const float* __restrict__ mup, const float* __restrict__ mun,
                 float* out) {
  float a[8], u[8], n[8];
  unpack8(pm, a); unpack8(p0, u); unpack8(pp, n);
  float4 m0 = *(const float4*)mup, m1 = *(const float4*)(mup + 4);
  float4 n0 = *(const float4*)mun, n1 = *(const float4*)(mun + 4);
  float mp[8] = {m0.x, m0.y, m0.z, m0.w, m1.x, m1.y, m1.z, m1.w};
  float mn[8] = {n0.x, n0.y, n0.z, n0.w, n1.x, n1.y, n1.z, n1.w};
#pragma unroll
  for (int e = 0; e < 8; ++e) out[e] = u[e] + mp[e] * (a[e] - u[e]) + mn[e] * (n[e] - u[e]);
}
DEVI void ld8f(const float* __restrict__ g, float* o) {
  float4 a = *(const float4*)g, b = *(const float4*)(g + 4);
  o[0] = a.x; o[1] = a.y; o[2] = a.z; o[3] = a.w; o[4] = b.x; o[5] = b.y; o[6] = b.z; o[7] = b.w;
}
DEVI void st8f(float* s, const float* v) {
  *(float4*)s = make_float4(v[0], v[1], v[2], v[3]);
  *(float4*)(s + 4) = make_float4(v[4], v[5], v[6], v[7]);
}

DEVI float dot8(const f32x2 (&S)[4], const float4& a, const float4& b) {
  f32x2 t = S[0] * f32x2{a.x, a.y};
  f32x2 u = S[1] * f32x2{a.z, a.w};
  t = __builtin_elementwise_fma(S[2], f32x2{b.x, b.y}, t);
  u = __builtin_elementwise_fma(S[3], f32x2{b.z, b.w}, u);
  t += u;
  return t.x + t.y;
}

DEVI void rwscan_pc_item(KP p, int l, int item, char* smem) {
  const int tid = otid();
  const int lane = tid & 63, wv = tid >> 6;
  const bool cons = wv < 4;
  const int fr = lane & 15, fq = lane >> 4;
  const int rg2 = item & 1, d = (item >> 1) & 1, bh = item >> 2, h = bh % 6, b = bh / 6;
  constexpr int BUFF = 12352;
  float* s_buf = (float*)smem;
  float* s_a = s_buf + 2 * BUFF;
  u16* s_lw = (u16*)(s_a + 2048);
  u16* s_la = s_lw + 32 * 72;
  float* s_y = (float*)(s_la + 32 * 72);
  float* s_mu = s_y + 1024;
  const u16* P = (const u16*)(p->ws + OFF_BIG);
  u16* Yd = (u16*)(p->ws + OFF_YRW) + (size_t)d * T_ * 384;
  const float* mup = p->in[I_MUP] + l * 1536;
  const float* mun = p->in[I_MUN] + l * 1536;
  const int pt = tid & 255, tl = pt >> 3, jg = pt & 7, pw = wv & 3;
  const int cr = 768 + h * 64 + jg * 8, ck = 1152 + h * 64 + jg * 8, cvv = 1536 + h * 64 + jg * 8;
  const int clw = 1920 + d * 64 + jg * 8, cla = 2048 + d * 64 + jg * 8;
  bf16x8 fW[2], fA[2];
  {
    const float* Wl = p->in[I_WLORA] + (size_t)(l * 2 + d) * 64 * 384 + h * 64 + pw * 16 + fr;
    const float* Al = p->in[I_ALORA] + (size_t)(l * 2 + d) * 64 * 384 + h * 64 + pw * 16 + fr;
#pragma unroll
    for (int ks = 0; ks < 2; ++ks) {
#pragma unroll
      for (int e = 0; e < 8; ++e) {
        int r = ks * 32 + fq * 8 + e;
        fW[ks][e] = (short)f2bf(Wl[r * 384]);
        fA[ks][e] = (short)f2bf(Al[r * 384]);
      }
    }
  }
  const float w0v = p->in[I_W0][(l * 2 + d) * 384 + h * 64 + pw * 16 + fr];
  const float a0v = p->in[I_A0][(l * 2 + d) * 384 + h * 64 + pw * 16 + fr];
  for (int e = tid; e < 768; e += NTHR) {
    float v;
    if (e < 640) {
      const int a5 = (e % 320) >> 6, j = e & 63;
      const int base = (a5 < 3) ? (a5 * 384 + h * 64) : (1152 + (a5 - 3) * 128 + d * 64);
      v = ((e < 320) ? mup : mun)[base + j];
    } else {
      v = ((e < 704) ? p->in[I_KK] : p->in[I_KA])[l * 384 + h * 64 + (e & 63)];
    }
    s_mu[e] = v;
  }
  __syncthreads();
  const int row8 = lane >> 3, e8 = lane & 7;
  const int rowi = rg2 * 32 + pw * 8 + row8;
  const int j8 = e8 * 8;
  f32x2 S[4];
#pragma unroll
  for (int i = 0; i < 4; ++i) S[i] = f32x2{0.f, 0.f};

  uint4 q[15];
#pragma unroll
  for (int i = 0; i < 15; ++i) q[i] = make_uint4(0, 0, 0, 0);
  if (!cons) {
    int t = d ? (L_ - 1 - tl) : tl;
#pragma unroll
    for (int dt = 0; dt < 3; ++dt) {
      q[0 + dt] = ldrow8(P, b, t + dt - 1, cr);
      q[3 + dt] = ldrow8(P, b, t + dt - 1, ck);
      q[6 + dt] = ldrow8(P, b, t + dt - 1, cvv);
      q[9 + dt] = ldrow8(P, b, t + dt - 1, clw);
      q[12 + dt] = ldrow8(P, b, t + dt - 1, cla);
    }
  }
  float kv[8], kkn[8];
#pragma unroll
  for (int e = 0; e < 8; ++e) { kv[e] = 0.f; kkn[e] = 0.f; }
  float yacc = 0.f;

  struct RwOps { float4 ka, kb, ra, rb; float vi; float2 sc; };
  struct RwUpd { float4 da, db, ba, bb, wa, wb; };
  auto scan_seg = [&](const float* cb, int seg) {
    auto ldops = [&](int s) {
      RwOps r;
      const float* o = cb + 2048 + s * 64 + j8;
      r.ka = *(const float4*)(o); r.kb = *(const float4*)(o + 4);
      r.ra = *(const float4*)(o - 2048); r.rb = *(const float4*)(o - 2048 + 4);
      r.vi = cb[10240 + s * 64 + rowi];
      r.sc = *(const float2*)(cb + 12288 + s * 2);
      return r;
    };
    auto ldupd = [&](int s) {
      RwUpd r;
      const float* o = cb + 2048 + s * 64 + j8;
      r.da = *(const float4*)(o + 2048); r.db = *(const float4*)(o + 2048 + 4);
      r.ba = *(const float4*)(o + 4096); r.bb = *(const float4*)(o + 4096 + 4);
      r.wa = *(const float4*)(o + 6144); r.wb = *(const float4*)(o + 6144 + 4);
      return r;
    };
    RwOps cur = ldops(seg * 8);
#pragma unroll
    for (int i_ = 0; i_ < 8; ++i_) {
      const int s = seg * 8 + i_;
      const RwUpd up = ldupd(s);
      const RwOps nxt = ldops(seg * 8 + ((i_ + 1) & 7));
      float dA = dot8(S, cur.ka, cur.kb);
      float dB = dot8(S, cur.ra, cur.rb);
      const f32x2 vi2 = f32x2{cur.vi, cur.vi};
      const f32x2 A0 = __builtin_elementwise_fma(S[0], f32x2{up.wa.x, up.wa.y}, vi2 * f32x2{up.da.x, up.da.y});
      const f32x2 A1 = __builtin_elementwise_fma(S[1], f32x2{up.wa.z, up.wa.w}, vi2 * f32x2{up.da.z, up.da.w});
      const f32x2 A2 = __builtin_elementwise_fma(S[2], f32x2{up.wb.x, up.wb.y}, vi2 * f32x2{up.db.x, up.db.y});
      const f32x2 A3 = __builtin_elementwise_fma(S[3], f32x2{up.wb.z, up.wb.w}, vi2 * f32x2{up.db.z, up.db.w});
      const float sa = allsum8(dA);
      dB = allsum8(dB);
      const float y = dB + sa * cur.sc.x + cur.vi * cur.sc.y;
      const f32x2 sa2 = f32x2{sa, sa};
      S[0] = __builtin_elementwise_fma(sa2, f32x2{up.ba.x, up.ba.y}, A0);
      S[1] = __builtin_elementwise_fma(sa2, f32x2{up.ba.z, up.ba.w}, A1);
      S[2] = __builtin_elementwise_fma(sa2, f32x2{up.bb.x, up.bb.y}, A2);
      S[3] = __builtin_elementwise_fma(sa2, f32x2{up.bb.z, up.bb.w}, A3);
      yacc = (e8 == i_) ? y : yacc;
      cur = nxt;
    }
    s_y[(seg * 8 + e8) * 32 + pw * 8 + row8] = yacc;
  };

  constexpr int NC = L_ / 32;
  if (cons) {
    for (int c = 0; c <= NC; ++c) {
      const float* cb = s_buf + ((c + 1) & 1) * BUFF;
      const bool cact = c >= 1;
      if (cact) scan_seg(cb, 0);
      __syncthreads();
      if (cact) scan_seg(cb, 1);
      __syncthreads();
      if (cact) scan_seg(cb, 2);
      __syncthreads();
    if (cact) {
        scan_seg(cb, 3);
        const int t2 = lane >> 1, hf = lane & 1;
        const float4 o4 = *(const float4*)(s_y + t2 * 32 + pw * 8 + hf * 4);
        const int ts = (c - 1) * 32 + t2;
        const int t = d ? (L_ - 1 - ts) : ts;
        uint2 o; o.x = pack2(o4.x, o4.y); o.y = pack2(o4.z, o4.w);
        *(uint2*)(Yd + ((size_t)(b * L_ + t)) * 384 + h * 64 + rg2 * 32 + pw * 8 + hf * 4) = o;
      }
    __syncthreads();
    }
  } else {
    const float* mp_ = s_mu + jg * 8;
    const float* mn_ = s_mu + 320 + jg * 8;
    for (int c = 0; c <= NC; ++c) {
      float* pb = s_buf + (c & 1) * BUFF;
      const bool pact = c < NC;
      const bool pnext = c + 1 < NC;
      const int tn_ = (c + 1) * 32 + tl;
      const int tnx = d ? (L_ - 1 - tn_) : tn_;
      if (pact) {
        float rr[8], lw[8], la[8];
        shift8(q[9], q[10], q[11], mp_ + 192, mn_ + 192, lw);
        shift8(q[12], q[13], q[14], mp_ + 256, mn_ + 256, la);
        shift8(q[0], q[1], q[2], mp_, mn_, rr);
#pragma unroll
        for (int e = 0; e < 8; ++e) lw[e] = 1.f - 2.f * frcp(1.f + __expf(2.f * lw[e]));
        *(uint4*)(s_lw + tl * 72 + jg * 8) = pack8(lw);
        *(uint4*)(s_la + tl * 72 + jg * 8) = pack8(la);
        st8f(pb + tl * 64 + jg * 8, rr);
      }
      if (pnext) {
#pragma unroll
        for (int dt = 0; dt < 3; ++dt) {
          q[9 + dt] = ldrow8(P, b, tnx + dt - 1, clw);
          q[12 + dt] = ldrow8(P, b, tnx + dt - 1, cla);
          q[0 + dt] = ldrow8(P, b, tnx + dt - 1, cr);
        }
      }
      __syncthreads();
      if (pact) {
#pragma unroll
        for (int mt = 0; mt < 2; ++mt) {
          f32x4 aw = {0.f, 0.f, 0.f, 0.f}, aa = {0.f, 0.f, 0.f, 0.f};
#pragma unroll
          for (int ks = 0; ks < 2; ++ks) {
            bf16x8 xw = *(const bf16x8*)(s_lw + (mt * 16 + fr) * 72 + ks * 32 + fq * 8);
            bf16x8 xa = *(const bf16x8*)(s_la + (mt * 16 + fr) * 72 + ks * 32 + fq * 8);
            aw = __builtin_amdgcn_mfma_f32_16x16x32_bf16(xw, fW[ks], aw, 0, 0, 0);
            aa = __builtin_amdgcn_mfma_f32_16x16x32_bf16(xa, fA[ks], aa, 0, 0, 0);
          }
#pragma unroll
          for (int j = 0; j < 4; ++j) {
            int t2 = mt * 16 + fq * 4 + j, jj = pw * 16 + fr;
            pb[8192 + t2 * 64 + jj] = __expf(-0.606531f * sigm(aw[j] + w0v));
            s_a[t2 * 64 + jj] = sigm(aa[j] + a0v);
          }
        }
        float vv[8];
        shift8(q[6], q[7], q[8], mp_ + 128, mn_ + 128, vv);
        st8f(pb + 10240 + tl * 64 + jg * 8, vv);
      }
      if (pnext) {
#pragma unroll
        for (int dt = 0; dt < 3; ++dt) q[6 + dt] = ldrow8(P, b, tnx + dt - 1, cvv);
      }
      __syncthreads();
      if (pact) {
        shift8(q[3], q[4], q[5], mp_ + 64, mn_ + 64, kv);
        float kkc[8];
        ld8f(s_mu + 640 + jg * 8, kkc);
        float ss = 0.f;
#pragma unroll
        for (int e = 0; e < 8; ++e) { kkn[e] = kv[e] * kkc[e]; ss += kkn[e] * kkn[e]; }
        ss = allsum8(ss);
        const float inv = rsqrtf(ss + 1e-6f);
        float nk[8];
#pragma unroll
        for (int e = 0; e < 8; ++e) { kkn[e] *= inv; nk[e] = -kkn[e]; }
        st8f(pb + 2048 + tl * 64 + jg * 8, nk);
      }
      if (pnext) {
#pragma unroll
        for (int dt = 0; dt < 3; ++dt) q[3 + dt] = ldrow8(P, b, tnx + dt - 1, ck);
      }
      __syncthreads();
      if (pact) {
        float av[8], kac[8], kd[8], bb[8], rr[8], wv8[8];
        ld8f(s_a + tl * 64 + jg * 8, av);
        ld8f(pb + tl * 64 + jg * 8, rr);
        ld8f(pb + 8192 + tl * 64 + jg * 8, wv8);
        ld8f(s_mu + 704 + jg * 8, kac);
        float br = 0.f, kr = 0.f;
#pragma unroll
        for (int e = 0; e < 8; ++e) {
          kd[e] = kv[e] * (1.f + (av[e] - 1.f) * kac[e]);
          bb[e] = kkn[e] * av[e];
          br += bb[e] * rr[e];
          kr += kd[e] * rr[e];
          rr[e] *= wv8[e];
        }
        br = allsum8(br);
        kr = allsum8(kr);
        st8f(pb + 4096 + tl * 64 + jg * 8, kd);
        st8f(pb + 6144 + tl * 64 + jg * 8, bb);
        st8f(pb + tl * 64 + jg * 8, rr);
        if (jg == 0) *(float2*)(pb + 12288 + tl * 2) = make_float2(br, kr);
      }
      __syncthreads();
    }
  }
}

DEVI void gdscan_pc_item(KP p, int l, int item, char* smem) {
  const int tid = otid();
  const int lane = tid & 63, wv = tid >> 6;
  const bool cons = wv < 4;
  const int rg2 = item & 1, d = (item >> 1) & 1, bh = item >> 2, h = bh % 6, b = bh / 6;
  constexpr int BUFF = 6272;
  float* s_buf = (float*)smem;
  float* s_y = s_buf + 2 * BUFF;
  const u16* P = (const u16*)(p->ws + OFF_BIG);
  u16* Yd = (u16*)(p->ws + OFF_YGD) + (size_t)d * T_ * 384;
  const float* cw = p->in[I_GCW] + l * 3 * 1152;
  const int pt = tid & 255, tl = pt >> 3, jg = pt & 7, pw = wv & 3;
  const int lq = h * 64 + jg * 8, lk = 384 + lq, lv = 768 + lq;
  const float negA = -__expf(p->in[I_GALOG][(l * 2 + d) * 6 + h]);
  const float dtb = p->in[I_GDT][(l * 2 + d) * 6 + h];
  const int cag = 3840 + d * 6 + h, cbg = 3852 + d * 6 + h;
  const int row8 = lane >> 3, e8 = lane & 7;
  const int col_e = rg2 * 32 + pw * 8 + row8;
  const int j8 = e8 * 8;
  f32x2 S[4];
#pragma unroll
  for (int i = 0; i < 4; ++i) S[i] = f32x2{0.f, 0.f};
  float yacc = 0.f;

  uint4 q[9];
#pragma unroll
  for (int i = 0; i < 9; ++i) q[i] = make_uint4(0, 0, 0, 0);
  u16 rag = 0, rbg = 0;
  if (!cons) {
    int t = d ? (L_ - 1 - tl) : tl;
#pragma unroll
    for (int dt = 0; dt < 3; ++dt) {
      q[0 + dt] = ldrow8(P, b, t + dt - 1, 2304 + lq);
      q[3 + dt] = ldrow8(P, b, t + dt - 1, 2304 + lk);
      q[6 + dt] = ldrow8(P, b, t + dt - 1, 2304 + lv);
    }
    { const u16* pr_ = P + ((size_t)(b * L_ + t)) * INC; rag = pr_[cag]; rbg = pr_[cbg]; }
  }
  struct GdOps { float4 ka, kb, qa, qb, sc; float ve; };
  auto scan_seg = [&](const float* cb, int seg) {
    auto ldops = [&](int s) {
      GdOps r;
      const float* o = cb + 2048 + s * 64 + j8;
      r.ka = *(const float4*)(o); r.kb = *(const float4*)(o + 4);
      r.qa = *(const float4*)(o - 2048); r.qb = *(const float4*)(o - 2048 + 4);
      r.ve = cb[4096 + s * 64 + col_e];
      r.sc = *(const float4*)(cb + 6144 + s * 4);
      return r;
    };
    GdOps cur = ldops(seg * 16);
#pragma unroll
    for (int i_ = 0; i_ < 16; ++i_) {
      const int s = seg * 16 + i_;
      const GdOps nxt = ldops(seg * 16 + ((i_ + 1) & 15));
      const float al = cur.sc.x, be = cur.sc.y, qk = cur.sc.z, nab = cur.sc.w;
      float d1 = dot8(S, cur.ka, cur.kb);
      float d2 = dot8(S, cur.qa, cur.qb);
      const f32x2 al2 = f32x2{al, al};
      const f32x2 A0 = S[0] * al2, A1 = S[1] * al2, A2 = S[2] * al2, A3 = S[3] * al2;
      const float bv = be * cur.ve;
      d1 = allsum8(d1);
      d2 = allsum8(d2);
      const float vn = __builtin_fmaf(nab, d1, bv);
      const float ov = al * d2 + qk * vn;
      const f32x2 vn2 = f32x2{vn, vn};
      S[0] = __builtin_elementwise_fma(vn2, f32x2{cur.ka.x, cur.ka.y}, A0);
      S[1] = __builtin_elementwise_fma(vn2, f32x2{cur.ka.z, cur.ka.w}, A1);
      S[2] = __builtin_elementwise_fma(vn2, f32x2{cur.kb.x, cur.kb.y}, A2);
      S[3] = __builtin_elementwise_fma(vn2, f32x2{cur.kb.z, cur.kb.w}, A3);
      yacc = (e8 == (i_ & 7)) ? ov : yacc;
      if ((i_ & 7) == 7) s_y[(s - 7 + e8) * 32 + pw * 8 + row8] = yacc;
      cur = nxt;
    }
  };
  __syncthreads();
  constexpr int NC = L_ / 32;
  for (int c = 0; c <= NC; ++c) {
    float* pb = s_buf + (c & 1) * BUFF;
    const float* cb = s_buf + ((c + 1) & 1) * BUFF;
    const bool pact = !cons && c < NC, cact = cons && c >= 1;
    if (pact) {
      float qq[8], kk[8], vv[8];
#pragma unroll
      for (int arr = 0; arr < 3; ++arr) {
        float a[8], u[8], n[8], w0[8], w1[8], w2[8];
        unpack8(q[arr * 3 + 0], a); unpack8(q[arr * 3 + 1], u); unpack8(q[arr * 3 + 2], n);
        const int lc = (arr == 0) ? lq : (arr == 1 ? lk : lv);
        ld8f(cw + lc, w0); ld8f(cw + 1152 + lc, w1); ld8f(cw + 2304 + lc, w2);
        float* o = (arr == 0) ? qq : (arr == 1 ? kk : vv);
#pragma unroll
        for (int e = 0; e < 8; ++e) o[e] = siluf(w0[e] * a[e] + w1[e] * u[e] + w2[e] * n[e]);
      }
      float sq = 0.f, sk = 0.f;
#pragma unroll
      for (int e = 0; e < 8; ++e) { sq += qq[e] * qq[e]; sk += kk[e] * kk[e]; }
      sq = allsum8(sq); sk = allsum8(sk);
      const float iq = rsqrtf(sq + 1e-6f) * 0.125f, ik = rsqrtf(sk + 1e-6f);
      float qk = 0.f;
#pragma unroll
      for (int e = 0; e < 8; ++e) { qq[e] *= iq; kk[e] *= ik; qk += qq[e] * kk[e]; }
      qk = allsum8(qk);
      st8f(pb + tl * 64 + jg * 8, qq);
      st8f(pb + 2048 + tl * 64 + jg * 8, kk);
      st8f(pb + 4096 + tl * 64 + jg * 8, vv);
      if (jg == 0) {
        float x = bf2f(rag) + dtb;
        float sp = (x > 20.f) ? x : log1pf(__expf(x));
        const float al_ = __expf(negA * sp), be_ = sigm(bf2f(rbg));
        *(float4*)(pb + 6144 + tl * 4) = make_float4(al_, be_, qk, -al_ * be_);
      }
    }
    if (cact) scan_seg(cb, 0);
    __syncthreads();
    if (!cons && c + 1 < NC) {
      int tn = (c + 1) * 32 + tl;
      int t = d ? (L_ - 1 - tn) : tn;
#pragma unroll
      for (int dt = 0; dt < 3; ++dt) {
        q[0 + dt] = ldrow8(P, b, t + dt - 1, 2304 + lq);
        q[3 + dt] = ldrow8(P, b, t + dt - 1, 2304 + lk);
        q[6 + dt] = ldrow8(P, b, t + dt - 1, 2304 + lv);
      }
      { const u16* pr_ = P + ((size_t)(b * L_ + t)) * INC; rag = pr_[cag]; rbg = pr_[cbg]; }
    }
    if (cact) {
      scan_seg(cb, 1);
      const int t2 = lane >> 1, hf = lane & 1;
      const float4 o4 = *(const float4*)(s_y + t2 * 32 + pw * 8 + hf * 4);
      const int ts = (c - 1) * 32 + t2;
      const int t = d ? (L_ - 1 - ts) : ts;
      uint2 o; o.x = pack2(o4.x, o4.y); o.y = pack2(o4.z, o4.w);
      *(uint2*)(Yd + ((size_t)(b * L_ + t)) * 384 + h * 64 + rg2 * 32 + pw * 8 + hf * 4) = o;
    }
    __syncthreads();
  }
}

DEVI void post_tok_item(KP p, int l, int item, char* smem) {
  const int tid = otid();
  const int tl = tid >> 3, jg = tid & 7;
  u16* s_sg = (u16*)smem;
  float* s_gate = (float*)(smem + 64 * 136 * 2);
  const u16* P = (const u16*)(p->ws + OFF_BIG);
  const u16* YR = (const u16*)(p->ws + OFF_YRW);
  const u16* YG = (const u16*)(p->ws + OFF_YGD);
  u16* Yo = (u16*)(p->ws + OFF_HN);
  const float* mup = p->in[I_MUP] + l * 1536;
  const float* mun = p->in[I_MUN] + l * 1536;
  const int tok = item * 64 + tl;
  const int b = tok / L_, t = tok % L_;
#pragma unroll
  for (int half = 0; half < 2; ++half) {
    const int col = 2176 + jg * 16 + half * 8;
    float lg[8];
    shift8(ldrow8(P, b, t - 1, col), ldrow8(P, b, t, col), ldrow8(P, b, t + 1, col), mup + (col - 768),
           mun + (col - 768), lg);
#pragma unroll
    for (int e = 0; e < 8; ++e) lg[e] = sigm(lg[e]);
    *(uint4*)(s_sg + tl * 136 + jg * 16 + half * 8) = pack8(lg);
  }
  __syncthreads();
  {
    const int lane = tid & 63, wv = tid >> 6, fr = lane & 15, fq = lane >> 4;
    const u16* GT = (const u16*)(p->ws + OFF_WKV);
    f32x4 acc[4][3];
#pragma unroll
    for (int m = 0; m < 4; ++m)
#pragma unroll
      for (int n = 0; n < 3; ++n) acc[m][n] = f32x4{0.f, 0.f, 0.f, 0.f};
#pragma unroll
    for (int ks = 0; ks < 4; ++ks) {
      bf16x8 af[4], bfr[3];
#pragma unroll
      for (int m = 0; m < 4; ++m) af[m] = *(const bf16x8*)(s_sg + (m * 16 + fr) * 136 + ks * 32 + fq * 8);
#pragma unroll
      for (int n = 0; n < 3; ++n) bfr[n] = *(const bf16x8*)(GT + ((wv * 3 + n) * 16 + fr) * 128 + ks * 32 + fq * 8);
#pragma unroll
      for (int m = 0; m < 4; ++m)
#pragma unroll
        for (int n = 0; n < 3; ++n) acc[m][n] = __builtin_amdgcn_mfma_f32_16x16x32_bf16(af[m], bfr[n], acc[m][n], 0, 0, 0);
    }
#pragma unroll
    for (int m = 0; m < 4; ++m)
#pragma unroll
      for (int n = 0; n < 3; ++n)
#pragma unroll
        for (int j = 0; j < 4; ++j) s_gate[(m * 16 + fq * 4 + j) * 388 + (wv * 3 + n) * 16 + fr] = acc[m][n][j];
  }
  __syncthreads();
  for (int h = 0; h < 6; ++h) {
    const int hc = h * 64 + jg * 8;
    {
      float y[8], yb8[8];
      unpack8(*(const uint4*)(YR + (size_t)tok * 384 + hc), y);
      unpack8(*(const uint4*)(YR + (size_t)(T_ + tok) * 384 + hc), yb8);
#pragma unroll
      for (int e = 0; e < 8; ++e) y[e] += yb8[e];
      float s = 0.f;
#pragma unroll
      for (int e = 0; e < 8; ++e) s += y[e];
      const float mu = allsum8(s) * (1.f / 64.f);
      float vs = 0.f;
#pragma unroll
      for (int e = 0; e < 8; ++e) { y[e] -= mu; vs += y[e] * y[e]; }
      const float rstd = rsqrtf(allsum8(vs) * (1.f / 64.f) + 64e-5f);
      float gw[8], gb[8], rk[8], rr[8], kv[8], vv[8];
      ld8f(p->in[I_GNW] + l * 384 + hc, gw);
      ld8f(p->in[I_GNB] + l * 384 + hc, gb);
      ld8f(p->in[I_RK] + l * 384 + hc, rk);
      const int cr = 768 + hc, ck = 1152 + hc, cv = 1536 + hc;
      shift8(ldrow8(P, b, t - 1, cr), ldrow8(P, b, t, cr), ldrow8(P, b, t + 1, cr), mup + hc, mun + hc, rr);
      shift8(ldrow8(P, b, t - 1, ck), ldrow8(P, b, t, ck), ldrow8(P, b, t + 1, ck), mup + 384 + hc, mun + 384 + hc, kv);
      shift8(ldrow8(P, b, t - 1, cv), ldrow8(P, b, t, cv), ldrow8(P, b, t + 1, cv), mup + 768 + hc, mun + 768 + hc, vv);
      float bs = 0.f;
#pragma unroll
      for (int e = 0; e < 8; ++e) bs += rr[e] * kv[e] * rk[e];
      bs = allsum8(bs);
      float gate[8];
      ld8f(s_gate + tl * 388 + hc, gate);
      float o[8];
#pragma unroll
      for (int e = 0; e < 8; ++e) o[e] = (y[e] * rstd * gw[e] + gb[e] + bs * vv[e]) * gate[e];
      *(uint4*)(Yo + (size_t)tok * DM + 256 + hc) = pack8(o);
    }
    {
      float o[8], nw[8], zg[8], ob8[8];
      unpack8(*(const uint4*)(YG + (size_t)tok * 384 + hc), o);
      unpack8(*(const uint4*)(YG + (size_t)(T_ + tok) * 384 + hc), ob8);
#pragma unroll
      for (int e = 0; e < 8; ++e) o[e] += ob8[e];
      float ms = 0.f;
#pragma unroll
      for (int e = 0; e < 8; ++e) ms += o[e] * o[e];
      const float rs = rsqrtf(allsum8(ms) * (1.f / 64.f) + 1e-6f);
      ld8f(p->in[I_GNORM] + l * 64 + jg * 8, nw);
      unpack8(ldrow8(P, b, t, 3456 + hc), zg);
#pragma unroll
      for (int e = 0; e < 8; ++e) o[e] = o[e] * rs * nw[e] * siluf(zg[e]);
      *(uint4*)(Yo + (size_t)tok * DM + 640 + hc) = pack8(o);
    }
  }
  __syncthreads();
}

DEVI void attn_phase(KP p, int l, char* smem, int bid, int nb) {
  u16* sKV = (u16*)smem;
  u16* sP = sKV + 64 * 264;
  const int tid = otid(), lane = tid & 63, wv = tid >> 6, fr = lane & 15, fq = lane >> 4;
  const u16* Q = (const u16*)(p->ws + OFF_BIG);
  const u16* KM = (const u16*)(p->ws + OFF_KM) + (size_t)l * 1024 * 1024;
  const u16* VT = (const u16*)(p->ws + OFF_VT) + (size_t)l * 1024 * 1024;
  u16* O = (u16*)(p->ws + OFF_HN);
  u16* myP = sP + wv * 16 * 264;
  const bool sliced = (nb == 256);
  for (int ii = bid; ii < 1024; ii += nb) {
    int it = ii;
    if (sliced) {
      const int rr = ii >> 8, x = bid & 7, j = (bid >> 3) + 32 * rr;
      it = (j & 3) | ((((x & 1) * 32) + (j >> 2)) << 2) | ((x >> 1) << 8);
    }
    const int h = it & 3, qt = (it >> 2) & 63, b = it >> 8;
    const int tok0 = b * L_ + qt * 128 + wv * 16;
    uint4 R0, R1, R2, R3;
    const int lrow = tid >> 5, lc = (tid & 31) * 8;
    const u16* kbase = KM + (size_t)(b * 256 + lrow) * DM + h * 256 + lc;
    const u16* vbase = VT + (size_t)(h * 256 + lrow) * 1024 + b * 256 + lc;
#define ATT_LDK(ch_) do { const u16* g_ = kbase + (size_t)(ch_) * 64 * DM; R0 = *(const uint4*)(g_); R1 = *(const uint4*)(g_ + 16 * DM); \
      R2 = *(const uint4*)(g_ + 32 * DM); R3 = *(const uint4*)(g_ + 48 * DM); } while (0)
#define ATT_LDV(dc_) do { const u16* g_ = vbase + (size_t)(dc_) * 64 * 1024; R0 = *(const uint4*)(g_); R1 = *(const uint4*)(g_ + 16 * 1024); \
      R2 = *(const uint4*)(g_ + 32 * 1024); R3 = *(const uint4*)(g_ + 48 * 1024); } while (0)
#define ATT_ST() do { u16* d_ = sKV + lrow * 264 + lc; *(uint4*)(d_) = R0; *(uint4*)(d_ + 16 * 264) = R1; \
      *(uint4*)(d_ + 32 * 264) = R2; *(uint4*)(d_ + 48 * 264) = R3; } while (0)
    ATT_LDK(0);
    bf16x8 qf[8];
#pragma unroll
    for (int ks = 0; ks < 8; ++ks)
      qf[ks] = *(const bf16x8*)(Q + (size_t)(tok0 + fr) * DM + h * 256 + ks * 32 + fq * 8);
    f32x4 sc[16];
#pragma unroll
    for (int i = 0; i < 16; ++i) sc[i] = f32x4{0.f, 0.f, 0.f, 0.f};
#pragma unroll
    for (int ch = 0; ch < 4; ++ch) {
      __syncthreads();
      ATT_ST();
      __syncthreads();
      if (ch < 3) ATT_LDK(ch + 1); else ATT_LDV(0);
#pragma unroll
      for (int nt = 0; nt < 4; ++nt) {
#pragma unroll
        for (int ks = 0; ks < 8; ++ks) {
          bf16x8 kf = *(const bf16x8*)(sKV + (nt * 16 + fr) * 264 + ks * 32 + fq * 8);
          sc[ch * 4 + nt] = __builtin_amdgcn_mfma_f32_16x16x32_bf16(qf[ks], kf, sc[ch * 4 + nt], 0, 0, 0);
        }
      }
    }
#pragma unroll
    for (int j = 0; j < 4; ++j) {
      float mx = -1e30f;
#pragma unroll
      for (int i = 0; i < 16; ++i) mx = fmaxf(mx, sc[i][j]);
#pragma unroll
      for (int o = 1; o < 16; o <<= 1) mx = fmaxf(mx, __shfl_xor(mx, o, 64));
      float sum = 0.f;
#pragma unroll
      for (int i = 0; i < 16; ++i) {
        float e = __expf((sc[i][j] - mx) * 0.0625f);
        sc[i][j] = e;
        sum += e;
      }
      sum = allsum16(sum);
      const float inv = frcp(sum);
#pragma unroll
      for (int i = 0; i < 16; ++i) myP[(fq * 4 + j) * 264 + i * 16 + fr] = f2bf(sc[i][j] * inv);
    }
#pragma unroll
    for (int dc = 0; dc < 4; ++dc) {
      __syncthreads();
      ATT_ST();
      __syncthreads();
      if (dc < 3) ATT_LDV(dc + 1);
      f32x4 oa[4];
#pragma unroll
      for (int nt = 0; nt < 4; ++nt) oa[nt] = f32x4{0.f, 0.f, 0.f, 0.f};
#pragma unroll
      for (int ks = 0; ks < 8; ++ks) {
        bf16x8 pf = *(const bf16x8*)(myP + fr * 264 + ks * 32 + fq * 8);
#pragma unroll
        for (int nt = 0; nt < 4; ++nt) {
          bf16x8 vf = *(const bf16x8*)(sKV + (nt * 16 + fr) * 264 + ks * 32 + fq * 8);
          oa[nt] = __builtin_amdgcn_mfma_f32_16x16x32_bf16(pf, vf, oa[nt], 0, 0, 0);
        }
      }
#pragma unroll
      for (int nt = 0; nt < 4; ++nt)
#pragma unroll
        for (int j = 0; j < 4; ++j)
          O[(size_t)(tok0 + fq * 4 + j) * DM + h * 256 + dc * 64 + nt * 16 + fr] = f2bf(oa[nt][j]);
    }
    __syncthreads();
#undef ATT_LDK
#undef ATT_LDV
#undef ATT_ST
  }
}


#define XB_TMO      128
#define XB_XCNT(j)  (256  + 64 * (j))
#define XB_XSUB(j)  (1280 + 64 * (j))
#define XB_XGEN(j)  (2304 + 64 * (j))
#define XB_TOP      3328
#define XB_TOPGEN   3392
#define XCD_BAR_WORDS 3456
#define XB_SPIN_CAP (1u << 24)
#define LAS __attribute__((address_space(3)))
DEVI unsigned xb_ld(unsigned* p) { return __hip_atomic_load(p, __ATOMIC_RELAXED, __HIP_MEMORY_SCOPE_AGENT); }
DEVI unsigned xb_add(unsigned* p, unsigned v) { return __hip_atomic_fetch_add(p, v, __ATOMIC_RELAXED, __HIP_MEMORY_SCOPE_AGENT); }
DEVI unsigned xb_xcc_id() { return (unsigned)__builtin_amdgcn_s_getreg((3 << 11) | 20) & 0xFu; }
#define XB_SPIN(cond, bar) do { unsigned _sp = 0; while (cond) { __builtin_amdgcn_s_sleep(1); \
    if ((++_sp & 255u) == 0u) { if (xb_ld(&(bar)[XB_TMO])) break; if (_sp > XB_SPIN_CAP) { atomicAdd(&(bar)[XB_TMO], 1u); break; } } } } while (0)
struct XcdBarrier { unsigned* bar; unsigned x; volatile LAS unsigned* st; };
DEVI XcdBarrier xcd_barrier_post(unsigned* bar, volatile LAS unsigned* st) {
  XcdBarrier b; b.bar = bar; b.x = xb_xcc_id(); b.st = st;
  if (threadIdx.x == 0) (void)xb_add(&bar[XB_XCNT(b.x)], 1u);
  return b;
}
DEVI void xcd_barrier_complete(unsigned* bar, unsigned x, unsigned& nloc, unsigned& nx) {
  const unsigned G = gridDim.x * gridDim.y * gridDim.z;
  unsigned sum, cnt, mine, sp = 0u;
  for (;;) {
    sum = 0u; cnt = 0u; mine = 0u;
#pragma unroll
    for (unsigned j = 0; j < 16; ++j) { const unsigned c = xb_ld(&bar[XB_XCNT(j)]); sum += c; cnt += (c > 0u) ? 1u : 0u; mine = (j == x) ? c : mine; }
    if (sum == G) break;
    __builtin_amdgcn_s_sleep(1);
    if ((++sp & 255u) == 0u) { if (xb_ld(&bar[XB_TMO])) break; if (sp > XB_SPIN_CAP) { atomicAdd(&bar[XB_TMO], 1u); break; } }
  }
  nloc = mine > 0u ? mine : 1u; nx = cnt > 0u ? cnt : 1u;
}
DEVI void xcd_barrier(const XcdBarrier& b) {
  asm volatile("s_waitcnt vmcnt(0)" ::: "memory");
  __syncthreads();
  if (threadIdx.x == 0) {
    unsigned* bar = b.bar;
    __builtin_amdgcn_s_waitcnt(0);
    unsigned nloc = b.st[0], nx = b.st[1];
    if (nloc == 0u) { xcd_barrier_complete(bar, b.x, nloc, nx); b.st[0] = nloc; b.st[1] = nx; }
    const unsigned old = xb_add(&bar[XB_XSUB(b.x)], 1u);
    const unsigned gen = old / nloc;
    if (old + 1u == (gen + 1u) * nloc) {
      __builtin_amdgcn_fence(__ATOMIC_RELEASE, "agent");
      asm volatile("s_waitcnt vmcnt(0)" ::: "memory");
      const unsigned og = xb_add(&bar[XB_TOP], 1u);
      const unsigned tg = og / nx;
      if (og + 1u == (tg + 1u) * nx) xb_add(&bar[XB_TOPGEN], 1u);
      else XB_SPIN(xb_ld(&bar[XB_TOPGEN]) == tg, bar);
      __builtin_amdgcn_fence(__ATOMIC_ACQUIRE, "agent");
      xb_add(&bar[XB_XGEN(b.x)], 1u);
      asm volatile("s_waitcnt vmcnt(0)" ::: "memory");
    } else {
      XB_SPIN(xb_ld(&bar[XB_XGEN(b.x)]) == gen, bar);
      __builtin_amdgcn_fence(__ATOMIC_ACQUIRE, "agent");
      asm volatile("s_waitcnt vmcnt(0)" ::: "memory");
    }
  }
  __syncthreads();
}

DEVI void sub_barrier(unsigned* word, unsigned expected) {
  asm volatile("s_waitcnt vmcnt(0)" ::: "memory");
  __syncthreads();
  if (threadIdx.x == 0) {
    __builtin_amdgcn_fence(__ATOMIC_RELEASE, "agent");
    asm volatile("s_waitcnt vmcnt(0)" ::: "memory");
    xb_add(word, 1u);
    unsigned sp = 0;
    while (xb_ld(word) < expected) { __builtin_amdgcn_s_sleep(1); if (++sp > XB_SPIN_CAP) break; }
    __builtin_amdgcn_fence(__ATOMIC_ACQUIRE, "agent");
    asm volatile("s_waitcnt vmcnt(0)" ::: "memory");
  }
  __syncthreads();
}

#ifndef PROBE_RW
#define PROBE_RW 0
#endif
#ifndef PROBE_GD
#define PROBE_GD 0
#endif
#ifndef PROBE_HY
#define PROBE_HY 0
#endif
#ifndef REP_HYPREP
#define REP_HYPREP 1
#endif
#ifndef REP_POST
#define REP_POST 1
#endif
#ifndef REP_ATT
#define REP_ATT 1
#endif
#ifndef REP_NORM
#define REP_NORM 1
#endif
#ifndef REP_P0
#define REP_P0 1
#endif
#ifndef REP_SYNC
#define REP_SYNC 0
#endif
#ifndef REP_MIX
#define REP_MIX 1
#endif
#ifndef REP_G1
#define REP_G1 1
#endif
#ifndef EN_HY
#define EN_HY 1
#endif
#ifndef EN_RW
#define EN_RW 1
#endif
#ifndef EN_GD
#define EN_GD 1
#endif
#ifndef EN_XA
#define EN_XA 1
#endif

__global__ void __launch_bounds__(NTHR, 2) fwd_megakernel(Params p_unused) {
  __shared__ __attribute__((aligned(16))) char smem[SMEM_BYTES];
  const KP kp0 = (KP)__builtin_amdgcn_kernarg_segment_ptr();
#define p (opqk(kp0))
  cg::grid_group grid = cg::this_grid();
  __shared__ uint4 xb_words;
  if (threadIdx.x == 0) xb_words = make_uint4(0u, 0u, 0u, 0u);
  __syncthreads();
  const XcdBarrier xb = xcd_barrier_post((unsigned*)(kp0->ws + OFF_BAR), (volatile LAS unsigned*)&xb_words);
  const int bid = blockIdx.x, nb = gridDim.x;
#define ws (p->ws)
#define WA ((u16*)(ws + OFF_WA))
#define WB ((u16*)(ws + OFF_WB))
#define WKV ((u16*)(ws + OFF_WKV))
#define MEMN ((u16*)(ws + OFF_MEMN))
#define HN ((u16*)(ws + OFF_HN))
#define BIG ((u16*)(ws + OFF_BIG))
#define X (p->out)

  {
  for (int l = 0; l < 2; ++l) {
    convert_phase(p->in[I_WK] + (size_t)l * DM * DM, nullptr, DM, DM, DM, WKV + (size_t)(l * 2 + 0) * DM * DM, smem, bid, nb);
    convert_phase(p->in[I_WV] + (size_t)l * DM * DM, nullptr, DM, DM, DM, WKV + (size_t)(l * 2 + 1) * DM * DM, smem, bid, nb);
  }
  rmsnorm_phase<false>(p->in[I_MEM], p->in[I_MEMNORM], MEMN, 1024, bid, nb);
  hyfilter_phase(p, smem, bid, nb);
  if (gridDim.x == 0x7fffffffu) grid.sync();
  xcd_barrier(xb);
  for (int l = 0; l < 2; ++l) {
    run_gemm(smem, MEMN, WKV + (size_t)(l * 2 + 0) * DM * DM, 1024, 1024, DM,
             pg8::EpiBf16{(u16*)(ws + OFF_KM) + (size_t)l * DM * DM, DM, DM}, bid, (l * 32) % nb, 16);
    run_gemm(smem, WKV + (size_t)(l * 2 + 1) * DM * DM, MEMN, 1024, 1024, DM,
             pg8::EpiBf16{(u16*)(ws + OFF_VT) + (size_t)l * DM * DM, DM, DM}, bid, (l * 32 + 16) % nb, 16);
  }
  hynorm_phase(p, smem, (bid + nb - 64 % nb) % nb, nb);
  xcd_barrier(xb);
  }
  for (int rs_ = 0; rs_ < REP_SYNC; ++rs_) xcd_barrier(xb);

  for (int l = 0; l < 2; ++l) {
    const float* xin = (l == 0) ? p->in[I_X] : X;
    rmsnorm_phase<false>(xin, p->in[I_NFFN1] + l * DM, HN, T_, bid, nb);
    convert_phase(p->in[I_F1W1] + (size_t)l * DM * DFF, p->in[I_F1W3] + (size_t)l * DM * DFF, DM, 2 * DFF, 2 * DFF, WA, smem, bid, nb);
    convert_phase(p->in[I_F1W2] + (size_t)l * DFF * DM, nullptr, DFF, DM, DM, WB, smem, bid, nb);
    xcd_barrier(xb);
    for (int rep_ = 0; rep_ < REP_G1; ++rep_) {
      run_gemm(smem, HN, WA, T_, 2 * DFF, DM, pg8::EpiSwiglu{BIG, DFF}, bid, 0, nb);
      xcd_barrier(xb);
    }
    run_gemm(smem, BIG, WB, T_, DM, DFF, pg8::EpiResid{X, xin, 0.5f}, bid, 0, nb);
    xcd_barrier(xb);
    rmsnorm_phase<false>(X, p->in[I_NMIX] + l * DM, HN, T_, bid, nb);
    convert_phase(p->in[I_WIN] + (size_t)l * DM * INC, nullptr, DM, INC, INCP, WA, smem, bid, nb);
    convert_phase(p->in[I_WOUT] + (size_t)l * DM * DM, nullptr, DM, DM, DM, WB, smem, bid, nb);
    convert_phase(p->in[I_GLORA] + (size_t)l * 128 * 384, nullptr, 128, 384, 384, WKV, smem, (bid + 128) % nb, nb);
    xcd_barrier(xb);
    run_gemm(smem, HN, WA, T_, INCP, DM, pg8::EpiBf16{BIG, INC, INC}, bid, 0, nb);
    xcd_barrier(xb);
    const bool hy_own_prep = (nb == 256);
    if (!hy_own_prep) {
      hyprep_phase(p, l, smem, bid, nb);
      xcd_barrier(xb);
    }
    for (int rep_ = 0; rep_ < REP_MIX; ++rep_) {
      if (rep_ > 0) xcd_barrier(xb);
      const int t5 = otid();
      const int half = t5 >> 8, tl5 = t5 & 255;
      char* hsm = smem + half * SCAN_SMEM;
      for (int r = bid; r < 256; r += nb) {
        if (r < 192) {
          const int q_ = (r < 96) ? r : r - 96;
          const int it_ = (((q_ >> 4) * 8 + (q_ & 7)) << 1) | ((q_ >> 3) & 1);
          if (r < 96) rwscan_pc_item(p, l, it_, smem);
          else gdscan_pc_item(p, l, it_, smem);
        }
        else if (EN_HY) {
          if (hy_own_prep) {
            hyprep_phase(p, l, smem, r - 192, 64);
            sub_barrier((unsigned*)(ws + OFF_BAR) + 3520 + 64 * l, 64u);
          }
          for (int c = r - 192; c < 256; c += 64) hyconv_item(p, l, c, smem);
        }
      }
    }
    xcd_barrier(xb);
    for (int rep_ = 0; rep_ < REP_POST; ++rep_) {
      {
        const bool sl_ = (nb == 256);
        const int it0_ = sl_ ? (64 * (bid & 7) + 2 * (bid >> 3)) : bid;
        const int its_ = sl_ ? 1 : nb;
        const int itn_ = sl_ ? 2 : 512;
#pragma unroll 1
        for (int k_ = 0; k_ < itn_; ++k_) {
          const int it = it0_ + k_ * its_;
          if (it >= 512) break;
          post_tok_item(p, l, it, smem);
        }
      }
      xcd_barrier(xb);
    }
    run_gemm(smem, HN, WB, T_, DM, DM, pg8::EpiResid{X, X, 1.0f}, bid, 0, nb);
    xcd_barrier(xb);
    for (int rep_ = 0; rep_ < REP_NORM; ++rep_)
    rmsnorm_phase<false>(X, p->in[I_NXA] + l * DM, HN, T_, bid, nb);
    convert_phase(p->in[I_WQ] + (size_t)l * DM * DM, nullptr, DM, DM, DM, WA, smem, bid, nb);
    convert_phase(p->in[I_WO] + (size_t)l * DM * DM, nullptr, DM, DM, DM, WB, smem, bid, nb);
    xcd_barrier(xb);
#if EN_XA
    run_gemm(smem, HN, WA, T_, DM, DM, pg8::EpiBf16{BIG, DM, DM}, bid, 0, nb);
    xcd_barrier(xb);
    for (int rep_ = 0; rep_ < REP_ATT; ++rep_) {
      attn_phase(p, l, smem, bid, nb);
      xcd_barrier(xb);
    }
    run_gemm(smem, HN, WB, T_, DM, DM, pg8::EpiResid{X, X, 1.0f}, bid, 0, nb);
    xcd_barrier(xb);
#endif
    rmsnorm_phase<false>(X, p->in[I_NFFN2] + l * DM, HN, T_, bid, nb);
    convert_phase(p->in[I_F2W1] + (size_t)l * DM * DFF, p->in[I_F2W3] + (size_t)l * DM * DFF, DM, 2 * DFF, 2 * DFF, WA, smem, bid, nb);
    convert_phase(p->in[I_F2W2] + (size_t)l * DFF * DM, nullptr, DFF, DM, DM, WB, smem, bid, nb);
    xcd_barrier(xb);
    for (int rep_ = 0; rep_ < REP_G1; ++rep_) {
      run_gemm(smem, HN, WA, T_, 2 * DFF, DM, pg8::EpiSwiglu{BIG, DFF}, bid, 0, nb);
      xcd_barrier(xb);
    }
    run_gemm(smem, BIG, WB, T_, DM, DFF, pg8::EpiResid{X, X, 0.5f}, bid, 0, nb);
    xcd_barrier(xb);
  }
  rmsnorm_phase<true>(X, p->in[I_NFINAL], X, T_, bid, nb);
#undef p
#undef ws
#undef WA
#undef WB
#undef WKV
#undef MEMN
#undef HN
#undef BIG
#undef X
}

extern "C" void kernel_launch(void* const* d_in, const int* in_sizes, int n_in, void* d_out, int out_size, void* d_ws,
                              size_t ws_size, hipStream_t stream) {
  static int grid_blocks = 0;
  if (!grid_blocks) {
    int dev = 0, cus = 0, per_cu = 0;
    (void)hipGetDevice(&dev);
    (void)hipDeviceGetAttribute(&cus, hipDeviceAttributeMultiprocessorCount, dev);
    (void)hipOccupancyMaxActiveBlocksPerMultiprocessor(&per_cu, fwd_megakernel, NTHR, 0);
    if (per_cu != 1) per_cu = 1;
    grid_blocks = cus * per_cu;
  }
  Params p{};
  for (int i = 0; i < 46; ++i) p.in[i] = (const float*)d_in[i];
  p.out = (float*)d_out;
  p.ws = (char*)d_ws;
  (void)hipMemsetAsync((char*)d_ws + OFF_BAR, 0, 16384, stream);
  void* args[] = {&p};
  hipError_t e = hipLaunchCooperativeKernel((void*)fwd_megakernel, dim3(grid_blocks), dim3(NTHR), args, 0, stream);
  if (e != hipSuccess) fprintf(stderr, "cooperative launch failed: %s (grid %d)\n", hipGetErrorString(e), grid_blocks);
}
```

```cpp
#include <hip/hip_runtime.h>
#include <hip/hip_bf16.h>
#include <hip/hip_cooperative_groups.h>
#include <cstdio>
namespace cg = cooperative_groups;

typedef unsigned short u16;
using bf16x8 = __attribute__((ext_vector_type(8))) short;
using f32x4 = __attribute__((ext_vector_type(4))) float;

#define DEVI __device__ __forceinline__

constexpr int T_ = 32768, L_ = 8192, NB_ = 4, DM = 1024, DFF = 2816, INC = 3864, INCP = 4096;
constexpr int NTHR = 512, NWV = NTHR / 64;

constexpr size_t OFF_WA = 0;
constexpr size_t OFF_WB = OFF_WA + 11534336;
constexpr size_t OFF_WKV = OFF_WB + 5767168;
constexpr size_t OFF_MEMN = OFF_WKV + 8388608;
constexpr size_t OFF_KM = OFF_MEMN + 2097152;
constexpr size_t OFF_VT = OFF_KM + 4194304;
constexpr size_t OFF_RK = OFF_VT + 4194304;
constexpr size_t OFF_UB = OFF_RK + 16777216;
constexpr size_t OFF_YC = OFF_UB + 20971520;
constexpr size_t OFF_HN = OFF_YC + 16777216;
constexpr size_t OFF_YRW = OFF_HN + 67108864;
constexpr size_t OFF_YGD = OFF_YRW + 50331648;
constexpr size_t OFF_BIG = OFF_YGD + 50331648;
constexpr size_t OFF_BAR = OFF_BIG + 253231104;
constexpr size_t OFF_X0 = OFF_BAR + 16384;
constexpr int UBS = 10240;
constexpr int SCAN_SMEM = 75776;
constexpr int SMEM_BYTES = 2 * SCAN_SMEM;

struct Params {
  const float* in[46];
  float* out;
  char* ws;
};

typedef const __attribute__((address_space(4))) Params* KP;
DEVI KP opqk(KP k) { asm volatile("" : "+s"(k)); return k; }

enum {
  I_X = 0, I_MEM, I_NFFN1, I_F1W1, I_F1W3, I_F1W2, I_NMIX, I_WIN, I_WOUT, I_HYCW, I_HYCB, I_HYFREQ, I_HYW1, I_HYB1,
  I_HYW2, I_HYB2, I_HYW3, I_HYDEC, I_HYBIAS, I_MUP, I_MUN, I_WLORA, I_W0, I_ALORA, I_A0, I_GLORA, I_KK, I_KA, I_RK,
  I_GNW, I_GNB, I_GCW, I_GALOG, I_GDT, I_GNORM, I_NXA, I_WQ, I_WK, I_WV, I_WO, I_MEMNORM, I_NFFN2, I_F2W1, I_F2W3,
  I_F2W2, I_NFINAL
};

typedef __bf16 bf16x2_t __attribute__((ext_vector_type(2)));
DEVI unsigned cvtpk(float lo, float hi) { bf16x2_t v = {(__bf16)lo, (__bf16)hi}; return __builtin_bit_cast(unsigned, v); }
DEVI u16 f2bf(float f) { return (u16)(cvtpk(f, 0.f) & 0xffffu); }
DEVI float frcp(float x) { return __builtin_amdgcn_rcpf(x); }
DEVI float bf2f(u16 h) { return __uint_as_float(((unsigned)h) << 16); }
DEVI float bflo(unsigned v) { return __uint_as_float(v << 16); }
DEVI float bfhi(unsigned v) { return __uint_as_float(v & 0xffff0000u); }
DEVI unsigned pack2(float a, float b) { return cvtpk(a, b); }
DEVI float sigm(float x) { return frcp(1.f + __expf(-x)); }
DEVI float siluf(float x) { return x * frcp(1.f + __expf(-x)); }

DEVI void unpack8(uint4 v, float* f) {
  f[0] = bflo(v.x); f[1] = bfhi(v.x); f[2] = bflo(v.y); f[3] = bfhi(v.y);
  f[4] = bflo(v.z); f[5] = bfhi(v.z); f[6] = bflo(v.w); f[7] = bfhi(v.w);
}
DEVI uint4 pack8(const float* f) {
  uint4 v; v.x = pack2(f[0], f[1]); v.y = pack2(f[2], f[3]); v.z = pack2(f[4], f[5]); v.w = pack2(f[6], f[7]);
  return v;
}

template <int CTRL> DEVI float dppf(float x) {
  return __int_as_float(__builtin_amdgcn_update_dpp(0, __float_as_int(x), CTRL, 0xf, 0xf, true));
}
DEVI float allsum16(float x) {
  x += dppf<0xB1>(x);
  x += dppf<0x4E>(x);
  x += dppf<0x141>(x);
  x += dppf<0x140>(x);
  return x;
}
DEVI float allsum8(float x) {
  x += dppf<0xB1>(x);
  x += dppf<0x4E>(x);
  x += dppf<0x141>(x);
  return x;
}
DEVI int otid() { int t = threadIdx.x; asm volatile("" : "+v"(t)); return t; }
template <class Tp> DEVI const Tp* opq(const Tp* p) { asm volatile("" : "+v"(p)); return p; }
typedef float f32x2 __attribute__((ext_vector_type(2)));
DEVI float dot4(float s0, float s1, float s2, float s3, const float4& k) {
  f32x2 t = f32x2{s0, s1} * f32x2{k.x, k.y};
  t = __builtin_elementwise_fma(f32x2{s2, s3}, f32x2{k.z, k.w}, t);
  return t.x + t.y;
}
DEVI float wavesum(float x) {
  for (int o = 32; o > 0; o >>= 1) x += __shfl_xor(x, o, 64);
  return x;
}

DEVI void convert_phase(const float* __restrict__ W0, const float* __restrict__ W1, int K, int N, int Npad,
                              u16* __restrict__ Wt, char* smem, int bid, int nb) {
  float* tile = (float*)smem;
  const int tid = otid();
  const int kt = K / 64;
  const int ntiles = (Npad / 64) * kt;
  const int NW = W1 ? N / 2 : N;
  for (int t = bid; t < ntiles; t += nb) {
    const int n0 = (t / kt) * 64, k0 = (t % kt) * 64;
#pragma unroll 4
    for (int i = 0; i < 64 / NWV; ++i) {
      int kk = i * NWV + (tid >> 6), nn = tid & 63, R = n0 + nn;
      float v = 0.f;
      if (R < N) {
        if (W1) {
          int g = R >> 5, wi = R & 31;
          const float* src = (wi < 16) ? W0 : W1;
          v = src[(size_t)(k0 + kk) * NW + g * 16 + (wi & 15)];
        } else {
          v = W0[(size_t)(k0 + kk) * NW + R];
        }
      }
      tile[kk * 65 + nn] = v;
    }
    __syncthreads();
#pragma unroll 4
    for (int i = 0; i < 64 / NWV; ++i) {
      int nn = i * NWV + (tid >> 6), kk = tid & 63;
      Wt[(size_t)(n0 + nn) * K + k0 + kk] = f2bf(tile[kk * 65 + nn]);
    }
    __syncthreads();
  }
}

template <bool OUT_F32>
DEVI void rmsnorm_phase(const float* __restrict__ x, const float* __restrict__ g, void* outp, int rows, int bid,
                              int nb) {
  const int tid_ = otid();
  const int lane = tid_ & 63, wv = tid_ >> 6;
  for (int r = bid * NWV + wv; r < rows; r += nb * NWV) {
    const float* xr = x + (size_t)r * DM;
    float4 v[4];
    float ss = 0.f;
#pragma unroll
    for (int i = 0; i < 4; ++i) {
      v[i] = *(const float4*)(xr + i * 256 + lane * 4);
      ss += v[i].x * v[i].x + v[i].y * v[i].y + v[i].z * v[i].z + v[i].w * v[i].w;
    }
    ss = wavesum(ss);
    const float sc = rsqrtf(ss * (1.f / DM) + 1e-6f);
#pragma unroll
    for (int i = 0; i < 4; ++i) {
      float4 gg = *(const float4*)(g + i * 256 + lane * 4);
      float a = v[i].x * sc * gg.x, b = v[i].y * sc * gg.y, c = v[i].z * sc * gg.z, d = v[i].w * sc * gg.w;
      if (OUT_F32) {
        *(float4*)((float*)outp + (size_t)r * DM + i * 256 + lane * 4) = make_float4(a, b, c, d);
      } else {
        uint2 o; o.x = pack2(a, b); o.y = pack2(c, d);
        *(uint2*)((u16*)outp + (size_t)r * DM + i * 256 + lane * 4) = o;
      }
    }
  }
}

namespace pg8 {
#define PG8_LAS __attribute__((address_space(3)))
typedef unsigned u32x4 __attribute__((ext_vector_type(4)));
constexpr int BM = 256, BK = 64, HALF = 128, HTB = HALF * BK * 2, NXCD = 8, WGM = 8;
DEVI int lds_byte(int r, int c) { const int st = (r >> 4) * 2 + (c >> 5), rr = r & 15, cc = c & 31, ob = rr * 64 + cc * 2; return st * 1024 + (ob ^ (((ob >> 9) & 1) << 5)); }
DEVI void stage_rc(int b, int& R, int& C) { const int st = b / 1024, sb = b % 1024, swz = sb ^ (((sb >> 9) & 1) << 5); R = (st >> 1) * 16 + swz / 64; C = (st & 1) * 32 + (swz % 64) / 2; }
DEVI int perm32(int rho) { const int n = rho >> 4, i = rho & 15; return 8 * (i >> 2) + 4 * n + (i & 3); }
struct Unit { int pm, pn; };
struct Gemm { const u16* A; const u16* Bt; int M, N, K; };
struct StaticOrder {
  int nM, nN, nwg, G, c;
  DEVI void init(int M, int N, int G_, int c_) { nM = M / BM; nN = N / BM; nwg = nM * nN; G = G_; c = c_; }
  DEVI bool next(int i, Unit& u) const {
    const long L = (long)i * G + c; if (L >= nwg) return false;
    int wgid = (int)L; { const int q = nwg / NXCD, r = nwg % NXCD, xcd = wgid % NXCD, off = wgid / NXCD; wgid = (xcd < r ? xcd * (q + 1) : r * (q + 1) + (xcd - r) * q) + off; }
    const int nig = WGM * nN, gid = wgid / nig, fm = gid * WGM, gsz = (nM - fm) < WGM ? (nM - fm) : WGM;
    u.pm = fm + ((wgid % nig) % gsz); u.pn = (wgid % nig) / gsz; return true;
  }
};
DEVI unsigned cvt_pk_bf16(float lo, float hi) { return cvtpk(lo, hi); }

struct EpiBf16 {
  static constexpr bool PERM = true;
  u16* O; int ldc; int N;
  DEVI void operator()(const f32x4 (&acc)[2][2][4][2], const Unit& u, int wr, int wc, int fr, int fq) const {
    const int row0 = u.pm * BM + wr * 64 + fr, col0 = u.pn * BM + wc * 32 + 8 * fq;
#pragma unroll
    for (int ai = 0; ai < 2; ++ai)
#pragma unroll
      for (int m = 0; m < 4; ++m) {
        u16* rowp = O + (size_t)(row0 + ai * HALF + m * 16) * ldc + col0;
#pragma unroll
        for (int bj = 0; bj < 2; ++bj) {
          const f32x4 v0 = acc[ai][bj][m][0], v1 = acc[ai][bj][m][1];
          u32x4 w; w.x = cvt_pk_bf16(v0[0], v0[1]); w.y = cvt_pk_bf16(v0[2], v0[3]); w.z = cvt_pk_bf16(v1[0], v1[1]); w.w = cvt_pk_bf16(v1[2], v1[3]);
          if (col0 + bj * HALF < N) *(u32x4*)(rowp + bj * HALF) = w;
        }
      }
  }
};
struct EpiSwiglu {
  static constexpr bool PERM = false;
  u16* U; int ldu;
  DEVI void operator()(const f32x4 (&acc)[2][2][4][2], const Unit& u, int wr, int wc, int fr, int fq) const {
    const int row0 = u.pm * BM + wr * 64 + fr;
#pragma unroll
    for (int ai = 0; ai < 2; ++ai)
#pragma unroll
      for (int m = 0; m < 4; ++m) {
        u16* rowp = U + (size_t)(row0 + ai * HALF + m * 16) * ldu;
#pragma unroll
        for (int bj = 0; bj < 2; ++bj) {
          const int g32 = (u.pn * BM + bj * HALF + wc * 32) >> 5;
          const f32x4 a = acc[ai][bj][m][0], b = acc[ai][bj][m][1];
          uint2 w;
          w.x = cvt_pk_bf16(siluf(a[0]) * b[0], siluf(a[1]) * b[1]);
          w.y = cvt_pk_bf16(siluf(a[2]) * b[2], siluf(a[3]) * b[3]);
          *(uint2*)(rowp + g32 * 16 + 4 * fq) = w;
        }
      }
  }
};
struct EpiResid {
  static constexpr bool PERM = false;
  float* X; const float* Xin; float scale;
  DEVI void operator()(const f32x4 (&acc)[2][2][4][2], const Unit& u, int wr, int wc, int fr, int fq) const {
    const int row0 = u.pm * BM + wr * 64 + fr, col0 = u.pn * BM + wc * 32 + 4 * fq;
#pragma unroll
    for (int ai = 0; ai < 2; ++ai)
#pragma unroll
      for (int m = 0; m < 4; ++m) {
        const size_t ro = (size_t)(row0 + ai * HALF + m * 16) * DM + col0;
#pragma unroll
        for (int bj = 0; bj < 2; ++bj)
#pragma unroll
          for (int n = 0; n < 2; ++n) {
            const f32x4 xi = *(const f32x4*)(Xin + ro + bj * HALF + n * 16);
            *(f32x4*)(X + ro + bj * HALF + n * 16) = xi + acc[ai][bj][m][n] * scale;
          }
      }
  }
};

template <class Epi>
DEVI void gemm_phase(PG8_LAS unsigned char* lds, const Gemm g, const StaticOrder& S, const Epi& E) {
  const int tid = otid(), wid = __builtin_amdgcn_readfirstlane(tid >> 6), lane = tid & 63, wr = wid >> 2, wc = wid & 3, fr = lane & 15, fq = lane >> 4;
  const int K = g.K, nt = K / BK;
  unsigned voffA[2], voffB[2];
#pragma unroll
  for (int i = 0; i < 2; ++i) { int R, C; stage_rc(tid * 16 + i * 8192, R, C); const int Rb = Epi::PERM ? ((R & ~31) + perm32(R & 31)) : R;
    voffA[i] = (unsigned)(R * K + C) * 2u; voffB[i] = (unsigned)(Rb * K + C) * 2u; }
  const size_t kstep = (size_t)(BK * 2);
  const size_t hstep = (size_t)HALF * K * 2;
  const size_t tstep = 2 * hstep;
  const unsigned ldsw = (unsigned)wid * 1024u;
  const int aoff = lds_byte(wr * 64 + fr, fq * 8), boff = lds_byte(wc * 32 + fr, fq * 8);
#define PG8_SA(b, h) (((b) * 2 + (h)) * HTB)
#define PG8_SB(b, h) ((4 + (b) * 2 + (h)) * HTB)
#define PG8_STAGE(bufoff, gbase, voff) do { _Pragma("unroll") for (int _i = 0; _i < 2; ++_i) \
    __builtin_amdgcn_global_load_lds((const unsigned*)((const char*)(gbase) + (voff)[_i]), (PG8_LAS unsigned*)(lds + (bufoff) + ldsw + _i * 8192), 16, 0, 0); } while (0)
#define PG8_LDA(dst, b, h) do { _Pragma("unroll") for (int m = 0; m < 4; ++m) _Pragma("unroll") for (int k = 0; k < 2; ++k) dst[m][k] = *(const PG8_LAS bf16x8*)(lds + PG8_SA(b, h) + aoff + m * 2048 + k * 1024); } while (0)
#define PG8_LDB(dst, b, h) do { _Pragma("unroll") for (int n = 0; n < 2; ++n) _Pragma("unroll") for (int k = 0; k < 2; ++k) dst[n][k] = *(const PG8_LAS bf16x8*)(lds + PG8_SB(b, h) + boff + n * 2048 + k * 1024); } while (0)
#define PG8_MMA(ai, bj, At, Bt) do { __builtin_amdgcn_s_setprio(1); _Pragma("unroll") for (int m = 0; m < 4; ++m) _Pragma("unroll") for (int n = 0; n < 2; ++n) _Pragma("unroll") for (int k = 0; k < 2; ++k) \
    acc[ai][bj][m][n] = __builtin_amdgcn_mfma_f32_16x16x32_bf16(Bt[n][k], At[m][k], acc[ai][bj][m][n], 0, 0, 0); __builtin_amdgcn_s_setprio(0); } while (0)
#define PG8_WAIT_V(n) asm volatile("s_waitcnt vmcnt(" #n ")" ::: "memory")
#define PG8_WAIT_L(n) asm volatile("s_waitcnt lgkmcnt(" #n ")" ::: "memory")
#define PG8_BAR __builtin_amdgcn_s_barrier()
#define PG8_SCHED __builtin_amdgcn_sched_barrier(0)
  Unit cur, nxt; int ui = 0;
  if (!S.next(0, cur)) return;
  f32x4 acc[2][2][4][2];
#pragma unroll
  for (int a = 0; a < 2; ++a)
#pragma unroll
    for (int b = 0; b < 2; ++b)
#pragma unroll
      for (int m = 0; m < 4; ++m)
#pragma unroll
        for (int n = 0; n < 2; ++n) acc[a][b][m][n] = (f32x4){0.f, 0.f, 0.f, 0.f};
  bf16x8 At[4][2], B0[2][2], B1[2][2];
  const char* cA = (const char*)g.A + (size_t)cur.pm * tstep; const char* cB = (const char*)g.Bt + (size_t)cur.pn * tstep;
  PG8_STAGE(PG8_SB(0, 0), cB, voffB); PG8_STAGE(PG8_SA(0, 0), cA, voffA); PG8_STAGE(PG8_SB(0, 1), cB + hstep, voffB); PG8_STAGE(PG8_SA(0, 1), cA + hstep, voffA);
  if (wr == 1) PG8_BAR;
  PG8_WAIT_V(4); PG8_BAR;
  PG8_STAGE(PG8_SB(1, 0), cB + kstep, voffB); PG8_STAGE(PG8_SA(1, 0), cA + kstep, voffA); PG8_STAGE(PG8_SB(1, 1), cB + hstep + kstep, voffB);
  PG8_WAIT_V(6); PG8_BAR;
  for (;;) {
    const bool has_next = S.next(ui + 1, nxt);
    const char* nA = has_next ? (const char*)g.A + (size_t)nxt.pm * tstep : cA; const char* nB = has_next ? (const char*)g.Bt + (size_t)nxt.pn * tstep : cB;
    for (int t = 0; t < nt; t += 2) {
      const bool last = (t == nt - 2);
      const char* a1 = cA + (size_t)(t + 1) * kstep;
      const char* a2 = last ? nA : cA + (size_t)(t + 2) * kstep; const char* b2 = last ? nB : cB + (size_t)(t + 2) * kstep;
      const char* a3 = a2 + kstep; const char* b3 = b2 + kstep;
      PG8_LDB(B0, 0, 0); PG8_SCHED; PG8_LDA(At, 0, 0); PG8_STAGE(PG8_SA(1, 1), a1 + hstep, voffA);
      PG8_WAIT_L(8); PG8_BAR; PG8_WAIT_L(0); PG8_MMA(0, 0, At, B0); PG8_BAR; PG8_SCHED;
      PG8_LDB(B1, 0, 1); PG8_STAGE(PG8_SB(0, 0), b2, voffB);
      PG8_BAR; PG8_WAIT_L(0); PG8_MMA(0, 1, At, B1); PG8_BAR;
      PG8_LDA(At, 0, 1); PG8_STAGE(PG8_SA(0, 0), a2, voffA);
      PG8_BAR; PG8_WAIT_L(0); PG8_MMA(1, 0, At, B0); PG8_BAR; PG8_SCHED;
      PG8_STAGE(PG8_SB(0, 1), b2 + hstep, voffB);
      PG8_WAIT_V(6); PG8_BAR; PG8_MMA(1, 1, At, B1); PG8_BAR;
      PG8_LDB(B0, 1, 0); PG8_SCHED; PG8_LDA(At, 1, 0); PG8_STAGE(PG8_SA(0, 1), a2 + hstep, voffA);
      PG8_WAIT_L(8); PG8_BAR; PG8_WAIT_L(0); PG8_MMA(0, 0, At, B0); PG8_BAR; PG8_SCHED;
      PG8_LDB(B1, 1, 1); PG8_STAGE(PG8_SB(1, 0), b3, voffB);
      PG8_BAR; PG8_WAIT_L(0); PG8_MMA(0, 1, At, B1); PG8_BAR;
      PG8_LDA(At, 1, 1); PG8_STAGE(PG8_SA(1, 0), a3, voffA);
      PG8_BAR; PG8_WAIT_L(0); PG8_MMA(1, 0, At, B0); PG8_BAR; PG8_SCHED;
      PG8_STAGE(PG8_SB(1, 1), b3 + hstep, voffB);
      PG8_WAIT_V(6); PG8_BAR; PG8_MMA(1, 1, At, B1); PG8_BAR;
    }
    E(acc, cur, wr, wc, fr, fq);
    if (!has_next) break;
#pragma unroll
    for (int a = 0; a < 2; ++a)
#pragma unroll
      for (int b = 0; b < 2; ++b)
#pragma unroll
        for (int m = 0; m < 4; ++m)
#pragma unroll
          for (int n = 0; n < 2; ++n) acc[a][b][m][n] = (f32x4){0.f, 0.f, 0.f, 0.f};
    cur = nxt; cA = nA; cB = nB; ++ui;
  }
  PG8_WAIT_V(0);
  if (wr == 0) PG8_BAR;
  PG8_BAR;
#undef PG8_SA
#undef PG8_SB
#undef PG8_STAGE
#undef PG8_LDA
#undef PG8_LDB
#undef PG8_MMA
#undef PG8_WAIT_V
#undef PG8_WAIT_L
#undef PG8_BAR
#undef PG8_SCHED
}
}

template <class Epi>
DEVI void run_gemm(char* smem, const u16* A, const u16* Bt, int M, int N, int K, const Epi& E, int bid, int b0, int G) {
  pg8::StaticOrder S;
  const int c = (bid >= b0 && bid < b0 + G) ? (bid - b0) : (1 << 28);
  S.init(M, N, G, c);
  pg8::Gemm g{A, Bt, M, N, K};
  pg8::gemm_phase<Epi>((PG8_LAS unsigned char*)smem, g, S, E);
}

DEVI void hyfilter_phase(KP p, char* smem, int bid, int nb) {
  float* z = (float*)smem;
  float* h1 = z + 16 * 33;
  float* h2 = h1 + 16 * 64;
  float* HRAW = (float*)(p->ws + OFF_YRW);
  const int tid = otid();
  for (int it = bid; it < 2 * 512; it += nb) {
    const int l = it >> 9, t0 = (it & 511) * 16;
    const float* freq = p->in[I_HYFREQ] + l * 64;
    const float* w1 = p->in[I_HYW1] + l * 33 * 64;
    const float* b1 = p->in[I_HYB1] + l * 64;
    const float* w2 = p->in[I_HYW2] + l * 64 * 64;
    const float* b2 = p->in[I_HYB2] + l * 64;
    const float* w3 = p->in[I_HYW3] + l * 64 * 512;
    const float* dec = p->in[I_HYDEC] + l * 512;
    for (int e = tid; e < 16 * 33; e += NTHR) {
      int pos = e / 33, f = e % 33;
      int i = t0 + pos;
      float v;
      if (f == 0) {
        v = (float)i / (float)(L_ - 1);
      } else {
        int m = (f - 1) & 15;
        float band = 1e-4f + (float)m * ((15.f - 1e-4f) / 15.f);
        float ang = 6.283185307179586f * (float)i / (float)L_;
        float a = band * ang;
        v = (f <= 16) ? cosf(a) : -sinf(a);
      }
      z[pos * 33 + f] = v;
    }
    __syncthreads();
    {
      const int o = tid & 63;
      const float fo = freq[o], bo = b1[o];
#pragma unroll
      for (int i = 0; i < 16 / NWV; ++i) {
        int pos = (tid >> 6) + NWV * i;
        float s = bo;
#pragma unroll 11
        for (int f = 0; f < 33; ++f) s += z[pos * 33 + f] * w1[f * 64 + o];
        h1[pos * 64 + o] = sinf(fo * s);
      }
    }
    __syncthreads();
    {
      const int o = tid & 63;
      const float fo = freq[o], bo = b2[o];
#pragma unroll
      for (int i = 0; i < 16 / NWV; ++i) {
        int pos = (tid >> 6) + NWV * i;
        float s = bo;
#pragma unroll 16
        for (int f = 0; f < 64; ++f) s += h1[pos * 64 + f] * w2[f * 64 + o];
        h2[pos * 64 + o] = sinf(fo * s);
      }
    }
    __syncthreads();
#pragma unroll 1
    for (int cc = 0; cc < 512 / NTHR; ++cc) {
      const int ch = tid + NTHR * cc;
      float acc[16];
#pragma unroll
      for (int q = 0; q < 16; ++q) acc[q] = 0.f;
#pragma unroll 8
      for (int o = 0; o < 64; ++o) {
        float w = w3[o * 512 + ch];
#pragma unroll
        for (int q = 0; q < 16; ++q) acc[q] += h2[q * 64 + o] * w;
      }
      const float dc = dec[ch];
      float* dst = HRAW + ((size_t)(l * 512 + ch)) * L_ + t0;
#pragma unroll
      for (int q = 0; q < 16; ++q) {
        float tp = (float)(t0 + q) / (float)(L_ - 1);
        dst[q] = acc[q] * __expf(-tp * dc);
      }
    }
    __syncthreads();
  }
}

DEVI void hynorm_phase(KP p, char* smem, int bid, int nb) {
  float* red = (float*)smem;
  const float* HRAW = (const float*)(p->ws + OFF_YRW);
  u16* RK = (u16*)(p->ws + OFF_RK);
  const int tid = otid();
  for (int it = bid; it < 512; it += nb) {
    const int l = it >> 8, c = it & 255;
    const float* hf = HRAW + ((size_t)(l * 512 + c)) * L_;
    const float* hb = HRAW + ((size_t)(l * 512 + 256 + c)) * L_;
    float s = 0.f;
    for (int t = tid; t < L_; t += NTHR) {
      s += fabsf(hf[t]);
      if (t > 0) s += fabsf(hb[t]);
    }
    s = wavesum(s);
    if ((tid & 63) == 0) red[tid >> 6] = s;
    __syncthreads();
    float tot = 0.f;
    for (int w = 0; w < NWV; ++w) tot += red[w];
    const float inv = 1.f / tot;
    u16* dst = RK + (size_t)it * 16384;
    for (int i = tid; i < 16384; i += NTHR) {
      int m = i - 8192;
      float v;
      if (m == -8192) v = 0.f;
      else if (m <= 0) v = hf[-m] * inv;
      else v = hb[m] * inv;
      dst[i] = f2bf(v);
    }
    __syncthreads();
  }
}

DEVI float ldP(const u16* P, int b, int t, int col) {
  return (t >= 0 && t < L_) ? bf2f(P[((size_t)(b * L_ + t)) * INC + col]) : 0.f;
}
DEVI uint4 ldrow8(const u16* P, int b, int t, int col);
DEVI void ld8f(const float* __restrict__ g, float* o);
DEVI void hyprep_phase(KP p, int l, char* smem, int bid, int nb) {
  float* tileU = (float*)smem;
  float* tileX = tileU + 64 * 65;
  const u16* P = (const u16*)(p->ws + OFF_BIG);
  u16* UB = (u16*)(p->ws + OFF_UB);
  u16* X0 = (u16*)(p->ws + OFF_X0);
  const float* cw = p->in[I_HYCW] + l * 3 * 768;
  const float* cb = p->in[I_HYCB] + l * 768;
  const int tid = otid();
  for (int it = bid; it < 2048; it += nb) {
    const int ct = it & 3, tt = (it >> 2) & 127, b = it >> 9;
    const int c0 = ct * 64, t0 = tt * 64;
    {
      const int tl = tid >> 3, cg = tid & 7, t = t0 + tl, c = c0 + cg * 8;
      float xs[3][8];
#pragma unroll
      for (int a3 = 0; a3 < 3; ++a3) {
        float pm[8], p0[8], pp[8], w0[8], w1[8], w2[8], bb[8];
        unpack8(ldrow8(P, b, t - 1, a3 * 256 + c), pm);
        unpack8(ldrow8(P, b, t, a3 * 256 + c), p0);
        unpack8(ldrow8(P, b, t + 1, a3 * 256 + c), pp);
        ld8f(cw + a3 * 256 + c, w0); ld8f(cw + 768 + a3 * 256 + c, w1); ld8f(cw + 1536 + a3 * 256 + c, w2);
        ld8f(cb + a3 * 256 + c, bb);
#pragma unroll
        for (int e = 0; e < 8; ++e) xs[a3][e] = w0[e] * pm[e] + w1[e] * p0[e] + w2[e] * pp[e] + bb[e];
      }
#pragma unroll
      for (int e = 0; e < 8; ++e) {
        tileU[tl * 65 + cg * 8 + e] = xs[1][e] * xs[2][e];
        tileX[tl * 65 + cg * 8 + e] = xs[0][e];
      }
    }
    __syncthreads();
    {
      const int cc = tid >> 3, tq = tid & 7;
      float u8[8], x8[8];
#pragma unroll
      for (int e = 0; e < 8; ++e) { u8[e] = tileU[(tq * 8 + e) * 65 + cc]; x8[e] = tileX[(tq * 8 + e) * 65 + cc]; }
      *(uint4*)(UB + ((size_t)((c0 + cc) * 4 + b)) * UBS + 1024 + t0 + tq * 8) = pack8(u8);
      *(uint4*)(X0 + ((size_t)((c0 + cc) * 4 + b)) * L_ + t0 + tq * 8) = pack8(x8);
    }
    if (tt == 0 || tt == 127) {
      const int poff = (tt == 0) ? 0 : (1024 + L_);
      for (int e = tid; e < 64 * 128; e += NTHR) {
        int cc = e >> 7, q = e & 127;
        *(uint4*)(UB + ((size_t)((c0 + cc) * 4 + b)) * UBS + poff + q * 8) = make_uint4(0, 0, 0, 0);
      }
    }
    __syncthreads();
  }
}

DEVI void hyconv_item(KP p, int l, int item, char* smem) {
  const int tid_ = otid();
  const int lane = tid_ & 63, wv = tid_ >> 6;
  const int fr = lane & 15, fq = lane >> 4;
  const int c = item, it32 = wv;
  const int a = it32 * 32;
  u16* sU = (u16*)smem;
  unsigned* sK = (unsigned*)(smem + 4 * UBS * 2);
  {
    const uint4* gu = (const uint4*)((const u16*)(p->ws + OFF_UB) + (size_t)(c * 4) * UBS);
    const uint4* gk = (const uint4*)((const u16*)(p->ws + OFF_RK) + (size_t)(l * 256 + c) * 16384);
    __syncthreads();
    for (int i = tid_; i < 4 * UBS / 8; i += NTHR) ((uint4*)sU)[i] = gu[i];
    for (int i = tid_; i < 16384 / 8; i += NTHR) ((uint4*)sK)[i] = gk[i];
    __syncthreads();
  }
  f32x4 acc[2][8];
#pragma unroll
  for (int m = 0; m < 2; ++m)
#pragma unroll
    for (int n = 0; n < 8; ++n) acc[m][n] = f32x4{0.f, 0.f, 0.f, 0.f};
#pragma unroll 1
  for (int D = a + 31; D >= a - 255; --D) {
    bf16x8 af[2];
#pragma unroll
    for (int mt = 0; mt < 2; ++mt) {
      int idx = fq * 8 - (mt * 16 + fr) - 32 * D + 8192;
      int bd = idx >> 1;
      unsigned sh = (idx & 1) * 16;
      unsigned d0 = sK[bd], d1 = sK[bd + 1], d2 = sK[bd + 2], d3 = sK[bd + 3], d4 = sK[bd + 4];
      union { unsigned u[4]; bf16x8 v; } cv;
      cv.u[0] = __builtin_amdgcn_alignbit(d1, d0, sh);
      cv.u[1] = __builtin_amdgcn_alignbit(d2, d1, sh);
      cv.u[2] = __builtin_amdgcn_alignbit(d3, d2, sh);
      cv.u[3] = __builtin_amdgcn_alignbit(d4, d3, sh);
      af[mt] = cv.v;
    }
#pragma unroll
    for (int n = 0; n < 8; ++n) {
      const int b = n >> 1, ct = n & 1;
      const int i1 = a + ct * 16 + fr;
      bf16x8 bf = *(const bf16x8*)(sU + b * UBS + 1024 + (i1 - D) * 32 + fq * 8);
      acc[0][n] = __builtin_amdgcn_mfma_f32_16x16x32_bf16(af[0], bf, acc[0][n], 0, 0, 0);
      acc[1][n] = __builtin_amdgcn_mfma_f32_16x16x32_bf16(af[1], bf, acc[1][n], 0, 0, 0);
    }
  }
  const u16* X0 = (const u16*)(p->ws + OFF_X0) + (size_t)(c * 4) * L_;
  u16* Yo = (u16*)(p->ws + OFF_HN);
  const float bias = p->in[I_HYBIAS][l * 256 + c];
#pragma unroll
  for (int n = 0; n < 8; ++n) {
    const int b = n >> 1, ct = n & 1;
    const int i1 = a + ct * 16 + fr;
#pragma unroll
    for (int mt = 0; mt < 2; ++mt) {
      const int t = i1 * 32 + mt * 16 + fq * 4;
      const uint2 xr = *(const uint2*)(X0 + (size_t)b * L_ + t);
      const uint2 ur = *(const uint2*)(sU + b * UBS + 1024 + t);
      const float x0[4] = {bflo(xr.x), bfhi(xr.x), bflo(xr.y), bfhi(xr.y)};
      const float uu[4] = {bflo(ur.x), bfhi(ur.x), bflo(ur.y), bfhi(ur.y)};
#pragma unroll
      for (int j = 0; j < 4; ++j)
        Yo[((size_t)(b * L_ + t + j)) * DM + c] = f2bf(x0[j] * (acc[mt][n][j] + bias * uu[j]));
    }
  }
}

DEVI uint4 ldrow8(const u16* P, int b, int t, int col) {
  if (t < 0 || t >= L_) return make_uint4(0, 0, 0, 0);
  return *(const uint4*)(P + ((size_t)(b * L_ + t)) * INC + col);
}
DEVI void shift8(uint4 pm, uint4 p0, uint4 pp, const float* __restrict__ mup, const float* __restrict__ mun,
                 float* out) {
  float a[8], u[8], n[8];
  unpack8(pm, a); unpack8(p0, u); unpack8(pp, n);
  float4 m0 = *(const float4*)mup, m1 = *(const float4*)(mup + 4);
  float4 n0 = *(const float4*)mun, n1 = *(const float4*)(mun + 4);
  float mp[8] = {m0.x, m0.y, m0.z, m0.w, m1.x, m1.y, m1.z, m1.w};
  float mn[8] = {n0.x, n0.y, n0.z, n0.w, n1.x, n1.y, n1.z, n1.w};
#pragma unroll
  for (int e = 0; e < 8; ++e) out[e] = u[e] + mp[e] * (a[e] - u[e]) + mn[e] * (n[e] - u[e]);
}
DEVI void ld8f(const float* __restrict__ g, float* o) {
  float4 a = *(const float4*)g, b = *(const float4*)(g + 4);
  o[0] = a.x; o[1] = a.y; o[2] = a.z; o[3] = a.w; o[4] = b.x; o[5] = b.y; o[6] = b.z; o[7] = b.w;
}
DEVI void st8f(float* s, const float* v) {
  *(float4*)s = make_float4(v[0], v[1], v[2], v[3]);
  *(float4*)(s + 4) = make_float4(v[4], v[5], v[6], v[7]);
}

DEVI float dot8(const f32x2 (&S)[4], const float4& a, const float4& b) {
  f32x2 t = S[0] * f32x2{a.x, a.y};
  f32x2 u = S[1] * f32x2{a.z, a.w};
  t = __builtin_elementwise_fma(S[2], f32x2{b.x, b.y}, t);
  u = __builtin_elementwise_fma(S[3], f32x2{b.z, b.w}, u);
  t += u;
  return t.x + t.y;
}

DEVI void rwscan_pc_item(KP p, int l, int item, char* smem) {
  const int tid = otid();
  const int lane = tid & 63, wv = tid >> 6;
  const bool cons = wv < 4;
  const int fr = lane & 15, fq = lane >> 4;
  const int rg2 = item & 1, d = (item >> 1) & 1, bh = item >> 2, h = bh % 6, b = bh / 6;
  constexpr int BUFF = 12352;
  float* s_buf = (float*)smem;
  float* s_a = s_buf + 2 * BUFF;
  u16* s_lw = (u16*)(s_a + 2048);
  u16* s_la = s_lw + 32 * 72;
  float* s_y = (float*)(s_la + 32 * 72);
  float* s_mu = s_y + 1024;
  const u16* P = (const u16*)(p->ws + OFF_BIG);
  u16* Yd = (u16*)(p->ws + OFF_YRW) + (size_t)d * T_ * 384;
  const float* mup = p->in[I_MUP] + l * 1536;
  const float* mun = p->in[I_MUN] + l * 1536;
  const int pt = tid & 255, tl = pt >> 3, jg = pt & 7, pw = wv & 3;
  const int cr = 768 + h * 64 + jg * 8, ck = 1152 + h * 64 + jg * 8, cvv = 1536 + h * 64 + jg * 8;
  const int clw = 1920 + d * 64 + jg * 8, cla = 2048 + d * 64 + jg * 8;
  bf16x8 fW[2], fA[2];
  {
    const float* Wl = p->in[I_WLORA] + (size_t)(l * 2 + d) * 64 * 384 + h * 64 + pw * 16 + fr;
    const float* Al = p->in[I_ALORA] + (size_t)(l * 2 + d) * 64 * 384 + h * 64 + pw * 16 + fr;
#pragma unroll
    for (int ks = 0; ks < 2; ++ks) {
#pragma unroll
      for (int e = 0; e < 8; ++e) {
        int r = ks * 32 + fq * 8 + e;
        fW[ks][e] = (short)f2bf(Wl[r * 384]);
        fA[ks][e] = (short)f2bf(Al[r * 384]);
      }
    }
  }
  const float w0v = p->in[I_W0][(l * 2 + d) * 384 + h * 64 + pw * 16 + fr];
  const float a0v = p->in[I_A0][(l * 2 + d) * 384 + h * 64 + pw * 16 + fr];
  for (int e = tid; e < 768; e += NTHR) {
    float v;
    if (e < 640) {
      const int a5 = (e % 320) >> 6, j = e & 63;
      const int base = (a5 < 3) ? (a5 * 384 + h * 64) : (1152 + (a5 - 3) * 128 + d * 64);
      v = ((e < 320) ? mup : mun)[base + j];
    } else {
      v = ((e < 704) ? p->in[I_KK] : p->in[I_KA])[l * 384 + h * 64 + (e & 63)];
    }
    s_mu[e] = v;
  }
  __syncthreads();
  const int row8 = lane >> 3, e8 = lane & 7;
  const int rowi = rg2 * 32 + pw * 8 + row8;
  const int j8 = e8 * 8;
  f32x2 S[4];
#pragma unroll
  for (int i = 0; i < 4; ++i) S[i] = f32x2{0.f, 0.f};

  uint4 q[15];
#pragma unroll
  for (int i = 0; i < 15; ++i) q[i] = make_uint4(0, 0, 0, 0);
  if (!cons) {
    int t = d ? (L_ - 1 - tl) : tl;
#pragma unroll
    for (int dt = 0; dt < 3; ++dt) {
      q[0 + dt] = ldrow8(P, b, t + dt - 1, cr);
      q[3 + dt] = ldrow8(P, b, t + dt - 1, ck);
      q[6 + dt] = ldrow8(P, b, t + dt - 1, cvv);
      q[9 + dt] = ldrow8(P, b, t + dt - 1, clw);
      q[12 + dt] = ldrow8(P, b, t + dt - 1, cla);
    }
  }
  float kv[8], kkn[8];
#pragma unroll
  for (int e = 0; e < 8; ++e) { kv[e] = 0.f; kkn[e] = 0.f; }
  float yacc = 0.f;

  struct RwOps { float4 ka, kb, ra, rb; float vi; float2 sc; };
  struct RwUpd { float4 da, db, ba, bb, wa, wb; };
  auto scan_seg = [&](const float* cb, int seg) {
    auto ldops = [&](int s) {
      RwOps r;
      const float* o = cb + 2048 + s * 64 + j8;
      r.ka = *(const float4*)(o); r.kb = *(const float4*)(o + 4);
      r.ra = *(const float4*)(o - 2048); r.rb = *(const float4*)(o - 2048 + 4);
      r.vi = cb[10240 + s * 64 + rowi];
      r.sc = *(const float2*)(cb + 12288 + s * 2);
      return r;
    };
    auto ldupd = [&](int s) {
      RwUpd r;
      const float* o = cb + 2048 + s * 64 + j8;
      r.da = *(const float4*)(o + 2048); r.db = *(const float4*)(o + 2048 + 4);
      r.ba = *(const float4*)(o + 4096); r.bb = *(const float4*)(o + 4096 + 4);
      r.wa = *(const float4*)(o + 6144); r.wb = *(const float4*)(o + 6144 + 4);
      return r;
    };
    RwOps cur = ldops(seg * 8);
#pragma unroll
    for (int i_ = 0; i_ < 8; ++i_) {
      const int s = seg * 8 + i_;
      const RwUpd up = ldupd(s);
      const RwOps nxt = ldops(seg * 8 + ((i_ + 1) & 7));
      float dA = dot8(S, cur.ka, cur.kb);
      float dB = dot8(S, cur.ra, cur.rb);
      const f32x2 vi2 = f32x2{cur.vi, cur.vi};
      const f32x2 A0 = __builtin_elementwise_fma(S[0], f32x2{up.wa.x, up.wa.y}, vi2 * f32x2{up.da.x, up.da.y});
      const f32x2 A1 = __builtin_elementwise_fma(S[1], f32x2{up.wa.z, up.wa.w}, vi2 * f32x2{up.da.z, up.da.w});
      const f32x2 A2 = __builtin_elementwise_fma(S[2], f32x2{up.wb.x, up.wb.y}, vi2 * f32x2{up.db.x, up.db.y});
      const f32x2 A3 = __builtin_elementwise_fma(S[3], f32x2{up.wb.z, up.wb.w}, vi2 * f32x2{up.db.z, up.db.w});
      const float sa = allsum8(dA);
      dB = allsum8(dB);
      const float y = dB + sa * cur.sc.x + cur.vi * cur.sc.y;
      const f32x2 sa2 = f32x2{sa, sa};
      S[0] = __builtin_elementwise_fma(sa2, f32x2{up.ba.x, up.ba.y}, A0);
      S[1] = __builtin_elementwise_fma(sa2, f32x2{up.ba.z, up.ba.w}, A1);
      S[2] = __builtin_elementwise_fma(sa2, f32x2{up.bb.x, up.bb.y}, A2);
      S[3] = __builtin_elementwise_fma(sa2, f32x2{up.bb.z, up.bb.w}, A3);
      yacc = (e8 == i_) ? y : yacc;
      cur = nxt;
    }
    s_y[(seg * 8 + e8) * 32 + pw * 8 + row8] = yacc;
  };

  constexpr int NC = L_ / 32;
  if (cons) {
    for (int c = 0; c <= NC; ++c) {
      const float* cb = s_buf + ((c + 1) & 1) * BUFF;
      const bool cact = c >= 1;
      if (cact) scan_seg(cb, 0);
      __syncthreads();
      if (cact) scan_seg(cb, 1);
      __syncthreads();
      if (cact) scan_seg(cb, 2);
      __syncthreads();
    if (cact) {
        scan_seg(cb, 3);
        const int t2 = lane >> 1, hf = lane & 1;
        const float4 o4 = *(const float4*)(s_y + t2 * 32 + pw * 8 + hf * 4);
        const int ts = (c - 1) * 32 + t2;
        const int t = d ? (L_ - 1 - ts) : ts;
        uint2 o; o.x = pack2(o4.x, o4.y); o.y = pack2(o4.z, o4.w);
        *(uint2*)(Yd + ((size_t)(b * L_ + t)) * 384 + h * 64 + rg2 * 32 + pw * 8 + hf * 4) = o;
      }
    __syncthreads();
    }
  } else {
    const float* mp_ = s_mu + jg * 8;
    const float* mn_ = s_mu + 320 + jg * 8;
    for (int c = 0; c <= NC; ++c) {
      float* pb = s_buf + (c & 1) * BUFF;
      const bool pact = c < NC;
      const bool pnext = c + 1 < NC;
      const int tn_ = (c + 1) * 32 + tl;
      const int tnx = d ? (L_ - 1 - tn_) : tn_;
      const u16* rw0_ = P + ((size_t)(b * L_ + tnx)) * INC;
      const u16* rk0 = rw0_ + (h * 64 + jg * 8);
      const u16* rl0 = rw0_ + (d * 64 + jg * 8);
      const bool edge = pnext && (c + 1 == NC - 1);
      const bool zm = edge && (tnx - 1 < 0), zp = edge && (tnx + 1 >= L_);
      const uint4 zero4 = make_uint4(0, 0, 0, 0);
      if (pact) {
        float rr[8], lw[8], la[8];
        shift8(q[9], q[10], q[11], mp_ + 192, mn_ + 192, lw);
        shift8(q[12], q[13], q[14], mp_ + 256, mn_ + 256, la);
        shift8(q[0], q[1], q[2], mp_, mn_, rr);
#pragma unroll
        for (int e = 0; e < 8; ++e) lw[e] = 1.f - 2.f * frcp(1.f + __expf(2.f * lw[e]));
        *(uint4*)(s_lw + tl * 72 + jg * 8) = pack8(lw);
        *(uint4*)(s_la + tl * 72 + jg * 8) = pack8(la);
        st8f(pb + tl * 64 + jg * 8, rr);
      }
      if (pnext) {
        q[9] = *(const uint4*)(rl0 + 1920 - INC); q[10] = *(const uint4*)(rl0 + 1920); q[11] = *(const uint4*)(rl0 + 1920 + INC);
        q[12] = *(const uint4*)(rl0 + 2048 - INC); q[13] = *(const uint4*)(rl0 + 2048); q[14] = *(const uint4*)(rl0 + 2048 + INC);
        q[0] = *(const uint4*)(rk0 + 768 - INC); q[1] = *(const uint4*)(rk0 + 768); q[2] = *(const uint4*)(rk0 + 768 + INC);
        if (edge) {
          if (zm) { q[9] = zero4; q[12] = zero4; q[0] = zero4; }
          if (zp) { q[11] = zero4; q[14] = zero4; q[2] = zero4; }
        }
      }
      __syncthreads();
      if (pact) {
#pragma unroll
        for (int mt = 0; mt < 2; ++mt) {
          f32x4 aw = {0.f, 0.f, 0.f, 0.f}, aa = {0.f, 0.f, 0.f, 0.f};
#pragma unroll
          for (int ks = 0; ks < 2; ++ks) {
            bf16x8 xw = *(const bf16x8*)(s_lw + (mt * 16 + fr) * 72 + ks * 32 + fq * 8);
            bf16x8 xa = *(const bf16x8*)(s_la + (mt * 16 + fr) * 72 + ks * 32 + fq * 8);
            aw = __builtin_amdgcn_mfma_f32_16x16x32_bf16(xw, fW[ks], aw, 0, 0, 0);
            aa = __builtin_amdgcn_mfma_f32_16x16x32_bf16(xa, fA[ks], aa, 0, 0, 0);
          }
#pragma unroll
          for (int j = 0; j < 4; ++j) {
            int t2 = mt * 16 + fq * 4 + j, jj = pw * 16 + fr;
            pb[8192 + t2 * 64 + jj] = __expf(-0.606531f * sigm(aw[j] + w0v));
            s_a[t2 * 64 + jj] = sigm(aa[j] + a0v);
          }
        }
        float vv[8];
        shift8(q[6], q[7], q[8], mp_ + 128, mn_ + 128, vv);
        st8f(pb + 10240 + tl * 64 + jg * 8, vv);
      }
      if (pnext) {
        q[6] = *(const uint4*)(rk0 + 1536 - INC); q[7] = *(const uint4*)(rk0 + 1536); q[8] = *(const uint4*)(rk0 + 1536 + INC);
        if (edge) { if (zm) q[6] = zero4; if (zp) q[8] = zero4; }
      }
      __syncthreads();
      if (pact) {
        shift8(q[3], q[4], q[5], mp_ + 64, mn_ + 64, kv);
        float kkc[8];
        ld8f(s_mu + 640 + jg * 8, kkc);
        float ss = 0.f;
#pragma unroll
        for (int e = 0; e < 8; ++e) { kkn[e] = kv[e] * kkc[e]; ss += kkn[e] * kkn[e]; }
        ss = allsum8(ss);
        const float inv = rsqrtf(ss + 1e-6f);
        float nk[8];
#pragma unroll
        for (int e = 0; e < 8; ++e) { kkn[e] *= inv; nk[e] = -kkn[e]; }
        st8f(pb + 2048 + tl * 64 + jg * 8, nk);
      }
      if (pnext) {
        q[3] = *(const uint4*)(rk0 + 1152 - INC); q[4] = *(const uint4*)(rk0 + 1152); q[5] = *(const uint4*)(rk0 + 1152 + INC);
        if (edge) { if (zm) q[3] = zero4; if (zp) q[5] = zero4; }
      }
      __syncthreads();
      if (pact) {
        float av[8], kac[8], kd[8], bb[8], rr[8], wv8[8];
        ld8f(s_a + tl * 64 + jg * 8, av);
        ld8f(pb + tl * 64 + jg * 8, rr);
        ld8f(pb + 8192 + tl * 64 + jg * 8, wv8);
        ld8f(s_mu + 704 + jg * 8, kac);
        float br = 0.f, kr = 0.f;
#pragma unroll
        for (int e = 0; e < 8; ++e) {
          kd[e] = kv[e] * (1.f + (av[e] - 1.f) * kac[e]);
          bb[e] = kkn[e] * av[e];
          br += bb[e] * rr[e];
          kr += kd[e] * rr[e];
          rr[e] *= wv8[e];
        }
        br = allsum8(br);
        kr = allsum8(kr);
        st8f(pb + 4096 + tl * 64 + jg * 8, kd);
        st8f(pb + 6144 + tl * 64 + jg * 8, bb);
        st8f(pb + tl * 64 + jg * 8, rr);
        if (jg == 0) *(float2*)(pb + 12288 + tl * 2) = make_float2(br, kr);
      }
      __syncthreads();
    }
  }
}

DEVI void gdscan_pc_item(KP p, int l, int item, char* smem) {
  const int tid = otid();
  const int lane = tid & 63, wv = tid >> 6;
  const bool cons = wv < 4;
  const int rg2 = item & 1, d = (item >> 1) & 1, bh = item >> 2, h = bh % 6, b = bh / 6;
  constexpr int BUFF = 6272;
  float* s_buf = (float*)smem;
  float* s_y = s_buf + 2 * BUFF;
  const u16* P = (const u16*)(p->ws + OFF_BIG);
  u16* Yd = (u16*)(p->ws + OFF_YGD) + (size_t)d * T_ * 384;
  const float* cw = p->in[I_GCW] + l * 3 * 1152;
  const int pt = tid & 255, tl = pt >> 3, jg = pt & 7, pw = wv & 3;
  const int lq = h * 64 + jg * 8, lk = 384 + lq, lv = 768 + lq;
  const float negA = -__expf(p->in[I_GALOG][(l * 2 + d) * 6 + h]);
  const float dtb = p->in[I_GDT][(l * 2 + d) * 6 + h];
  const int cag = 3840 + d * 6 + h, cbg = 3852 + d * 6 + h;
  const int row8 = lane >> 3, e8 = lane & 7;
  const int col_e = rg2 * 32 + pw * 8 + row8;
  const int j8 = e8 * 8;
  f32x2 S[4];
#pragma unroll
  for (int i = 0; i < 4; ++i) S[i] = f32x2{0.f, 0.f};
  float yacc = 0.f;

  uint4 q[9];
#pragma unroll
  for (int i = 0; i < 9; ++i) q[i] = make_uint4(0, 0, 0, 0);
  u16 rag = 0, rbg = 0;
  if (!cons) {
    int t = d ? (L_ - 1 - tl) : tl;
#pragma unroll
    for (int dt = 0; dt < 3; ++dt) {
      q[0 + dt] = ldrow8(P, b, t + dt - 1, 2304 + lq);
      q[3 + dt] = ldrow8(P, b, t + dt - 1, 2304 + lk);
      q[6 + dt] = ldrow8(P, b, t + dt - 1, 2304 + lv);
    }
    { const u16* pr_ = P + ((size_t)(b * L_ + t)) * INC; rag = pr_[cag]; rbg = pr_[cbg]; }
  }
  struct GdOps { float4 ka, kb, qa, qb, sc; float ve; };
  auto scan_seg = [&](const float* cb, int seg) {
    auto ldops = [&](int s) {
      GdOps r;
      const float* o = cb + 2048 + s * 64 + j8;
      r.ka = *(const float4*)(o); r.kb = *(const float4*)(o + 4);
      r.qa = *(const float4*)(o - 2048); r.qb = *(const float4*)(o - 2048 + 4);
      r.ve = cb[4096 + s * 64 + col_e];
      r.sc = *(const float4*)(cb + 6144 + s * 4);
      return r;
    };
    GdOps cur = ldops(seg * 16);
#pragma unroll
    for (int i_ = 0; i_ < 16; ++i_) {
      const int s = seg * 16 + i_;
      const GdOps nxt = ldops(seg * 16 + ((i_ + 1) & 15));
      const float al = cur.sc.x, be = cur.sc.y, qk = cur.sc.z, nab = cur.sc.w;
      float d1 = dot8(S, cur.ka, cur.kb);
      float d2 = dot8(S, cur.qa, cur.qb);
      const f32x2 al2 = f32x2{al, al};
      const f32x2 A0 = S[0] * al2, A1 = S[1] * al2, A2 = S[2] * al2, A3 = S[3] * al2;
      const float bv = be * cur.ve;
      d1 = allsum8(d1);
      d2 = allsum8(d2);
      const float vn = __builtin_fmaf(nab, d1, bv);
      const float ov = al * d2 + qk * vn;
      const f32x2 vn2 = f32x2{vn, vn};
      S[0] = __builtin_elementwise_fma(vn2, f32x2{cur.ka.x, cur.ka.y}, A0);
      S[1] = __builtin_elementwise_fma(vn2, f32x2{cur.ka.z, cur.ka.w}, A1);
      S[2] = __builtin_elementwise_fma(vn2, f32x2{cur.kb.x, cur.kb.y}, A2);
      S[3] = __builtin_elementwise_fma(vn2, f32x2{cur.kb.z, cur.kb.w}, A3);
      yacc = (e8 == (i_ & 7)) ? ov : yacc;
      if ((i_ & 7) == 7) s_y[(s - 7 + e8) * 32 + pw * 8 + row8] = yacc;
      cur = nxt;
    }
  };
  __syncthreads();
  constexpr int NC = L_ / 32;
  for (int c = 0; c <= NC; ++c) {
    float* pb = s_buf + (c & 1) * BUFF;
    const float* cb = s_buf + ((c + 1) & 1) * BUFF;
    const bool pact = !cons && c < NC, cact = cons && c >= 1;
    if (pact) {
      float qq[8], kk[8], vv[8];
#pragma unroll
      for (int arr = 0; arr < 3; ++arr) {
        float a[8], u[8], n[8], w0[8], w1[8], w2[8];
        unpack8(q[arr * 3 + 0], a); unpack8(q[arr * 3 + 1], u); unpack8(q[arr * 3 + 2], n);
        const int lc = (arr == 0) ? lq : (arr == 1 ? lk : lv);
        ld8f(cw + lc, w0); ld8f(cw + 1152 + lc, w1); ld8f(cw + 2304 + lc, w2);
        float* o = (arr == 0) ? qq : (arr == 1 ? kk : vv);
#pragma unroll
        for (int e = 0; e < 8; ++e) o[e] = siluf(w0[e] * a[e] + w1[e] * u[e] + w2[e] * n[e]);
      }
      float sq = 0.f, sk = 0.f;
#pragma unroll
      for (int e = 0; e < 8; ++e) { sq += qq[e] * qq[e]; sk += kk[e] * kk[e]; }
      sq = allsum8(sq); sk = allsum8(sk);
      const float iq = rsqrtf(sq + 1e-6f) * 0.125f, ik = rsqrtf(sk + 1e-6f);
      float qk = 0.f;
#pragma unroll
      for (int e = 0; e < 8; ++e) { qq[e] *= iq; kk[e] *= ik; qk += qq[e] * kk[e]; }
      qk = allsum8(qk);
      st8f(pb + tl * 64 + jg * 8, qq);
      st8f(pb + 2048 + tl * 64 + jg * 8, kk);
      st8f(pb + 4096 + tl * 64 + jg * 8, vv);
      if (jg == 0) {
        float x = bf2f(rag) + dtb;
        float sp = (x > 20.f) ? x : log1pf(__expf(x));
        const float al_ = __expf(negA * sp), be_ = sigm(bf2f(rbg));
        *(float4*)(pb + 6144 + tl * 4) = make_float4(al_, be_, qk, -al_ * be_);
      }
    }
    if (cact) scan_seg(cb, 0);
    __syncthreads();
    if (!cons && c + 1 < NC) {
      int tn = (c + 1) * 32 + tl;
      int t = d ? (L_ - 1 - tn) : tn;
#pragma unroll
      for (int dt = 0; dt < 3; ++dt) {
        q[0 + dt] = ldrow8(P, b, t + dt - 1, 2304 + lq);
        q[3 + dt] = ldrow8(P, b, t + dt - 1, 2304 + lk);
        q[6 + dt] = ldrow8(P, b, t + dt - 1, 2304 + lv);
      }
      { const u16* pr_ = P + ((size_t)(b * L_ + t)) * INC; rag = pr_[cag]; rbg = pr_[cbg]; }
    }
    if (cact) {
      scan_seg(cb, 1);
      const int t2 = lane >> 1, hf = lane & 1;
      const float4 o4 = *(const float4*)(s_y + t2 * 32 + pw * 8 + hf * 4);
      const int ts = (c - 1) * 32 + t2;
      const int t = d ? (L_ - 1 - ts) : ts;
      uint2 o; o.x = pack2(o4.x, o4.y); o.y = pack2(o4.z, o4.w);
      *(uint2*)(Yd + ((size_t)(b * L_ + t)) * 384 + h * 64 + rg2 * 32 + pw * 8 + hf * 4) = o;
    }
    __syncthreads();
  }
}

DEVI void post_tok_item(KP p, int l, int item, char* smem) {
  const int tid = otid();
  const int tl = tid >> 3, jg = tid & 7;
  u16* s_sg = (u16*)smem;
  float* s_gate = (float*)(smem + 64 * 136 * 2);
  const u16* P = (const u16*)(p->ws + OFF_BIG);
  const u16* YR = (const u16*)(p->ws + OFF_YRW);
  const u16* YG = (const u16*)(p->ws + OFF_YGD);
  u16* Yo = (u16*)(p->ws + OFF_HN);
  const float* mup = p->in[I_MUP] + l * 1536;
  const float* mun = p->in[I_MUN] + l * 1536;
  const int tok = item * 64 + tl;
  const int b = tok / L_, t = tok % L_;
#pragma unroll
  for (int half = 0; half < 2; ++half) {
    const int col = 2176 + jg * 16 + half * 8;
    float lg[8];
    shift8(ldrow8(P, b, t - 1, col), ldrow8(P, b, t, col), ldrow8(P, b, t + 1, col), mup + (col - 768),
           mun + (col - 768), lg);
#pragma unroll
    for (int e = 0; e < 8; ++e) lg[e] = sigm(lg[e]);
    *(uint4*)(s_sg + tl * 136 + jg * 16 + half * 8) = pack8(lg);
  }
  __syncthreads();
  {
    const int lane = tid & 63, wv = tid >> 6, fr = lane & 15, fq = lane >> 4;
    const u16* GT = (const u16*)(p->ws + OFF_WKV);
    f32x4 acc[4][3];
#pragma unroll
    for (int m = 0; m < 4; ++m)
#pragma unroll
      for (int n = 0; n < 3; ++n) acc[m][n] = f32x4{0.f, 0.f, 0.f, 0.f};
#pragma unroll
    for (int ks = 0; ks < 4; ++ks) {
      bf16x8 af[4], bfr[3];
#pragma unroll
      for (int m = 0; m < 4; ++m) af[m] = *(const bf16x8*)(s_sg + (m * 16 + fr) * 136 + ks * 32 + fq * 8);
#pragma unroll
      for (int n = 0; n < 3; ++n) bfr[n] = *(const bf16x8*)(GT + ((wv * 3 + n) * 16 + fr) * 128 + ks * 32 + fq * 8);
#pragma unroll
      for (int m = 0; m < 4; ++m)
#pragma unroll
        for (int n = 0; n < 3; ++n) acc[m][n] = __builtin_amdgcn_mfma_f32_16x16x32_bf16(af[m], bfr[n], acc[m][n], 0, 0, 0);
    }
#pragma unroll
    for (int m = 0; m < 4; ++m)
#pragma unroll
      for (int n = 0; n < 3; ++n)
#pragma unroll
        for (int j = 0; j < 4; ++j) s_gate[(m * 16 + fq * 4 + j) * 388 + (wv * 3 + n) * 16 + fr] = acc[m][n][j];
  }
  __syncthreads();
  for (int h = 0; h < 6; ++h) {
    const int hc = h * 64 + jg * 8;
    {
      float y[8], yb8[8];
      unpack8(*(const uint4*)(YR + (size_t)tok * 384 + hc), y);
      unpack8(*(const uint4*)(YR + (size_t)(T_ + tok) * 384 + hc), yb8);
#pragma unroll
      for (int e = 0; e < 8; ++e) y[e] += yb8[e];
      float s = 0.f;
#pragma unroll
      for (int e = 0; e < 8; ++e) s += y[e];
      const float mu = allsum8(s) * (1.f / 64.f);
      float vs = 0.f;
#pragma unroll
      for (int e = 0; e < 8; ++e) { y[e] -= mu; vs += y[e] * y[e]; }
      const float rstd = rsqrtf(allsum8(vs) * (1.f / 64.f) + 64e-5f);
      float gw[8], gb[8], rk[8], rr[8], kv[8], vv[8];
      ld8f(p->in[I_GNW] + l * 384 + hc, gw);
      ld8f(p->in[I_GNB] + l * 384 + hc, gb);
      ld8f(p->in[I_RK] + l * 384 + hc, rk);
      const int cr = 768 + hc, ck = 1152 + hc, cv = 1536 + hc;
      shift8(ldrow8(P, b, t - 1, cr), ldrow8(P, b, t, cr), ldrow8(P, b, t + 1, cr), mup + hc, mun + hc, rr);
      shift8(ldrow8(P, b, t - 1, ck), ldrow8(P, b, t, ck), ldrow8(P, b, t + 1, ck), mup + 384 + hc, mun + 384 + hc, kv);
      shift8(ldrow8(P, b, t - 1, cv), ldrow8(P, b, t, cv), ldrow8(P, b, t + 1, cv), mup + 768 + hc, mun + 768 + hc, vv);
      float bs = 0.f;
#pragma unroll
      for (int e = 0; e < 8; ++e) bs += rr[e] * kv[e] * rk[e];
      bs = allsum8(bs);
      float gate[8];
      ld8f(s_gate + tl * 388 + hc, gate);
      float o[8];
#pragma unroll
      for (int e = 0; e < 8; ++e) o[e] = (y[e] * rstd * gw[e] + gb[e] + bs * vv[e]) * gate[e];
      *(uint4*)(Yo + (size_t)tok * DM + 256 + hc) = pack8(o);
    }
    {
      float o[8], nw[8], zg[8], ob8[8];
      unpack8(*(const uint4*)(YG + (size_t)tok * 384 + hc), o);
      unpack8(*(const uint4*)(YG + (size_t)(T_ + tok) * 384 + hc), ob8);
#pragma unroll
      for (int e = 0; e < 8; ++e) o[e] += ob8[e];
      float ms = 0.f;
#pragma unroll
      for (int e = 0; e < 8; ++e) ms += o[e] * o[e];
      const float rs = rsqrtf(allsum8(ms) * (1.f / 64.f) + 1e-6f);
      ld8f(p->in[I_GNORM] + l * 64 + jg * 8, nw);
      unpack8(ldrow8(P, b, t, 3456 + hc), zg);
#pragma unroll
      for (int e = 0; e < 8; ++e) o[e] = o[e] * rs * nw[e] * siluf(zg[e]);
      *(uint4*)(Yo + (size_t)tok * DM + 640 + hc) = pack8(o);
    }
  }
  __syncthreads();
}

DEVI void attn_phase(KP p, int l, char* smem, int bid, int nb) {
  u16* sKV = (u16*)smem;
  u16* sP = sKV + 64 * 264;
  const int tid = otid(), lane = tid & 63, wv = tid >> 6, fr = lane & 15, fq = lane >> 4;
  const u16* Q = (const u16*)(p->ws + OFF_BIG);
  const u16* KM = (const u16*)(p->ws + OFF_KM) + (size_t)l * 1024 * 1024;
  const u16* VT = (const u16*)(p->ws + OFF_VT) + (size_t)l * 1024 * 1024;
  u16* O = (u16*)(p->ws + OFF_HN);
  u16* myP = sP + wv * 16 * 264;
  for (int it = bid; it < 1024; it += nb) {
    const int h = it & 3, qt = (it >> 2) & 63, b = it >> 8;
    const int tok0 = b * L_ + qt * 128 + wv * 16;
    uint4 R0, R1, R2, R3;
    const int lrow = tid >> 5, lc = (tid & 31) * 8;
    const u16* kbase = KM + (size_t)(b * 256 + lrow) * DM + h * 256 + lc;
    const u16* vbase = VT + (size_t)(h * 256 + lrow) * 1024 + b * 256 + lc;
#define ATT_LDK(ch_) do { const u16* g_ = kbase + (size_t)(ch_) * 64 * DM; R0 = *(const uint4*)(g_); R1 = *(const uint4*)(g_ + 16 * DM); \
      R2 = *(const uint4*)(g_ + 32 * DM); R3 = *(const uint4*)(g_ + 48 * DM); } while (0)
#define ATT_LDV(dc_) do { const u16* g_ = vbase + (size_t)(dc_) * 64 * 1024; R0 = *(const uint4*)(g_); R1 = *(const uint4*)(g_ + 16 * 1024); \
      R2 = *(const uint4*)(g_ + 32 * 1024); R3 = *(const uint4*)(g_ + 48 * 1024); } while (0)
#define ATT_ST() do { u16* d_ = sKV + lrow * 264 + lc; *(uint4*)(d_) = R0; *(uint4*)(d_ + 16 * 264) = R1; \
      *(uint4*)(d_ + 32 * 264) = R2; *(uint4*)(d_ + 48 * 264) = R3; } while (0)
    ATT_LDK(0);
    bf16x8 qf[8];
#pragma unroll
    for (int ks = 0; ks < 8; ++ks)
      qf[ks] = *(const bf16x8*)(Q + (size_t)(tok0 + fr) * DM + h * 256 + ks * 32 + fq * 8);
    f32x4 sc[16];
#pragma unroll
    for (int i = 0; i < 16; ++i) sc[i] = f32x4{0.f, 0.f, 0.f, 0.f};
#pragma unroll
    for (int ch = 0; ch < 4; ++ch) {
      __syncthreads();
      ATT_ST();
      __syncthreads();
      if (ch < 3) ATT_LDK(ch + 1); else ATT_LDV(0);
#pragma unroll
      for (int nt = 0; nt < 4; ++nt) {
#pragma unroll
        for (int ks = 0; ks < 8; ++ks) {
          bf16x8 kf = *(const bf16x8*)(sKV + (nt * 16 + fr) * 264 + ks * 32 + fq * 8);
          sc[ch * 4 + nt] = __builtin_amdgcn_mfma_f32_16x16x32_bf16(qf[ks], kf, sc[ch * 4 + nt], 0, 0, 0);
        }
      }
    }
#pragma unroll
    for (int j = 0; j < 4; ++j) {
      float mx = -1e30f;
#pragma unroll
      for (int i = 0; i < 16; ++i) mx = fmaxf(mx, sc[i][j]);
#pragma unroll
      for (int o = 1; o < 16; o <<= 1) mx = fmaxf(mx, __shfl_xor(mx, o, 64));
      float sum = 0.f;
#pragma unroll
      for (int i = 0; i < 16; ++i) {
        float e = __expf((sc[i][j] - mx) * 0.0625f);
        sc[i][j] = e;
        sum += e;
      }
      sum = allsum16(sum);
      const float inv = frcp(sum);
#pragma unroll
      for (int i = 0; i < 16; ++i) myP[(fq * 4 + j) * 264 + i * 16 + fr] = f2bf(sc[i][j] * inv);
    }
#pragma unroll
    for (int dc = 0; dc < 4; ++dc) {
      __syncthreads();
      ATT_ST();
      __syncthreads();
      if (dc < 3) ATT_LDV(dc + 1);
      f32x4 oa[4];
#pragma unroll
      for (int nt = 0; nt < 4; ++nt) oa[nt] = f32x4{0.f, 0.f, 0.f, 0.f};
#pragma unroll
      for (int ks = 0; ks < 8; ++ks) {
        bf16x8 pf = *(const bf16x8*)(myP + fr * 264 + ks * 32 + fq * 8);
#pragma unroll
        for (int nt = 0; nt < 4; ++nt) {
          bf16x8 vf = *(const bf16x8*)(sKV + (nt * 16 + fr) * 264 + ks * 32 + fq * 8);
          oa[nt] = __builtin_amdgcn_mfma_f32_16x16x32_bf16(pf, vf, oa[nt], 0, 0, 0);
        }
      }
#pragma unroll
      for (int nt = 0; nt < 4; ++nt)
#pragma unroll
        for (int j = 0; j < 4; ++j)
          O[(size_t)(tok0 + fq * 4 + j) * DM + h * 256 + dc * 64 + nt * 16 + fr] = f2bf(oa[nt][j]);
    }
    __syncthreads();
#undef ATT_LDK
#undef ATT_LDV
#undef ATT_ST
  }
}


#define XB_TMO      128
#define XB_XCNT(j)  (256  + 64 * (j))
#define XB_XSUB(j)  (1280 + 64 * (j))
#define XB_XGEN(j)  (2304 + 64 * (j))
#define XB_TOP      3328
#define XB_TOPGEN   3392
#define XCD_BAR_WORDS 3456
#define XB_SPIN_CAP (1u << 24)
#define LAS __attribute__((address_space(3)))
DEVI unsigned xb_ld(unsigned* p) { return __hip_atomic_load(p, __ATOMIC_RELAXED, __HIP_MEMORY_SCOPE_AGENT); }
DEVI unsigned xb_add(unsigned* p, unsigned v) { return __hip_atomic_fetch_add(p, v, __ATOMIC_RELAXED, __HIP_MEMORY_SCOPE_AGENT); }
DEVI unsigned xb_xcc_id() { return (unsigned)__builtin_amdgcn_s_getreg((3 << 11) | 20) & 0xFu; }
#define XB_SPIN(cond, bar) do { unsigned _sp = 0; while (cond) { __builtin_amdgcn_s_sleep(1); \
    if ((++_sp & 255u) == 0u) { if (xb_ld(&(bar)[XB_TMO])) break; if (_sp > XB_SPIN_CAP) { atomicAdd(&(bar)[XB_TMO], 1u); break; } } } } while (0)
struct XcdBarrier { unsigned* bar; unsigned x; volatile LAS unsigned* st; };
DEVI XcdBarrier xcd_barrier_post(unsigned* bar, volatile LAS unsigned* st) {
  XcdBarrier b; b.bar = bar; b.x = xb_xcc_id(); b.st = st;
  if (threadIdx.x == 0) (void)xb_add(&bar[XB_XCNT(b.x)], 1u);
  return b;
}
DEVI void xcd_barrier_complete(unsigned* bar, unsigned x, unsigned& nloc, unsigned& nx) {
  const unsigned G = gridDim.x * gridDim.y * gridDim.z;
  unsigned sum, cnt, mine, sp = 0u;
  for (;;) {
    sum = 0u; cnt = 0u; mine = 0u;
#pragma unroll
    for (unsigned j = 0; j < 16; ++j) { const unsigned c = xb_ld(&bar[XB_XCNT(j)]); sum += c; cnt += (c > 0u) ? 1u : 0u; mine = (j == x) ? c : mine; }
    if (sum == G) break;
    __builtin_amdgcn_s_sleep(1);
    if ((++sp & 255u) == 0u) { if (xb_ld(&bar[XB_TMO])) break; if (sp > XB_SPIN_CAP) { atomicAdd(&bar[XB_TMO], 1u); break; } }
  }
  nloc = mine > 0u ? mine : 1u; nx = cnt > 0u ? cnt : 1u;
}
DEVI void xcd_barrier(const XcdBarrier& b) {
  asm volatile("s_waitcnt vmcnt(0)" ::: "memory");
  __syncthreads();
  if (threadIdx.x == 0) {
    unsigned* bar = b.bar;
    __builtin_amdgcn_s_waitcnt(0);
    unsigned nloc = b.st[0], nx = b.st[1];
    if (nloc == 0u) { xcd_barrier_complete(bar, b.x, nloc, nx); b.st[0] = nloc; b.st[1] = nx; }
    const unsigned old = xb_add(&bar[XB_XSUB(b.x)], 1u);
    const unsigned gen = old / nloc;
    if (old + 1u == (gen + 1u) * nloc) {
      __builtin_amdgcn_fence(__ATOMIC_RELEASE, "agent");
      asm volatile("s_waitcnt vmcnt(0)" ::: "memory");
      const unsigned og = xb_add(&bar[XB_TOP], 1u);
      const unsigned tg = og / nx;
      if (og + 1u == (tg + 1u) * nx) xb_add(&bar[XB_TOPGEN], 1u);
      else XB_SPIN(xb_ld(&bar[XB_TOPGEN]) == tg, bar);
      __builtin_amdgcn_fence(__ATOMIC_ACQUIRE, "agent");
      xb_add(&bar[XB_XGEN(b.x)], 1u);
      asm volatile("s_waitcnt vmcnt(0)" ::: "memory");
    } else {
      XB_SPIN(xb_ld(&bar[XB_XGEN(b.x)]) == gen, bar);
      __builtin_amdgcn_fence(__ATOMIC_ACQUIRE, "agent");
      asm volatile("s_waitcnt vmcnt(0)" ::: "memory");
    }
  }
  __syncthreads();
}

DEVI void sub_barrier(unsigned* word, unsigned expected) {
  asm volatile("s_waitcnt vmcnt(0)" ::: "memory");
  __syncthreads();
  if (threadIdx.x == 0) {
    __builtin_amdgcn_fence(__ATOMIC_RELEASE, "agent");
    asm volatile("s_waitcnt vmcnt(0)" ::: "memory");
    xb_add(word, 1u);
    unsigned sp = 0;
    while (xb_ld(word) < expected) { __builtin_amdgcn_s_sleep(1); if (++sp > XB_SPIN_CAP) break; }
    __builtin_amdgcn_fence(__ATOMIC_ACQUIRE, "agent");
    asm volatile("s_waitcnt vmcnt(0)" ::: "memory");
  }
  __syncthreads();
}

#ifndef PROBE_RW
#define PROBE_RW 0
#endif
#ifndef PROBE_GD
#define PROBE_GD 0
#endif
#ifndef PROBE_HY
#define PROBE_HY 0
#endif
#ifndef REP_HYPREP
#define REP_HYPREP 1
#endif
#ifndef REP_POST
#define REP_POST 1
#endif
#ifndef REP_ATT
#define REP_ATT 1
#endif
#ifndef REP_NORM
#define REP_NORM 1
#endif
#ifndef REP_P0
#define REP_P0 1
#endif
#ifndef REP_SYNC
#define REP_SYNC 0
#endif
#ifndef REP_MIX
#define REP_MIX 1
#endif
#ifndef REP_G1
#define REP_G1 1
#endif
#ifndef EN_HY
#define EN_HY 1
#endif
#ifndef EN_RW
#define EN_RW 1
#endif
#ifndef EN_GD
#define EN_GD 1
#endif
#ifndef EN_XA
#define EN_XA 1
#endif

__global__ void __launch_bounds__(NTHR, 2) fwd_megakernel(Params p_unused) {
  __shared__ __attribute__((aligned(16))) char smem[SMEM_BYTES];
  const KP kp0 = (KP)__builtin_amdgcn_kernarg_segment_ptr();
#define p (opqk(kp0))
  cg::grid_group grid = cg::this_grid();
  __shared__ uint4 xb_words;
  if (threadIdx.x == 0) xb_words = make_uint4(0u, 0u, 0u, 0u);
  __syncthreads();
  const XcdBarrier xb = xcd_barrier_post((unsigned*)(kp0->ws + OFF_BAR), (volatile LAS unsigned*)&xb_words);
  const int bid = blockIdx.x, nb = gridDim.x;
#define ws (p->ws)
#define WA ((u16*)(ws + OFF_WA))
#define WB ((u16*)(ws + OFF_WB))
#define WKV ((u16*)(ws + OFF_WKV))
#define MEMN ((u16*)(ws + OFF_MEMN))
#define HN ((u16*)(ws + OFF_HN))
#define BIG ((u16*)(ws + OFF_BIG))
#define X (p->out)

  {
  for (int l = 0; l < 2; ++l) {
    convert_phase(p->in[I_WK] + (size_t)l * DM * DM, nullptr, DM, DM, DM, WKV + (size_t)(l * 2 + 0) * DM * DM, smem, bid, nb);
    convert_phase(p->in[I_WV] + (size_t)l * DM * DM, nullptr, DM, DM, DM, WKV + (size_t)(l * 2 + 1) * DM * DM, smem, bid, nb);
  }
  rmsnorm_phase<false>(p->in[I_MEM], p->in[I_MEMNORM], MEMN, 1024, bid, nb);
  hyfilter_phase(p, smem, bid, nb);
  if (gridDim.x == 0x7fffffffu) grid.sync();
  xcd_barrier(xb);
  for (int l = 0; l < 2; ++l) {
    run_gemm(smem, MEMN, WKV + (size_t)(l * 2 + 0) * DM * DM, 1024, 1024, DM,
             pg8::EpiBf16{(u16*)(ws + OFF_KM) + (size_t)l * DM * DM, DM, DM}, bid, (l * 32) % nb, 16);
    run_gemm(smem, WKV + (size_t)(l * 2 + 1) * DM * DM, MEMN, 1024, 1024, DM,
             pg8::EpiBf16{(u16*)(ws + OFF_VT) + (size_t)l * DM * DM, DM, DM}, bid, (l * 32 + 16) % nb, 16);
  }
  hynorm_phase(p, smem, (bid + nb - 64 % nb) % nb, nb);
  xcd_barrier(xb);
  }
  for (int rs_ = 0; rs_ < REP_SYNC; ++rs_) xcd_barrier(xb);

  for (int l = 0; l < 2; ++l) {
    const float* xin = (l == 0) ? p->in[I_X] : X;
    rmsnorm_phase<false>(xin, p->in[I_NFFN1] + l * DM, HN, T_, bid, nb);
    convert_phase(p->in[I_F1W1] + (size_t)l * DM * DFF, p->in[I_F1W3] + (size_t)l * DM * DFF, DM, 2 * DFF, 2 * DFF, WA, smem, bid, nb);
    convert_phase(p->in[I_F1W2] + (size_t)l * DFF * DM, nullptr, DFF, DM, DM, WB, smem, bid, nb);
    xcd_barrier(xb);
    for (int rep_ = 0; rep_ < REP_G1; ++rep_) {
      run_gemm(smem, HN, WA, T_, 2 * DFF, DM, pg8::EpiSwiglu{BIG, DFF}, bid, 0, nb);
      xcd_barrier(xb);
    }
    run_gemm(smem, BIG, WB, T_, DM, DFF, pg8::EpiResid{X, xin, 0.5f}, bid, 0, nb);
    xcd_barrier(xb);
    rmsnorm_phase<false>(X, p->in[I_NMIX] + l * DM, HN, T_, bid, nb);
    convert_phase(p->in[I_WIN] + (size_t)l * DM * INC, nullptr, DM, INC, INCP, WA, smem, bid, nb);
    convert_phase(p->in[I_WOUT] + (size_t)l * DM * DM, nullptr, DM, DM, DM, WB, smem, bid, nb);
    convert_phase(p->in[I_GLORA] + (size_t)l * 128 * 384, nullptr, 128, 384, 384, WKV, smem, (bid + 128) % nb, nb);
    xcd_barrier(xb);
    run_gemm(smem, HN, WA, T_, INCP, DM, pg8::EpiBf16{BIG, INC, INC}, bid, 0, nb);
    xcd_barrier(xb);
    const bool hy_own_prep = (nb == 256);
    if (!hy_own_prep) {
      hyprep_phase(p, l, smem, bid, nb);
      xcd_barrier(xb);
    }
    for (int rep_ = 0; rep_ < REP_MIX; ++rep_) {
      if (rep_ > 0) xcd_barrier(xb);
      const int t5 = otid();
      const int half = t5 >> 8, tl5 = t5 & 255;
      char* hsm = smem + half * SCAN_SMEM;
      for (int r = bid; r < 256; r += nb) {
        if (r < 192) {
          const int q_ = (r < 96) ? r : r - 96;
          const int it_ = (((q_ >> 4) * 8 + (q_ & 7)) << 1) | ((q_ >> 3) & 1);
          if (r < 96) rwscan_pc_item(p, l, it_, smem);
          else gdscan_pc_item(p, l, it_, smem);
        }
        else if (EN_HY) {
          if (hy_own_prep) {
            hyprep_phase(p, l, smem, r - 192, 64);
            sub_barrier((unsigned*)(ws + OFF_BAR) + 3520 + 64 * l, 64u);
          }
          for (int c = r - 192; c < 256; c += 64) hyconv_item(p, l, c, smem);
        }
      }
    }
    xcd_barrier(xb);
    for (int rep_ = 0; rep_ < REP_POST; ++rep_) {
      for (int it = bid; it < 512; it += nb) post_tok_item(p, l, it, smem);
      xcd_barrier(xb);
    }
    run_gemm(smem, HN, WB, T_, DM, DM, pg8::EpiResid{X, X, 1.0f}, bid, 0, nb);
    xcd_barrier(xb);
    for (int rep_ = 0; rep_ < REP_NORM; ++rep_)
    rmsnorm_phase<false>(X, p->in[I_NXA] + l * DM, HN, T_, bid, nb);
    convert_phase(p->in[I_WQ] + (size_t)l * DM * DM, nullptr, DM, DM, DM, WA, smem, bid, nb);
    convert_phase(p->in[I_WO] + (size_t)l * DM * DM, nullptr, DM, DM, DM, WB, smem, bid, nb);
    xcd_barrier(xb);
#if EN_XA
    run_gemm(smem, HN, WA, T_, DM, DM, pg8::EpiBf16{BIG, DM, DM}, bid, 0, nb);
    xcd_barrier(xb);
    for (int rep_ = 0; rep_ < REP_ATT; ++rep_) {
      attn_phase(p, l, smem, bid, nb);
      xcd_barrier(xb);
    }
    run_gemm(smem, HN, WB, T_, DM, DM, pg8::EpiResid{X, X, 1.0f}, bid, 0, nb);
    xcd_barrier(xb);
#endif
    rmsnorm_phase<false>(X, p->in[I_NFFN2] + l * DM, HN, T_, bid, nb);
    convert_phase(p->in[I_F2W1] + (size_t)l * DM * DFF, p->in[I_F2W3] + (size_t)l * DM * DFF, DM, 2 * DFF, 2 * DFF, WA, smem, bid, nb);
    convert_phase(p->in[I_F2W2] + (size_t)l * DFF * DM, nullptr, DFF, DM, DM, WB, smem, bid, nb);
    xcd_barrier(xb);
    for (int rep_ = 0; rep_ < REP_G1; ++rep_) {
      run_gemm(smem, HN, WA, T_, 2 * DFF, DM, pg8::EpiSwiglu{BIG, DFF}, bid, 0, nb);
      xcd_barrier(xb);
    }
    run_gemm(smem, BIG, WB, T_, DM, DFF, pg8::EpiResid{X, X, 0.5f}, bid, 0, nb);
    xcd_barrier(xb);
  }
  rmsnorm_phase<true>(X, p->in[I_NFINAL], X, T_, bid, nb);
#undef p
#undef ws
#undef WA
#undef WB
#undef WKV
#undef MEMN
#undef HN
#undef BIG
#undef X
}

extern "C" void kernel_launch(void* const* d_in, const int* in_sizes, int n_in, void* d_out, int out_size, void* d_ws,
                              size_t ws_size, hipStream_t stream) {
  static int grid_blocks = 0;
  if (!grid_blocks) {
    int dev = 0, cus = 0, per_cu = 0;
    (void)hipGetDevice(&dev);
    (void)hipDeviceGetAttribute(&cus, hipDeviceAttributeMultiprocessorCount, dev);
    (void)hipOccupancyMaxActiveBlocksPerMultiprocessor(&per_cu, fwd_megakernel, NTHR, 0);
    if (per_cu != 1) per_cu = 1;
    grid_blocks = cus * per_cu;
  }
  Params p{};
  for (int i = 0; i < 46; ++i) p.in[i] = (const float*)d_in[i];
  p.out = (float*)d_out;
  p.ws = (char*)d_ws;
  (void)hipMemsetAsync((char*)d_ws + OFF_BAR, 0, 16384, stream);
  void* args[] = {&p};
  hipError_t e = hipLaunchCooperativeKernel((void*)fwd_megakernel, dim3(grid_blocks), dim3(NTHR), args, 0, stream);
  if (e != hipSuccess) fprintf(stderr, "cooperative launch failed: %s (grid %d)\n", hipGetErrorString(e), grid_blocks);
}
```

```cpp
#include <hip/hip_runtime.h>
#include <hip/hip_bf16.h>
#include <hip/hip_cooperative_groups.h>
#include <cstdio>
namespace cg = cooperative_groups;

typedef unsigned short u16;
using bf16x8 = __attribute__((ext_vector_type(8))) short;
using f32x4 = __attribute__((ext_vector_type(4))) float;

#define DEVI __device__ __forceinline__

constexpr int T_ = 32768, L_ = 8192, NB_ = 4, DM = 1024, DFF = 2816, INC = 3864, INCP = 4096;
constexpr int NTHR = 512, NWV = NTHR / 64;

constexpr size_t OFF_WA = 0;
constexpr size_t OFF_WB = OFF_WA + 11534336;
constexpr size_t OFF_WKV = OFF_WB + 5767168;
constexpr size_t OFF_MEMN = OFF_WKV + 8388608;
constexpr size_t OFF_KM = OFF_MEMN + 2097152;
constexpr size_t OFF_VT = OFF_KM + 4194304;
constexpr size_t OFF_RK = OFF_VT + 4194304;
constexpr size_t OFF_UB = OFF_RK + 16777216;
constexpr size_t OFF_YC = OFF_UB + 20971520;
constexpr size_t OFF_HN = OFF_YC + 16777216;
constexpr size_t OFF_YRW = OFF_HN + 67108864;
constexpr size_t OFF_YGD = OFF_YRW + 50331648;
constexpr size_t OFF_BIG = OFF_YGD + 50331648;
constexpr size_t OFF_BAR = OFF_BIG + 253231104;
constexpr size_t OFF_X0 = OFF_BAR + 16384;
constexpr int UBS = 10240;
constexpr int SCAN_SMEM = 75776;
constexpr int SMEM_BYTES = 2 * SCAN_SMEM;

struct Params {
  const float* in[46];
  float* out;
  char* ws;
};

typedef const __attribute__((address_space(4))) Params* KP;
DEVI KP opqk(KP k) { asm volatile("" : "+s"(k)); return k; }

enum {
  I_X = 0, I_MEM, I_NFFN1, I_F1W1, I_F1W3, I_F1W2, I_NMIX, I_WIN, I_WOUT, I_HYCW, I_HYCB, I_HYFREQ, I_HYW1, I_HYB1,
  I_HYW2, I_HYB2, I_HYW3, I_HYDEC, I_HYBIAS, I_MUP, I_MUN, I_WLORA, I_W0, I_ALORA, I_A0, I_GLORA, I_KK, I_KA, I_RK,
  I_GNW, I_GNB, I_GCW, I_GALOG, I_GDT, I_GNORM, I_NXA, I_WQ, I_WK, I_WV, I_WO, I_MEMNORM, I_NFFN2, I_F2W1, I_F2W3,
  I_F2W2, I_NFINAL
};

typedef __bf16 bf16x2_t __attribute__((ext_vector_type(2)));
DEVI unsigned cvtpk(float lo, float hi) { bf16x2_t v = {(__bf16)lo, (__bf16)hi}; return __builtin_bit_cast(unsigned, v); }
DEVI u16 f2bf(float f) { return (u16)(cvtpk(f, 0.f) & 0xffffu); }
DEVI float frcp(float x) { return __builtin_amdgcn_rcpf(x); }
DEVI float bf2f(u16 h) { return __uint_as_float(((unsigned)h) << 16); }
DEVI float bflo(unsigned v) { return __uint_as_float(v << 16); }
DEVI float bfhi(unsigned v) { return __uint_as_float(v & 0xffff0000u); }
DEVI unsigned pack2(float a, float b) { return cvtpk(a, b); }
DEVI float sigm(float x) { return frcp(1.f + __expf(-x)); }
DEVI float siluf(float x) { return x * frcp(1.f + __expf(-x)); }

DEVI void unpack8(uint4 v, float* f) {
  f[0] = bflo(v.x); f[1] = bfhi(v.x); f[2] = bflo(v.y); f[3] = bfhi(v.y);
  f[4] = bflo(v.z); f[5] = bfhi(v.z); f[6] = bflo(v.w); f[7] = bfhi(v.w);
}
DEVI uint4 pack8(const float* f) {
  uint4 v; v.x = pack2(f[0], f[1]); v.y = pack2(f[2], f[3]); v.z = pack2(f[4], f[5]); v.w = pack2(f[6], f[7]);
  return v;
}

template <int CTRL> DEVI float dppf(float x) {
  return __int_as_float(__builtin_amdgcn_update_dpp(0, __float_as_int(x), CTRL, 0xf, 0xf, true));
}
DEVI float allsum16(float x) {
  x += dppf<0xB1>(x);
  x += dppf<0x4E>(x);
  x += dppf<0x141>(x);
  x += dppf<0x140>(x);
  return x;
}
DEVI float allsum8(float x) {
  x += dppf<0xB1>(x);
  x += dppf<0x4E>(x);
  x += dppf<0x141>(x);
  return x;
}
DEVI int otid() { int t = threadIdx.x; asm volatile("" : "+v"(t)); return t; }
template <class Tp> DEVI const Tp* opq(const Tp* p) { asm volatile("" : "+v"(p)); return p; }
typedef float f32x2 __attribute__((ext_vector_type(2)));
DEVI float dot4(float s0, float s1, float s2, float s3, const float4& k) {
  f32x2 t = f32x2{s0, s1} * f32x2{k.x, k.y};
  t = __builtin_elementwise_fma(f32x2{s2, s3}, f32x2{k.z, k.w}, t);
  return t.x + t.y;
}
DEVI float wavesum(float x) {
  for (int o = 32; o > 0; o >>= 1) x += __shfl_xor(x, o, 64);
  return x;
}

DEVI void convert_phase(const float* __restrict__ W0, const float* __restrict__ W1, int K, int N, int Npad,
                              u16* __restrict__ Wt, char* smem, int bid, int nb) {
  float* tile = (float*)smem;
  const int tid = otid();
  const int kt = K / 64;
  const int ntiles = (Npad / 64) * kt;
  const int NW = W1 ? N / 2 : N;
  for (int t = bid; t < ntiles; t += nb) {
    const int n0 = (t / kt) * 64, k0 = (t % kt) * 64;
#pragma unroll 4
    for (int i = 0; i < 64 / NWV; ++i) {
      int kk = i * NWV + (tid >> 6), nn = tid & 63, R = n0 + nn;
      float v = 0.f;
      if (R < N) {
        if (W1) {
          int g = R >> 5, wi = R & 31;
          const float* src = (wi < 16) ? W0 : W1;
          v = src[(size_t)(k0 + kk) * NW + g * 16 + (wi & 15)];
        } else {
          v = W0[(size_t)(k0 + kk) * NW + R];
        }
      }
      tile[kk * 65 + nn] = v;
    }
    __syncthreads();
#pragma unroll 4
    for (int i = 0; i < 64 / NWV; ++i) {
      int nn = i * NWV + (tid >> 6), kk = tid & 63;
      Wt[(size_t)(n0 + nn) * K + k0 + kk] = f2bf(tile[kk * 65 + nn]);
    }
    __syncthreads();
  }
}

template <bool OUT_F32>
DEVI void rmsnorm_phase(const float* __restrict__ x, const float* __restrict__ g, void* outp, int rows, int bid,
                              int nb) {
  const int tid_ = otid();
  const int lane = tid_ & 63, wv = tid_ >> 6;
  for (int r = bid * NWV + wv; r < rows; r += nb * NWV) {
    const float* xr = x + (size_t)r * DM;
    float4 v[4];
    float ss = 0.f;
#pragma unroll
    for (int i = 0; i < 4; ++i) {
      v[i] = *(const float4*)(xr + i * 256 + lane * 4);
      ss += v[i].x * v[i].x + v[i].y * v[i].y + v[i].z * v[i].z + v[i].w * v[i].w;
    }
    ss = wavesum(ss);
    const float sc = rsqrtf(ss * (1.f / DM) + 1e-6f);
#pragma unroll
    for (int i = 0; i < 4; ++i) {
      float4 gg = *(const float4*)(g + i * 256 + lane * 4);
      float a = v[i].x * sc * gg.x, b = v[i].y * sc * gg.y, c = v[i].z * sc * gg.z, d = v[i].w * sc * gg.w;
      if (OUT_F32) {
        *(float4*)((float*)outp + (size_t)r * DM + i * 256 + lane * 4) = make_float4(a, b, c, d);
      } else {
        uint2 o; o.x = pack2(a, b); o.y = pack2(c, d);
        *(uint2*)((u16*)outp + (size_t)r * DM + i * 256 + lane * 4) = o;
      }
    }
  }
}

namespace pg8 {
#define PG8_LAS __attribute__((address_space(3)))
typedef unsigned u32x4 __attribute__((ext_vector_type(4)));
constexpr int BM = 256, BK = 64, HALF = 128, HTB = HALF * BK * 2, NXCD = 8, WGM = 8;
DEVI int lds_byte(int r, int c) { const int st = (r >> 4) * 2 + (c >> 5), rr = r & 15, cc = c & 31, ob = rr * 64 + cc * 2; return st * 1024 + (ob ^ (((ob >> 9) & 1) << 5)); }
DEVI void stage_rc(int b, int& R, int& C) { const int st = b / 1024, sb = b % 1024, swz = sb ^ (((sb >> 9) & 1) << 5); R = (st >> 1) * 16 + swz / 64; C = (st & 1) * 32 + (swz % 64) / 2; }
DEVI int perm32(int rho) { const int n = rho >> 4, i = rho & 15; return 8 * (i >> 2) + 4 * n + (i & 3); }
struct Unit { int pm, pn; };
struct Gemm { const u16* A; const u16* Bt; int M, N, K; };
struct StaticOrder {
  int nM, nN, nwg, G, c;
  DEVI void init(int M, int N, int G_, int c_) { nM = M / BM; nN = N / BM; nwg = nM * nN; G = G_; c = c_; }
  DEVI bool next(int i, Unit& u) const {
    const long L = (long)i * G + c; if (L >= nwg) return false;
    int wgid = (int)L; { const int q = nwg / NXCD, r = nwg % NXCD, xcd = wgid % NXCD, off = wgid / NXCD; wgid = (xcd < r ? xcd * (q + 1) : r * (q + 1) + (xcd - r) * q) + off; }
    const int nig = WGM * nN, gid = wgid / nig, fm = gid * WGM, gsz = (nM - fm) < WGM ? (nM - fm) : WGM;
    u.pm = fm + ((wgid % nig) % gsz); u.pn = (wgid % nig) / gsz; return true;
  }
};
DEVI unsigned cvt_pk_bf16(float lo, float hi) { return cvtpk(lo, hi); }

struct EpiBf16 {
  static constexpr bool PERM = true;
  u16* O; int ldc; int N;
  DEVI void operator()(const f32x4 (&acc)[2][2][4][2], const Unit& u, int wr, int wc, int fr, int fq) const {
    const int row0 = u.pm * BM + wr * 64 + fr, col0 = u.pn * BM + wc * 32 + 8 * fq;
#pragma unroll
    for (int ai = 0; ai < 2; ++ai)
#pragma unroll
      for (int m = 0; m < 4; ++m) {
        u16* rowp = O + (size_t)(row0 + ai * HALF + m * 16) * ldc + col0;
#pragma unroll
        for (int bj = 0; bj < 2; ++bj) {
          const f32x4 v0 = acc[ai][bj][m][0], v1 = acc[ai][bj][m][1];
          u32x4 w; w.x = cvt_pk_bf16(v0[0], v0[1]); w.y = cvt_pk_bf16(v0[2], v0[3]); w.z = cvt_pk_bf16(v1[0], v1[1]); w.w = cvt_pk_bf16(v1[2], v1[3]);
          if (col0 + bj * HALF < N) *(u32x4*)(rowp + bj * HALF) = w;
        }
      }
  }
};
struct EpiSwiglu {
  static constexpr bool PERM = false;
  u16* U; int ldu;
  DEVI void operator()(const f32x4 (&acc)[2][2][4][2], const Unit& u, int wr, int wc, int fr, int fq) const {
    const int row0 = u.pm * BM + wr * 64 + fr;
#pragma unroll
    for (int ai = 0; ai < 2; ++ai)
#pragma unroll
      for (int m = 0; m < 4; ++m) {
        u16* rowp = U + (size_t)(row0 + ai * HALF + m * 16) * ldu;
#pragma unroll
        for (int bj = 0; bj < 2; ++bj) {
          const int g32 = (u.pn * BM + bj * HALF + wc * 32) >> 5;
          const f32x4 a = acc[ai][bj][m][0], b = acc[ai][bj][m][1];
          uint2 w;
          w.x = cvt_pk_bf16(siluf(a[0]) * b[0], siluf(a[1]) * b[1]);
          w.y = cvt_pk_bf16(siluf(a[2]) * b[2], siluf(a[3]) * b[3]);
          *(uint2*)(rowp + g32 * 16 + 4 * fq) = w;
        }
      }
  }
};
struct EpiResid {
  static constexpr bool PERM = false;
  float* X; const float* Xin; float scale;
  DEVI void operator()(const f32x4 (&acc)[2][2][4][2], const Unit& u, int wr, int wc, int fr, int fq) const {
    const int row0 = u.pm * BM + wr * 64 + fr, col0 = u.pn * BM + wc * 32 + 4 * fq;
#pragma unroll
    for (int ai = 0; ai < 2; ++ai)
#pragma unroll
      for (int m = 0; m < 4; ++m) {
        const size_t ro = (size_t)(row0 + ai * HALF + m * 16) * DM + col0;
#pragma unroll
        for (int bj = 0; bj < 2; ++bj)
#pragma unroll
          for (int n = 0; n < 2; ++n) {
            const f32x4 xi = *(const f32x4*)(Xin + ro + bj * HALF + n * 16);
            *(f32x4*)(X + ro + bj * HALF + n * 16) = xi + acc[ai][bj][m][n] * scale;
          }
      }
  }
};

template <class Epi>
DEVI void gemm_phase(PG8_LAS unsigned char* lds, const Gemm g, const StaticOrder& S, const Epi& E) {
  const int tid = otid(), wid = __builtin_amdgcn_readfirstlane(tid >> 6), lane = tid & 63, wr = wid >> 2, wc = wid & 3, fr = lane & 15, fq = lane >> 4;
  const int K = g.K, nt = K / BK;
  unsigned voffA[2], voffB[2];
#pragma unroll
  for (int i = 0; i < 2; ++i) { int R, C; stage_rc(tid * 16 + i * 8192, R, C); const int Rb = Epi::PERM ? ((R & ~31) + perm32(R & 31)) : R;
    voffA[i] = (unsigned)(R * K + C) * 2u; voffB[i] = (unsigned)(Rb * K + C) * 2u; }
  const size_t kstep = (size_t)(BK * 2);
  const size_t hstep = (size_t)HALF * K * 2;
  const size_t tstep = 2 * hstep;
  const unsigned ldsw = (unsigned)wid * 1024u;
  const int aoff = lds_byte(wr * 64 + fr, fq * 8), boff = lds_byte(wc * 32 + fr, fq * 8);
#define PG8_SA(b, h) (((b) * 2 + (h)) * HTB)
#define PG8_SB(b, h) ((4 + (b) * 2 + (h)) * HTB)
#define PG8_STAGE(bufoff, gbase, voff) do { _Pragma("unroll") for (int _i = 0; _i < 2; ++_i) \
    __builtin_amdgcn_global_load_lds((const unsigned*)((const char*)(gbase) + (voff)[_i]), (PG8_LAS unsigned*)(lds + (bufoff) + ldsw + _i * 8192), 16, 0, 0); } while (0)
#define PG8_LDA(dst, b, h) do { _Pragma("unroll") for (int m = 0; m < 4; ++m) _Pragma("unroll") for (int k = 0; k < 2; ++k) dst[m][k] = *(const PG8_LAS bf16x8*)(lds + PG8_SA(b, h) + aoff + m * 2048 + k * 1024); } while (0)
#define PG8_LDB(dst, b, h) do { _Pragma("unroll") for (int n = 0; n < 2; ++n) _Pragma("unroll") for (int k = 0; k < 2; ++k) dst[n][k] = *(const PG8_LAS bf16x8*)(lds + PG8_SB(b, h) + boff + n * 2048 + k * 1024); } while (0)
#define PG8_MMA(ai, bj, At, Bt) do { __builtin_amdgcn_s_setprio(1); _Pragma("unroll") for (int m = 0; m < 4; ++m) _Pragma("unroll") for (int n = 0; n < 2; ++n) _Pragma("unroll") for (int k = 0; k < 2; ++k) \
    acc[ai][bj][m][n] = __builtin_amdgcn_mfma_f32_16x16x32_bf16(Bt[n][k], At[m][k], acc[ai][bj][m][n], 0, 0, 0); __builtin_amdgcn_s_setprio(0); } while (0)
#define PG8_WAIT_V(n) asm volatile("s_waitcnt vmcnt(" #n ")" ::: "memory")
#define PG8_WAIT_L(n) asm volatile("s_waitcnt lgkmcnt(" #n ")" ::: "memory")
#define PG8_BAR __builtin_amdgcn_s_barrier()
#define PG8_SCHED __builtin_amdgcn_sched_barrier(0)
  Unit cur, nxt; int ui = 0;
  if (!S.next(0, cur)) return;
  f32x4 acc[2][2][4][2];
#pragma unroll
  for (int a = 0; a < 2; ++a)
#pragma unroll
    for (int b = 0; b < 2; ++b)
#pragma unroll
      for (int m = 0; m < 4; ++m)
#pragma unroll
        for (int n = 0; n < 2; ++n) acc[a][b][m][n] = (f32x4){0.f, 0.f, 0.f, 0.f};
  bf16x8 At[4][2], B0[2][2], B1[2][2];
  const char* cA = (const char*)g.A + (size_t)cur.pm * tstep; const char* cB = (const char*)g.Bt + (size_t)cur.pn * tstep;
  PG8_STAGE(PG8_SB(0, 0), cB, voffB); PG8_STAGE(PG8_SA(0, 0), cA, voffA); PG8_STAGE(PG8_SB(0, 1), cB + hstep, voffB); PG8_STAGE(PG8_SA(0, 1), cA + hstep, voffA);
  if (wr == 1) PG8_BAR;
  PG8_WAIT_V(4); PG8_BAR;
  PG8_STAGE(PG8_SB(1, 0), cB + kstep, voffB); PG8_STAGE(PG8_SA(1, 0), cA + kstep, voffA); PG8_STAGE(PG8_SB(1, 1), cB + hstep + kstep, voffB);
  PG8_WAIT_V(6); PG8_BAR;
  for (;;) {
    const bool has_next = S.next(ui + 1, nxt);
    const char* nA = has_next ? (const char*)g.A + (size_t)nxt.pm * tstep : cA; const char* nB = has_next ? (const char*)g.Bt + (size_t)nxt.pn * tstep : cB;
    for (int t = 0; t < nt; t += 2) {
      const bool last = (t == nt - 2);
      const char* a1 = cA + (size_t)(t + 1) * kstep;
      const char* a2 = last ? nA : cA + (size_t)(t + 2) * kstep; const char* b2 = last ? nB : cB + (size_t)(t + 2) * kstep;
      const char* a3 = a2 + kstep; const char* b3 = b2 + kstep;
      PG8_LDB(B0, 0, 0); PG8_SCHED; PG8_LDA(At, 0, 0); PG8_STAGE(PG8_SA(1, 1), a1 + hstep, voffA);
      PG8_WAIT_L(8); PG8_BAR; PG8_WAIT_L(0); PG8_MMA(0, 0, At, B0); PG8_BAR; PG8_SCHED;
      PG8_LDB(B1, 0, 1); PG8_STAGE(PG8_SB(0, 0), b2, voffB);
      PG8_BAR; PG8_WAIT_L(0); PG8_MMA(0, 1, At, B1); PG8_BAR;
      PG8_LDA(At, 0, 1); PG8_STAGE(PG8_SA(0, 0), a2, voffA);
      PG8_BAR; PG8_WAIT_L(0); PG8_MMA(1, 0, At, B0); PG8_BAR; PG8_SCHED;
      PG8_STAGE(PG8_SB(0, 1), b2 + hstep, voffB);
      PG8_WAIT_V(6); PG8_BAR; PG8_MMA(1, 1, At, B1); PG8_BAR;
      PG8_LDB(B0, 1, 0); PG8_SCHED; PG8_LDA(At, 1, 0); PG8_STAGE(PG8_SA(0, 1), a2 + hstep, voffA);
      PG8_WAIT_L(8); PG8_BAR; PG8_WAIT_L(0); PG8_MMA(0, 0, At, B0); PG8_BAR; PG8_SCHED;
      PG8_LDB(B1, 1, 1); PG8_STAGE(PG8_SB(1, 0), b3, voffB);
      PG8_BAR; PG8_WAIT_L(0); PG8_MMA(0, 1, At, B1); PG8_BAR;
      PG8_LDA(At, 1, 1); PG8_STAGE(PG8_SA(1, 0), a3, voffA);
      PG8_BAR; PG8_WAIT_L(0); PG8_MMA(1, 0, At, B0); PG8_BAR; PG8_SCHED;
      PG8_STAGE(PG8_SB(1, 1), b3 + hstep, voffB);
      PG8_WAIT_V(6); PG8_BAR; PG8_MMA(1, 1, At, B1); PG8_BAR;
    }
    E(acc, cur, wr, wc, fr, fq);
    if (!has_next) break;
#pragma unroll
    for (int a = 0; a < 2; ++a)
#pragma unroll
      for (int b = 0; b < 2; ++b)
#pragma unroll
        for (int m = 0; m < 4; ++m)
#pragma unroll
          for (int n = 0; n < 2; ++n) acc[a][b][m][n] = (f32x4){0.f, 0.f, 0.f, 0.f};
    cur = nxt; cA = nA; cB = nB; ++ui;
  }
  PG8_WAIT_V(0);
  if (wr == 0) PG8_BAR;
  PG8_BAR;
#undef PG8_SA
#undef PG8_SB
#undef PG8_STAGE
#undef PG8_LDA
#undef PG8_LDB
#undef PG8_MMA
#undef PG8_WAIT_V
#undef PG8_WAIT_L
#undef PG8_BAR
#undef PG8_SCHED
}
}

template <class Epi>
DEVI void run_gemm(char* smem, const u16* A, const u16* Bt, int M, int N, int K, const Epi& E, int bid, int b0, int G) {
  pg8::StaticOrder S;
  asm volatile("" : "+s"(bid));
  const int c = (bid >= b0 && bid < b0 + G) ? (bid - b0) : (1 << 28);
  S.init(M, N, G, c);
  pg8::Gemm g{A, Bt, M, N, K};
  pg8::gemm_phase<Epi>((PG8_LAS unsigned char*)smem, g, S, E);
}

DEVI void hyfilter_phase(KP p, char* smem, int bid, int nb, int l_only = -1, size_t hoff = OFF_YRW) {
  float* z = (float*)smem;
  float* h1 = z + 16 * 33;
  float* h2 = h1 + 16 * 64;
  float* HRAW = (float*)(p->ws + hoff);
  const int tid = otid();
  for (int it = bid; it < 512; it += nb) {
    const int l = l_only, t0 = it * 16;
    const int slot_ = 0;
    const float* freq = p->in[I_HYFREQ] + l * 64;
    const float* w1 = p->in[I_HYW1] + l * 33 * 64;
    const float* b1 = p->in[I_HYB1] + l * 64;
    const float* w2 = p->in[I_HYW2] + l * 64 * 64;
    const float* b2 = p->in[I_HYB2] + l * 64;
    const float* w3 = p->in[I_HYW3] + l * 64 * 512;
    const float* dec = p->in[I_HYDEC] + l * 512;
    for (int e = tid; e < 16 * 33; e += NTHR) {
      int pos = e / 33, f = e % 33;
      int i = t0 + pos;
      float v;
      if (f == 0) {
        v = (float)i / (float)(L_ - 1);
      } else {
        int m = (f - 1) & 15;
        float band = 1e-4f + (float)m * ((15.f - 1e-4f) / 15.f);
        float ang = 6.283185307179586f * (float)i / (float)L_;
        float a = band * ang;
        v = (f <= 16) ? cosf(a) : -sinf(a);
      }
      z[pos * 33 + f] = v;
    }
    __syncthreads();
    {
      const int o = tid & 63;
      const float fo = freq[o], bo = b1[o];
#pragma unroll
      for (int i = 0; i < 16 / NWV; ++i) {
        int pos = (tid >> 6) + NWV * i;
        float s = bo;
#pragma unroll 11
        for (int f = 0; f < 33; ++f) s += z[pos * 33 + f] * w1[f * 64 + o];
        h1[pos * 64 + o] = sinf(fo * s);
      }
    }
    __syncthreads();
    {
      const int o = tid & 63;
      const float fo = freq[o], bo = b2[o];
#pragma unroll
      for (int i = 0; i < 16 / NWV; ++i) {
        int pos = (tid >> 6) + NWV * i;
        float s = bo;
#pragma unroll 16
        for (int f = 0; f < 64; ++f) s += h1[pos * 64 + f] * w2[f * 64 + o];
        h2[pos * 64 + o] = sinf(fo * s);
      }
    }
    __syncthreads();
#pragma unroll 1
    for (int cc = 0; cc < 512 / NTHR; ++cc) {
      const int ch = tid + NTHR * cc;
      float acc[16];
#pragma unroll
      for (int q = 0; q < 16; ++q) acc[q] = 0.f;
#pragma unroll 8
      for (int o = 0; o < 64; ++o) {
        float w = w3[o * 512 + ch];
#pragma unroll
        for (int q = 0; q < 16; ++q) acc[q] += h2[q * 64 + o] * w;
      }
      const float dc = dec[ch];
      float* dst = HRAW + ((size_t)(slot_ * 512 + ch)) * L_ + t0;
#pragma unroll
      for (int q = 0; q < 16; ++q) {
        float tp = (float)(t0 + q) / (float)(L_ - 1);
        dst[q] = acc[q] * __expf(-tp * dc);
      }
    }
    __syncthreads();
  }
}

DEVI void hynorm_phase(KP p, char* smem, int bid, int nb, int l_only = -1, size_t hoff = OFF_YRW) {
  float* red = (float*)smem;
  const float* HRAW = (const float*)(p->ws + hoff);
  u16* RK = (u16*)(p->ws + OFF_RK);
  const int tid = otid();
  for (int it0_ = bid; it0_ < 256; it0_ += nb) {
    const int l = l_only, c = it0_;
    const int slot_ = 0;
    const int it = l * 256 + c;
    const float* hf = HRAW + ((size_t)(slot_ * 512 + c)) * L_;
    const float* hb = HRAW + ((size_t)(slot_ * 512 + 256 + c)) * L_;
    float s = 0.f;
    for (int t = tid; t < L_; t += NTHR) {
      s += fabsf(hf[t]);
      if (t > 0) s += fabsf(hb[t]);
    }
    s = wavesum(s);
    if ((tid & 63) == 0) red[tid >> 6] = s;
    __syncthreads();
    float tot = 0.f;
    for (int w = 0; w < NWV; ++w) tot += red[w];
    const float inv = 1.f / tot;
    u16* dst = RK + (size_t)it * 16384;
    for (int i = tid; i < 16384; i += NTHR) {
      int m = i - 8192;
      float v;
      if (m == -8192) v = 0.f;
      else if (m <= 0) v = hf[-m] * inv;
      else v = hb[m] * inv;
      dst[i] = f2bf(v);
    }
    __syncthreads();
  }
}

DEVI float ldP(const u16* P, int b, int t, int col) {
  return (t >= 0 && t < L_) ? bf2f(P[((size_t)(b * L_ + t)) * INC + col]) : 0.f;
}
DEVI uint4 ldrow8(const u16* P, int b, int t, int col);
DEVI void ld8f(const float* __restrict__ g, float* o);
DEVI void hyprep_phase(KP p, int l, char* smem, int bid, int nb) {
  float* tileU = (float*)smem;
  float* tileX = tileU + 64 * 65;
  const u16* P = (const u16*)(p->ws + OFF_BIG);
  u16* UB = (u16*)(p->ws + OFF_UB);
  u16* X0 = (u16*)(p->ws + OFF_X0);
  const float* cw = p->in[I_HYCW] + l * 3 * 768;
  const float* cb = p->in[I_HYCB] + l * 768;
  const int tid = otid();
  for (int it = bid; it < 2048; it += nb) {
    const int ct = it & 3, tt = (it >> 2) & 127, b = it >> 9;
    const int c0 = ct * 64, t0 = tt * 64;
    {
      const int tl = tid >> 3, cg = tid & 7, t = t0 + tl, c = c0 + cg * 8;
      float xs[3][8];
#pragma unroll
      for (int a3 = 0; a3 < 3; ++a3) {
        float pm[8], p0[8], pp[8], w0[8], w1[8], w2[8], bb[8];
        unpack8(ldrow8(P, b, t - 1, a3 * 256 + c), pm);
        unpack8(ldrow8(P, b, t, a3 * 256 + c), p0);
        unpack8(ldrow8(P, b, t + 1, a3 * 256 + c), pp);
        ld8f(cw + a3 * 256 + c, w0); ld8f(cw + 768 + a3 * 256 + c, w1); ld8f(cw + 1536 + a3 * 256 + c, w2);
        ld8f(cb + a3 * 256 + c, bb);
#pragma unroll
        for (int e = 0; e < 8; ++e) xs[a3][e] = w0[e] * pm[e] + w1[e] * p0[e] + w2[e] * pp[e] + bb[e];
      }
#pragma unroll
      for (int e = 0; e < 8; ++e) {
        tileU[tl * 65 + cg * 8 + e] = xs[1][e] * xs[2][e];
        tileX[tl * 65 + cg * 8 + e] = xs[0][e];
      }
    }
    __syncthreads();
    {
      const int cc = tid >> 3, tq = tid & 7;
      float u8[8], x8[8];
#pragma unroll
      for (int e = 0; e < 8; ++e) { u8[e] = tileU[(tq * 8 + e) * 65 + cc]; x8[e] = tileX[(tq * 8 + e) * 65 + cc]; }
      *(uint4*)(UB + ((size_t)((c0 + cc) * 4 + b)) * UBS + 1024 + t0 + tq * 8) = pack8(u8);
      *(uint4*)(X0 + ((size_t)((c0 + cc) * 4 + b)) * L_ + t0 + tq * 8) = pack8(x8);
    }
    if (tt == 0 || tt == 127) {
      const int poff = (tt == 0) ? 0 : (1024 + L_);
      for (int e = tid; e < 64 * 128; e += NTHR) {
        int cc = e >> 7, q = e & 127;
        *(uint4*)(UB + ((size_t)((c0 + cc) * 4 + b)) * UBS + poff + q * 8) = make_uint4(0, 0, 0, 0);
      }
    }
    __syncthreads();
  }
}

DEVI void hyconv_item(KP p, int l, int item, char* smem) {
  const int tid_ = otid();
  const int lane = tid_ & 63, wv = tid_ >> 6;
  const int fr = lane & 15, fq = lane >> 4;
  const int c = item, it32 = wv;
  const int a = it32 * 32;
  u16* sU = (u16*)smem;
  unsigned* sK = (unsigned*)(smem + 4 * UBS * 2);
  {
    const uint4* gu = (const uint4*)((const u16*)(p->ws + OFF_UB) + (size_t)(c * 4) * UBS);
    const uint4* gk = (const uint4*)((const u16*)(p->ws + OFF_RK) + (size_t)(l * 256 + c) * 16384);
    __syncthreads();
    for (int i = tid_; i < 4 * UBS / 8; i += NTHR) ((uint4*)sU)[i] = gu[i];
    for (int i = tid_; i < 16384 / 8; i += NTHR) ((uint4*)sK)[i] = gk[i];
    __syncthreads();
  }
  f32x4 acc[2][8];
#pragma unroll
  for (int m = 0; m < 2; ++m)
#pragma unroll
    for (int n = 0; n < 8; ++n) acc[m][n] = f32x4{0.f, 0.f, 0.f, 0.f};
#pragma unroll 1
  for (int D = a + 31; D >= a - 255; --D) {
    bf16x8 af[2];
#pragma unroll
    for (int mt = 0; mt < 2; ++mt) {
      int idx = fq * 8 - (mt * 16 + fr) - 32 * D + 8192;
      int bd = idx >> 1;
      unsigned sh = (idx & 1) * 16;
      unsigned d0 = sK[bd], d1 = sK[bd + 1], d2 = sK[bd + 2], d3 = sK[bd + 3], d4 = sK[bd + 4];
      union { unsigned u[4]; bf16x8 v; } cv;
      cv.u[0] = __builtin_amdgcn_alignbit(d1, d0, sh);
      cv.u[1] = __builtin_amdgcn_alignbit(d2, d1, sh);
      cv.u[2] = __builtin_amdgcn_alignbit(d3, d2, sh);
      cv.u[3] = __builtin_amdgcn_alignbit(d4, d3, sh);
      af[mt] = cv.v;
    }
#pragma unroll
    for (int n = 0; n < 8; ++n) {
      const int b = n >> 1, ct = n & 1;
      const int i1 = a + ct * 16 + fr;
      bf16x8 bf = *(const bf16x8*)(sU + b * UBS + 1024 + (i1 - D) * 32 + fq * 8);
      acc[0][n] = __builtin_amdgcn_mfma_f32_16x16x32_bf16(af[0], bf, acc[0][n], 0, 0, 0);
      acc[1][n] = __builtin_amdgcn_mfma_f32_16x16x32_bf16(af[1], bf, acc[1][n], 0, 0, 0);
    }
  }
  const u16* X0 = (const u16*)(p->ws + OFF_X0) + (size_t)(c * 4) * L_;
  u16* Yo = (u16*)(p->ws + OFF_HN);
  const float bias = p->in[I_HYBIAS][l * 256 + c];
#pragma unroll
  for (int n = 0; n < 8; ++n) {
    const int b = n >> 1, ct = n & 1;
    const int i1 = a + ct * 16 + fr;
#pragma unroll
    for (int mt = 0; mt < 2; ++mt) {
      const int t = i1 * 32 + mt * 16 + fq * 4;
      const uint2 xr = *(const uint2*)(X0 + (size_t)b * L_ + t);
      const uint2 ur = *(const uint2*)(sU + b * UBS + 1024 + t);
      const float x0[4] = {bflo(xr.x), bfhi(xr.x), bflo(xr.y), bfhi(xr.y)};
      const float uu[4] = {bflo(ur.x), bfhi(ur.x), bflo(ur.y), bfhi(ur.y)};
#pragma unroll
      for (int j = 0; j < 4; ++j)
        Yo[((size_t)(b * L_ + t + j)) * DM + c] = f2bf(x0[j] * (acc[mt][n][j] + bias * uu[j]));
    }
  }
}

DEVI uint4 ldrow8(const u16* P, int b, int t, int col) {
  if (t < 0 || t >= L_) return make_uint4(0, 0, 0, 0);
  return *(const uint4*)(P + ((size_t)(b * L_ + t)) * INC + col);
}
DEVI void shift8(uint4 pm, uint4 p0, uint4 pp, const float* __restrict__ mup, const float* __restrict__ mun,
                 float* out) {
  float a[8], u[8], n[8];
  unpack8(pm, a); unpack8(p0, u); unpack8(pp, n);
  float4 m0 = *(const float4*)mup, m1 = *(const float4*)(mup + 4);
  float4 n0 = *(const float4*)mun, n1 = *(const float4*)(mun + 4);
  float mp[8] = {m0.x, m0.y, m0.z, m0.w, m1.x, m1.y, m1.z, m1.w};
  float mn[8] = {n0.x, n0.y, n0.z, n0.w, n1.x, n1.y, n1.z, n1.w};
#pragma unroll
  for (int e = 0; e < 8; ++e) out[e] = u[e] + mp[e] * (a[e] - u[e]) + mn[e] * (n[e] - u[e]);
}
DEVI void ld8f(const float* __restrict__ g, float* o) {
  float4 a = *(const float4*)g, b = *(const float4*)(g + 4);
  o[0] = a.x; o[1] = a.y; o[2] = a.z; o[3] = a.w; o[4] = b.x; o[5] = b.y; o[6] = b.z; o[7] = b.w;
}
DEVI void st8f(float* s, const float* v) {
  *(float4*)s = make_float4(v[0], v[1], v[2], v[3]);
  *(float4*)(s + 4) = make_float4(v[4], v[5], v[6], v[7]);
}

DEVI float dot8(const f32x2 (&S)[4], const float4& a, const float4& b) {
  f32x2 t = S[0] * f32x2{a.x, a.y};
  f32x2 u = S[1] * f32x2{a.z, a.w};
  t = __builtin_elementwise_fma(S[2], f32x2{b.x, b.y}, t);
  u = __builtin_elementwise_fma(S[3], f32x2{b.z, b.w}, u);
  t += u;
  return t.x + t.y;
}

DEVI void rwscan_pc_item(KP p, int l, int item, char* smem) {
  const int tid = otid();
  const int lane = tid & 63, wv = tid >> 6;
  const bool cons = wv < 4;
  const int fr = lane & 15, fq = lane >> 4;
  const int rg2 = item & 1, d = (item >> 1) & 1, bh = item >> 2, h = bh % 6, b = bh / 6;
  constexpr int BUFF = 12352;
  float* s_buf = (float*)smem;
  float* s_a = s_buf + 2 * BUFF;
  u16* s_lw = (u16*)(s_a + 2048);
  u16* s_la = s_lw + 32 * 72;
  float* s_y = (float*)(s_la + 32 * 72);
  float* s_mu = s_y + 1024;
  const u16* P = (const u16*)(p->ws + OFF_BIG);
  u16* Yd = (u16*)(p->ws + OFF_YRW) + (size_t)d * T_ * 384;
  const float* mup = p->in[I_MUP] + l * 1536;
  const float* mun = p->in[I_MUN] + l * 1536;
  const int pt = tid & 255, tl = pt >> 3, jg = pt & 7, pw = wv & 3;
  const int cr = 768 + h * 64 + jg * 8, ck = 1152 + h * 64 + jg * 8, cvv = 1536 + h * 64 + jg * 8;
  const int clw = 1920 + d * 64 + jg * 8, cla = 2048 + d * 64 + jg * 8;
  bf16x8 fW[2], fA[2];
  {
    const float* Wl = p->in[I_WLORA] + (size_t)(l * 2 + d) * 64 * 384 + h * 64 + pw * 16 + fr;
    const float* Al = p->in[I_ALORA] + (size_t)(l * 2 + d) * 64 * 384 + h * 64 + pw * 16 + fr;
#pragma unroll
    for (int ks = 0; ks < 2; ++ks) {
#pragma unroll
      for (int e = 0; e < 8; ++e) {
        int r = ks * 32 + fq * 8 + e;
        fW[ks][e] = (short)f2bf(Wl[r * 384]);
        fA[ks][e] = (short)f2bf(Al[r * 384]);
      }
    }
  }
  const float w0v = p->in[I_W0][(l * 2 + d) * 384 + h * 64 + pw * 16 + fr];
  const float a0v = p->in[I_A0][(l * 2 + d) * 384 + h * 64 + pw * 16 + fr];
  for (int e = tid; e < 768; e += NTHR) {
    float v;
    if (e < 640) {
      const int a5 = (e % 320) >> 6, j = e & 63;
      const int base = (a5 < 3) ? (a5 * 384 + h * 64) : (1152 + (a5 - 3) * 128 + d * 64);
      v = ((e < 320) ? mup : mun)[base + j];
    } else {
      v = ((e < 704) ? p->in[I_KK] : p->in[I_KA])[l * 384 + h * 64 + (e & 63)];
    }
    s_mu[e] = v;
  }
  __syncthreads();
  const int row8 = lane >> 3, e8 = lane & 7;
  const int rowi = rg2 * 32 + pw * 8 + row8;
  const int j8 = e8 * 8;
  f32x2 S[4];
#pragma unroll
  for (int i = 0; i < 4; ++i) S[i] = f32x2{0.f, 0.f};

  uint4 q[15];
#pragma unroll
  for (int i = 0; i < 15; ++i) q[i] = make_uint4(0, 0, 0, 0);
  if (!cons) {
    int t = d ? (L_ - 1 - tl) : tl;
#pragma unroll
    for (int dt = 0; dt < 3; ++dt) {
      q[0 + dt] = ldrow8(P, b, t + dt - 1, cr);
      q[3 + dt] = ldrow8(P, b, t + dt - 1, ck);
      q[6 + dt] = ldrow8(P, b, t + dt - 1, cvv);
      q[9 + dt] = ldrow8(P, b, t + dt - 1, clw);
      q[12 + dt] = ldrow8(P, b, t + dt - 1, cla);
    }
  }
  float kv[8], kkn[8];
#pragma unroll
  for (int e = 0; e < 8; ++e) { kv[e] = 0.f; kkn[e] = 0.f; }
  float yacc = 0.f;

  struct RwOps { float4 ka, kb, ra, rb; float vi; float2 sc; };
  struct RwUpd { float4 da, db, ba, bb, wa, wb; };
  auto scan_seg = [&](const float* cb, int seg) {
    auto ldops = [&](int s) {
      RwOps r;
      const float* o = cb + 2048 + s * 64 + j8;
      r.ka = *(const float4*)(o); r.kb = *(const float4*)(o + 4);
      r.ra = *(const float4*)(o - 2048); r.rb = *(const float4*)(o - 2048 + 4);
      r.vi = cb[10240 + s * 64 + rowi];
      r.sc = *(const float2*)(cb + 12288 + s * 2);
      return r;
    };
    auto ldupd = [&](int s) {
      RwUpd r;
      const float* o = cb + 2048 + s * 64 + j8;
      r.da = *(const float4*)(o + 2048); r.db = *(const float4*)(o + 2048 + 4);
      r.ba = *(const float4*)(o + 4096); r.bb = *(const float4*)(o + 4096 + 4);
      r.wa = *(const float4*)(o + 6144); r.wb = *(const float4*)(o + 6144 + 4);
      return r;
    };
    RwOps cur = ldops(seg * 8);
#pragma unroll
    for (int i_ = 0; i_ < 8; ++i_) {
      const int s = seg * 8 + i_;
      const RwUpd up = ldupd(s);
      const RwOps nxt = ldops(seg * 8 + ((i_ + 1) & 7));
      float dA = dot8(S, cur.ka, cur.kb);
      float dB = dot8(S, cur.ra, cur.rb);
      const f32x2 vi2 = f32x2{cur.vi, cur.vi};
      const f32x2 A0 = __builtin_elementwise_fma(S[0], f32x2{up.wa.x, up.wa.y}, vi2 * f32x2{up.da.x, up.da.y});
      const f32x2 A1 = __builtin_elementwise_fma(S[1], f32x2{up.wa.z, up.wa.w}, vi2 * f32x2{up.da.z, up.da.w});
      const f32x2 A2 = __builtin_elementwise_fma(S[2], f32x2{up.wb.x, up.wb.y}, vi2 * f32x2{up.db.x, up.db.y});
      const f32x2 A3 = __builtin_elementwise_fma(S[3], f32x2{up.wb.z, up.wb.w}, vi2 * f32x2{up.db.z, up.db.w});
      const float sa = allsum8(dA);
      dB = allsum8(dB);
      const float y = dB + sa * cur.sc.x + cur.vi * cur.sc.y;
      const f32x2 sa2 = f32x2{sa, sa};
      S[0] = __builtin_elementwise_fma(sa2, f32x2{up.ba.x, up.ba.y}, A0);
      S[1] = __builtin_elementwise_fma(sa2, f32x2{up.ba.z, up.ba.w}, A1);
      S[2] = __builtin_elementwise_fma(sa2, f32x2{up.bb.x, up.bb.y}, A2);
      S[3] = __builtin_elementwise_fma(sa2, f32x2{up.bb.z, up.bb.w}, A3);
      yacc = (e8 == i_) ? y : yacc;
      cur = nxt;
    }
    s_y[(seg * 8 + e8) * 32 + pw * 8 + row8] = yacc;
  };

  constexpr int NC = L_ / 32;
  if (cons) {
    for (int c = 0; c <= NC; ++c) {
      const float* cb = s_buf + ((c + 1) & 1) * BUFF;
      const bool cact = c >= 1;
      if (cact) scan_seg(cb, 0);
      __syncthreads();
      if (cact) scan_seg(cb, 1);
      __syncthreads();
      if (cact) scan_seg(cb, 2);
      __syncthreads();
    if (cact) {
        scan_seg(cb, 3);
        const int t2 = lane >> 1, hf = lane & 1;
        const float4 o4 = *(const float4*)(s_y + t2 * 32 + pw * 8 + hf * 4);
        const int ts = (c - 1) * 32 + t2;
        const int t = d ? (L_ - 1 - ts) : ts;
        uint2 o; o.x = pack2(o4.x, o4.y); o.y = pack2(o4.z, o4.w);
        *(uint2*)(Yd + ((size_t)(b * L_ + t)) * 384 + h * 64 + rg2 * 32 + pw * 8 + hf * 4) = o;
      }
    __syncthreads();
    }
  } else {
    const float* mp_ = s_mu + jg * 8;
    const float* mn_ = s_mu + 320 + jg * 8;
    for (int c = 0; c <= NC; ++c) {
      float* pb = s_buf + (c & 1) * BUFF;
      const bool pact = c < NC;
      const bool pnext = c + 1 < NC;
      const int tn_ = (c + 1) * 32 + tl;
      const int tnx = d ? (L_ - 1 - tn_) : tn_;
      const u16* rw0_ = P + ((size_t)(b * L_ + tnx)) * INC;
      const u16* rk0 = rw0_ + (h * 64 + jg * 8);
      const u16* rl0 = rw0_ + (d * 64 + jg * 8);
      const bool edge = pnext && (c + 1 == NC - 1);
      const bool zm = edge && (tnx - 1 < 0), zp = edge && (tnx + 1 >= L_);
      const uint4 zero4 = make_uint4(0, 0, 0, 0);
      if (pact) {
        float rr[8], lw[8], la[8];
        shift8(q[9], q[10], q[11], mp_ + 192, mn_ + 192, lw);
        shift8(q[12], q[13], q[14], mp_ + 256, mn_ + 256, la);
        shift8(q[0], q[1], q[2], mp_, mn_, rr);
#pragma unroll
        for (int e = 0; e < 8; ++e) lw[e] = 1.f - 2.f * frcp(1.f + __expf(2.f * lw[e]));
        *(uint4*)(s_lw + tl * 72 + jg * 8) = pack8(lw);
        *(uint4*)(s_la + tl * 72 + jg * 8) = pack8(la);
        st8f(pb + tl * 64 + jg * 8, rr);
      }
      if (pnext) {
        q[9] = *(const uint4*)(rl0 + 1920 - INC); q[10] = *(const uint4*)(rl0 + 1920); q[11] = *(const uint4*)(rl0 + 1920 + INC);
        q[12] = *(const uint4*)(rl0 + 2048 - INC); q[13] = *(const uint4*)(rl0 + 2048); q[14] = *(const uint4*)(rl0 + 2048 + INC);
        q[0] = *(const uint4*)(rk0 + 768 - INC); q[1] = *(const uint4*)(rk0 + 768); q[2] = *(const uint4*)(rk0 + 768 + INC);
        if (edge) {
          if (zm) { q[9] = zero4; q[12] = zero4; q[0] = zero4; }
          if (zp) { q[11] = zero4; q[14] = zero4; q[2] = zero4; }
        }
      }
      __syncthreads();
      if (pact) {
#pragma unroll
        for (int mt = 0; mt < 2; ++mt) {
          f32x4 aw = {0.f, 0.f, 0.f, 0.f}, aa = {0.f, 0.f, 0.f, 0.f};
#pragma unroll
          for (int ks = 0; ks < 2; ++ks) {
            bf16x8 xw = *(const bf16x8*)(s_lw + (mt * 16 + fr) * 72 + ks * 32 + fq * 8);
            bf16x8 xa = *(const bf16x8*)(s_la + (mt * 16 + fr) * 72 + ks * 32 + fq * 8);
            aw = __builtin_amdgcn_mfma_f32_16x16x32_bf16(xw, fW[ks], aw, 0, 0, 0);
            aa = __builtin_amdgcn_mfma_f32_16x16x32_bf16(xa, fA[ks], aa, 0, 0, 0);
          }
#pragma unroll
          for (int j = 0; j < 4; ++j) {
            int t2 = mt * 16 + fq * 4 + j, jj = pw * 16 + fr;
            pb[8192 + t2 * 64 + jj] = __expf(-0.606531f * sigm(aw[j] + w0v));
            s_a[t2 * 64 + jj] = sigm(aa[j] + a0v);
          }
        }
        float vv[8];
        shift8(q[6], q[7], q[8], mp_ + 128, mn_ + 128, vv);
        st8f(pb + 10240 + tl * 64 + jg * 8, vv);
      }
      if (pnext) {
        q[6] = *(const uint4*)(rk0 + 1536 - INC); q[7] = *(const uint4*)(rk0 + 1536); q[8] = *(const uint4*)(rk0 + 1536 + INC);
        if (edge) { if (zm) q[6] = zero4; if (zp) q[8] = zero4; }
      }
      __syncthreads();
      if (pact) {
        shift8(q[3], q[4], q[5], mp_ + 64, mn_ + 64, kv);
        float kkc[8];
        ld8f(s_mu + 640 + jg * 8, kkc);
        float ss = 0.f;
#pragma unroll
        for (int e = 0; e < 8; ++e) { kkn[e] = kv[e] * kkc[e]; ss += kkn[e] * kkn[e]; }
        ss = allsum8(ss);
        const float inv = rsqrtf(ss + 1e-6f);
        float nk[8];
#pragma unroll
        for (int e = 0; e < 8; ++e) { kkn[e] *= inv; nk[e] = -kkn[e]; }
        st8f(pb + 2048 + tl * 64 + jg * 8, nk);
      }
      if (pnext) {
        q[3] = *(const uint4*)(rk0 + 1152 - INC); q[4] = *(const uint4*)(rk0 + 1152); q[5] = *(const uint4*)(rk0 + 1152 + INC);
        if (edge) { if (zm) q[3] = zero4; if (zp) q[5] = zero4; }
      }
      __syncthreads();
      if (pact) {
        float av[8], kac[8], kd[8], bb[8], rr[8], wv8[8];
        ld8f(s_a + tl * 64 + jg * 8, av);
        ld8f(pb + tl * 64 + jg * 8, rr);
        ld8f(pb + 8192 + tl * 64 + jg * 8, wv8);
        ld8f(s_mu + 704 + jg * 8, kac);
        float br = 0.f, kr = 0.f;
#pragma unroll
        for (int e = 0; e < 8; ++e) {
          kd[e] = kv[e] * (1.f + (av[e] - 1.f) * kac[e]);
          bb[e] = kkn[e] * av[e];
          br += bb[e] * rr[e];
          kr += kd[e] * rr[e];
          rr[e] *= wv8[e];
        }
        br = allsum8(br);
        kr = allsum8(kr);
        st8f(pb + 4096 + tl * 64 + jg * 8, kd);
        st8f(pb + 6144 + tl * 64 + jg * 8, bb);
        st8f(pb + tl * 64 + jg * 8, rr);
        if (jg == 0) *(float2*)(pb + 12288 + tl * 2) = make_float2(br, kr);
      }
      __syncthreads();
    }
  }
}

DEVI void gdscan_pc_item(KP p, int l, int item, char* smem) {
  const int tid = otid();
  const int lane = tid & 63, wv = tid >> 6;
  const bool cons = wv < 4;
  const int rg2 = item & 1, d = (item >> 1) & 1, bh = item >> 2, h = bh % 6, b = bh / 6;
  constexpr int BUFF = 6272;
  float* s_buf = (float*)smem;
  float* s_y = s_buf + 2 * BUFF;
  const u16* P = (const u16*)(p->ws + OFF_BIG);
  u16* Yd = (u16*)(p->ws + OFF_YGD) + (size_t)d * T_ * 384;
  const float* cw = p->in[I_GCW] + l * 3 * 1152;
  const int pt = tid & 255, tl = pt >> 3, jg = pt & 7, pw = wv & 3;
  const int lq = h * 64 + jg * 8, lk = 384 + lq, lv = 768 + lq;
  const float negA = -__expf(p->in[I_GALOG][(l * 2 + d) * 6 + h]);
  const float dtb = p->in[I_GDT][(l * 2 + d) * 6 + h];
  const int cag = 3840 + d * 6 + h, cbg = 3852 + d * 6 + h;
  const int row8 = lane >> 3, e8 = lane & 7;
  const int col_e = rg2 * 32 + pw * 8 + row8;
  const int j8 = e8 * 8;
  f32x2 S[4];
#pragma unroll
  for (int i = 0; i < 4; ++i) S[i] = f32x2{0.f, 0.f};
  float yacc = 0.f;

  uint4 q[9];
#pragma unroll
  for (int i = 0; i < 9; ++i) q[i] = make_uint4(0, 0, 0, 0);
  u16 rag = 0, rbg = 0;
  if (!cons) {
    int t = d ? (L_ - 1 - tl) : tl;
#pragma unroll
    for (int dt = 0; dt < 3; ++dt) {
      q[0 + dt] = ldrow8(P, b, t + dt - 1, 2304 + lq);
      q[3 + dt] = ldrow8(P, b, t + dt - 1, 2304 + lk);
      q[6 + dt] = ldrow8(P, b, t + dt - 1, 2304 + lv);
    }
    { const u16* pr_ = P + ((size_t)(b * L_ + t)) * INC; rag = pr_[cag]; rbg = pr_[cbg]; }
  }
  struct GdOps { float4 ka, kb, qa, qb, sc; float ve; };
  auto scan_seg = [&](const float* cb, int seg) {
    auto ldops = [&](int s) {
      GdOps r;
      const float* o = cb + 2048 + s * 64 + j8;
      r.ka = *(const float4*)(o); r.kb = *(const float4*)(o + 4);
      r.qa = *(const float4*)(o - 2048); r.qb = *(const float4*)(o - 2048 + 4);
      r.ve = cb[4096 + s * 64 + col_e];
      r.sc = *(const float4*)(cb + 6144 + s * 4);
      return r;
    };
    GdOps cur = ldops(seg * 16);
#pragma unroll
    for (int i_ = 0; i_ < 16; ++i_) {
      const int s = seg * 16 + i_;
      const GdOps nxt = ldops(seg * 16 + ((i_ + 1) & 15));
      const float al = cur.sc.x, be = cur.sc.y, qk = cur.sc.z, nab = cur.sc.w;
      float d1 = dot8(S, cur.ka, cur.kb);
      float d2 = dot8(S, cur.qa, cur.qb);
      const f32x2 al2 = f32x2{al, al};
      const f32x2 A0 = S[0] * al2, A1 = S[1] * al2, A2 = S[2] * al2, A3 = S[3] * al2;
      const float bv = be * cur.ve;
      d1 = allsum8(d1);
      d2 = allsum8(d2);
      const float vn = __builtin_fmaf(nab, d1, bv);
      const float ov = al * d2 + qk * vn;
      const f32x2 vn2 = f32x2{vn, vn};
      S[0] = __builtin_elementwise_fma(vn2, f32x2{cur.ka.x, cur.ka.y}, A0);
      S[1] = __builtin_elementwise_fma(vn2, f32x2{cur.ka.z, cur.ka.w}, A1);
      S[2] = __builtin_elementwise_fma(vn2, f32x2{cur.kb.x, cur.kb.y}, A2);
      S[3] = __builtin_elementwise_fma(vn2, f32x2{cur.kb.z, cur.kb.w}, A3);
      yacc = (e8 == (i_ & 7)) ? ov : yacc;
      if ((i_ & 7) == 7) s_y[(s - 7 + e8) * 32 + pw * 8 + row8] = yacc;
      cur = nxt;
    }
  };
  __syncthreads();
  constexpr int NC = L_ / 32;
  for (int c = 0; c <= NC; ++c) {
    float* pb = s_buf + (c & 1) * BUFF;
    const float* cb = s_buf + ((c + 1) & 1) * BUFF;
    const bool pact = !cons && c < NC, cact = cons && c >= 1;
    if (pact) {
      float qq[8], kk[8], vv[8];
#pragma unroll
      for (int arr = 0; arr < 3; ++arr) {
        float a[8], u[8], n[8], w0[8], w1[8], w2[8];
        unpack8(q[arr * 3 + 0], a); unpack8(q[arr * 3 + 1], u); unpack8(q[arr * 3 + 2], n);
        const int lc = (arr == 0) ? lq : (arr == 1 ? lk : lv);
        ld8f(cw + lc, w0); ld8f(cw + 1152 + lc, w1); ld8f(cw + 2304 + lc, w2);
        float* o = (arr == 0) ? qq : (arr == 1 ? kk : vv);
#pragma unroll
        for (int e = 0; e < 8; ++e) o[e] = siluf(w0[e] * a[e] + w1[e] * u[e] + w2[e] * n[e]);
      }
      float sq = 0.f, sk = 0.f;
#pragma unroll
      for (int e = 0; e < 8; ++e) { sq += qq[e] * qq[e]; sk += kk[e] * kk[e]; }
      sq = allsum8(sq); sk = allsum8(sk);
      const float iq = rsqrtf(sq + 1e-6f) * 0.125f, ik = rsqrtf(sk + 1e-6f);
      float qk = 0.f;
#pragma unroll
      for (int e = 0; e < 8; ++e) { qq[e] *= iq; kk[e] *= ik; qk += qq[e] * kk[e]; }
      qk = allsum8(qk);
      st8f(pb + tl * 64 + jg * 8, qq);
      st8f(pb + 2048 + tl * 64 + jg * 8, kk);
      st8f(pb + 4096 + tl * 64 + jg * 8, vv);
      if (jg == 0) {
        float x = bf2f(rag) + dtb;
        float sp = (x > 20.f) ? x : log1pf(__expf(x));
        const float al_ = __expf(negA * sp), be_ = sigm(bf2f(rbg));
        *(float4*)(pb + 6144 + tl * 4) = make_float4(al_, be_, qk, -al_ * be_);
      }
    }
    if (cact) scan_seg(cb, 0);
    __syncthreads();
    if (!cons && c + 1 < NC) {
      int tn = (c + 1) * 32 + tl;
      int t = d ? (L_ - 1 - tn) : tn;
#pragma unroll
      for (int dt = 0; dt < 3; ++dt) {
        q[0 + dt] = ldrow8(P, b, t + dt - 1, 2304 + lq);
        q[3 + dt] = ldrow8(P, b, t + dt - 1, 2304 + lk);
        q[6 + dt] = ldrow8(P, b, t + dt - 1, 2304 + lv);
      }
      { const u16* pr_ = P + ((size_t)(b * L_ + t)) * INC; rag = pr_[cag]; rbg = pr_[cbg]; }
    }
    if (cact) {
      scan_seg(cb, 1);
      const int t2 = lane >> 1, hf = lane & 1;
      const float4 o4 = *(const float4*)(s_y + t2 * 32 + pw * 8 + hf * 4);
      const int ts = (c - 1) * 32 + t2;
      const int t = d ? (L_ - 1 - ts) : ts;
      uint2 o; o.x = pack2(o4.x, o4.y); o.y = pack2(o4.z, o4.w);
      *(uint2*)(Yd + ((size_t)(b * L_ + t)) * 384 + h * 64 + rg2 * 32 + pw * 8 + hf * 4) = o;
    }
    __syncthreads();
  }
}

DEVI void post_tok_item(KP p, int l, int item, char* smem) {
  const int tid = otid();
  const int tl = tid >> 3, jg = tid & 7;
  u16* s_sg = (u16*)smem;
  float* s_gate = (float*)(smem + 64 * 136 * 2);
  const u16* P = (const u16*)(p->ws + OFF_BIG);
  const u16* YR = (const u16*)(p->ws + OFF_YRW);
  const u16* YG = (const u16*)(p->ws + OFF_YGD);
  u16* Yo = (u16*)(p->ws + OFF_HN);
  const float* mup = p->in[I_MUP] + l * 1536;
  const float* mun = p->in[I_MUN] + l * 1536;
  const int tok = item * 64 + tl;
  const int b = tok / L_, t = tok % L_;
#pragma unroll
  for (int half = 0; half < 2; ++half) {
    const int col = 2176 + jg * 16 + half * 8;
    float lg[8];
    shift8(ldrow8(P, b, t - 1, col), ldrow8(P, b, t, col), ldrow8(P, b, t + 1, col), mup + (col - 768),
           mun + (col - 768), lg);
#pragma unroll
    for (int e = 0; e < 8; ++e) lg[e] = sigm(lg[e]);
    *(uint4*)(s_sg + tl * 136 + jg * 16 + half * 8) = pack8(lg);
  }
  __syncthreads();
  {
    const int lane = tid & 63, wv = tid >> 6, fr = lane & 15, fq = lane >> 4;
    const u16* GT = (const u16*)(p->ws + OFF_WKV);
    f32x4 acc[4][3];
#pragma unroll
    for (int m = 0; m < 4; ++m)
#pragma unroll
      for (int n = 0; n < 3; ++n) acc[m][n] = f32x4{0.f, 0.f, 0.f, 0.f};
#pragma unroll
    for (int ks = 0; ks < 4; ++ks) {
      bf16x8 af[4], bfr[3];
#pragma unroll
      for (int m = 0; m < 4; ++m) af[m] = *(const bf16x8*)(s_sg + (m * 16 + fr) * 136 + ks * 32 + fq * 8);
#pragma unroll
      for (int n = 0; n < 3; ++n) bfr[n] = *(const bf16x8*)(GT + ((wv * 3 + n) * 16 + fr) * 128 + ks * 32 + fq * 8);
#pragma unroll
      for (int m = 0; m < 4; ++m)
#pragma unroll
        for (int n = 0; n < 3; ++n) acc[m][n] = __builtin_amdgcn_mfma_f32_16x16x32_bf16(af[m], bfr[n], acc[m][n], 0, 0, 0);
    }
#pragma unroll
    for (int m = 0; m < 4; ++m)
#pragma unroll
      for (int n = 0; n < 3; ++n)
#pragma unroll
        for (int j = 0; j < 4; ++j) s_gate[(m * 16 + fq * 4 + j) * 388 + (wv * 3 + n) * 16 + fr] = acc[m][n][j];
  }
  __syncthreads();
  for (int h = 0; h < 6; ++h) {
    const int hc = h * 64 + jg * 8;
    {
      float y[8], yb8[8];
      unpack8(*(const uint4*)(YR + (size_t)tok * 384 + hc), y);
      unpack8(*(const uint4*)(YR + (size_t)(T_ + tok) * 384 + hc), yb8);
#pragma unroll
      for (int e = 0; e < 8; ++e) y[e] += yb8[e];
      float s = 0.f;
#pragma unroll
      for (int e = 0; e < 8; ++e) s += y[e];
      const float mu = allsum8(s) * (1.f / 64.f);
      float vs = 0.f;
#pragma unroll
      for (int e = 0; e < 8; ++e) { y[e] -= mu; vs += y[e] * y[e]; }
      const float rstd = rsqrtf(allsum8(vs) * (1.f / 64.f) + 64e-5f);
      float gw[8], gb[8], rk[8], rr[8], kv[8], vv[8];
      ld8f(p->in[I_GNW] + l * 384 + hc, gw);
      ld8f(p->in[I_GNB] + l * 384 + hc, gb);
      ld8f(p->in[I_RK] + l * 384 + hc, rk);
      const int cr = 768 + hc, ck = 1152 + hc, cv = 1536 + hc;
      shift8(ldrow8(P, b, t - 1, cr), ldrow8(P, b, t, cr), ldrow8(P, b, t + 1, cr), mup + hc, mun + hc, rr);
      shift8(ldrow8(P, b, t - 1, ck), ldrow8(P, b, t, ck), ldrow8(P, b, t + 1, ck), mup + 384 + hc, mun + 384 + hc, kv);
      shift8(ldrow8(P, b, t - 1, cv), ldrow8(P, b, t, cv), ldrow8(P, b, t + 1, cv), mup + 768 + hc, mun + 768 + hc, vv);
      float bs = 0.f;
#pragma unroll
      for (int e = 0; e < 8; ++e) bs += rr[e] * kv[e] * rk[e];
      bs = allsum8(bs);
      float gate[8];
      ld8f(s_gate + tl * 388 + hc, gate);
      float o[8];
#pragma unroll
      for (int e = 0; e < 8; ++e) o[e] = (y[e] * rstd * gw[e] + gb[e] + bs * vv[e]) * gate[e];
      *(uint4*)(Yo + (size_t)tok * DM + 256 + hc) = pack8(o);
    }
    {
      float o[8], nw[8], zg[8], ob8[8];
      unpack8(*(const uint4*)(YG + (size_t)tok * 384 + hc), o);
      unpack8(*(const uint4*)(YG + (size_t)(T_ + tok) * 384 + hc), ob8);
#pragma unroll
      for (int e = 0; e < 8; ++e) o[e] += ob8[e];
      float ms = 0.f;
#pragma unroll
      for (int e = 0; e < 8; ++e) ms += o[e] * o[e];
      const float rs = rsqrtf(allsum8(ms) * (1.f / 64.f) + 1e-6f);
      ld8f(p->in[I_GNORM] + l * 64 + jg * 8, nw);
      unpack8(ldrow8(P, b, t, 3456 + hc), zg);
#pragma unroll
      for (int e = 0; e < 8; ++e) o[e] = o[e] * rs * nw[e] * siluf(zg[e]);
      *(uint4*)(Yo + (size_t)tok * DM + 640 + hc) = pack8(o);
    }
  }
  __syncthreads();
}

DEVI void attn_phase(KP p, int l, char* smem, int bid, int nb) {
  u16* sKV = (u16*)smem;
  u16* sP = sKV + 64 * 264;
  const int tid = otid(), lane = tid & 63, wv = tid >> 6, fr = lane & 15, fq = lane >> 4;
  const u16* Q = (const u16*)(p->ws + OFF_BIG);
  const u16* KM = (const u16*)(p->ws + OFF_KM) + (size_t)l * 1024 * 1024;
  const u16* VT = (const u16*)(p->ws + OFF_VT) + (size_t)l * 1024 * 1024;
  u16* O = (u16*)(p->ws + OFF_HN);
  u16* myP = sP + wv * 16 * 264;
  for (int it = bid; it < 1024; it += nb) {
    const int h = it & 3, qt = (it >> 2) & 63, b = it >> 8;
    const int tok0 = b * L_ + qt * 128 + wv * 16;
    uint4 R0, R1, R2, R3;
    const int lrow = tid >> 5, lc = (tid & 31) * 8;
    const u16* kbase = KM + (size_t)(b * 256 + lrow) * DM + h * 256 + lc;
    const u16* vbase = VT + (size_t)(h * 256 + lrow) * 1024 + b * 256 + lc;
#define ATT_LDK(ch_) do { const u16* g_ = kbase + (size_t)(ch_) * 64 * DM; R0 = *(const uint4*)(g_); R1 = *(const uint4*)(g_ + 16 * DM); \
      R2 = *(const uint4*)(g_ + 32 * DM); R3 = *(const uint4*)(g_ + 48 * DM); } while (0)
#define ATT_LDV(dc_) do { const u16* g_ = vbase + (size_t)(dc_) * 64 * 1024; R0 = *(const uint4*)(g_); R1 = *(const uint4*)(g_ + 16 * 1024); \
      R2 = *(const uint4*)(g_ + 32 * 1024); R3 = *(const uint4*)(g_ + 48 * 1024); } while (0)
#define ATT_ST() do { u16* d_ = sKV + lrow * 264 + lc; *(uint4*)(d_) = R0; *(uint4*)(d_ + 16 * 264) = R1; \
      *(uint4*)(d_ + 32 * 264) = R2; *(uint4*)(d_ + 48 * 264) = R3; } while (0)
    ATT_LDK(0);
    bf16x8 qf[8];
#pragma unroll
    for (int ks = 0; ks < 8; ++ks)
      qf[ks] = *(const bf16x8*)(Q + (size_t)(tok0 + fr) * DM + h * 256 + ks * 32 + fq * 8);
    f32x4 sc[16];
#pragma unroll
    for (int i = 0; i < 16; ++i) sc[i] = f32x4{0.f, 0.f, 0.f, 0.f};
#pragma unroll
    for (int ch = 0; ch < 4; ++ch) {
      __syncthreads();
      ATT_ST();
      __syncthreads();
      if (ch < 3) ATT_LDK(ch + 1); else ATT_LDV(0);
#pragma unroll
      for (int nt = 0; nt < 4; ++nt) {
#pragma unroll
        for (int ks = 0; ks < 8; ++ks) {
          bf16x8 kf = *(const bf16x8*)(sKV + (nt * 16 + fr) * 264 + ks * 32 + fq * 8);
          sc[ch * 4 + nt] = __builtin_amdgcn_mfma_f32_16x16x32_bf16(qf[ks], kf, sc[ch * 4 + nt], 0, 0, 0);
        }
      }
    }
#pragma unroll
    for (int j = 0; j < 4; ++j) {
      float mx = -1e30f;
#pragma unroll
      for (int i = 0; i < 16; ++i) mx = fmaxf(mx, sc[i][j]);
#pragma unroll
      for (int o = 1; o < 16; o <<= 1) mx = fmaxf(mx, __shfl_xor(mx, o, 64));
      float sum = 0.f;
#pragma unroll
      for (int i = 0; i < 16; ++i) {
        float e = __expf((sc[i][j] - mx) * 0.0625f);
        sc[i][j] = e;
        sum += e;
      }
      sum = allsum16(sum);
      const float inv = frcp(sum);
#pragma unroll
      for (int i = 0; i < 16; ++i) myP[(fq * 4 + j) * 264 + i * 16 + fr] = f2bf(sc[i][j] * inv);
    }
#pragma unroll
    for (int dc = 0; dc < 4; ++dc) {
      __syncthreads();
      ATT_ST();
      __syncthreads();
      if (dc < 3) ATT_LDV(dc + 1);
      f32x4 oa[4];
#pragma unroll
      for (int nt = 0; nt < 4; ++nt) oa[nt] = f32x4{0.f, 0.f, 0.f, 0.f};
#pragma unroll
      for (int ks = 0; ks < 8; ++ks) {
        bf16x8 pf = *(const bf16x8*)(myP + fr * 264 + ks * 32 + fq * 8);
#pragma unroll
        for (int nt = 0; nt < 4; ++nt) {
          bf16x8 vf = *(const bf16x8*)(sKV + (nt * 16 + fr) * 264 + ks * 32 + fq * 8);
          oa[nt] = __builtin_amdgcn_mfma_f32_16x16x32_bf16(pf, vf, oa[nt], 0, 0, 0);
        }
      }
#pragma unroll
      for (int nt = 0; nt < 4; ++nt)
#pragma unroll
        for (int j = 0; j < 4; ++j)
          O[(size_t)(tok0 + fq * 4 + j) * DM + h * 256 + dc * 64 + nt * 16 + fr] = f2bf(oa[nt][j]);
    }
    __syncthreads();
#undef ATT_LDK
#undef ATT_LDV
#undef ATT_ST
  }
}


#define XB_TMO      128
#define XB_XCNT(j)  (256  + 64 * (j))
#define XB_XSUB(j)  (1280 + 64 * (j))
#define XB_XGEN(j)  (2304 + 64 * (j))
#define XB_TOP      3328
#define XB_TOPGEN   3392
#define XCD_BAR_WORDS 3456
#define XB_SPIN_CAP (1u << 24)
#define LAS __attribute__((address_space(3)))
DEVI unsigned xb_ld(unsigned* p) { return __hip_atomic_load(p, __ATOMIC_RELAXED, __HIP_MEMORY_SCOPE_AGENT); }
DEVI unsigned xb_add(unsigned* p, unsigned v) { return __hip_atomic_fetch_add(p, v, __ATOMIC_RELAXED, __HIP_MEMORY_SCOPE_AGENT); }
DEVI unsigned xb_xcc_id() { return (unsigned)__builtin_amdgcn_s_getreg((3 << 11) | 20) & 0xFu; }
#define XB_SPIN(cond, bar) do { unsigned _sp = 0; while (cond) { __builtin_amdgcn_s_sleep(1); \
    if ((++_sp & 255u) == 0u) { if (xb_ld(&(bar)[XB_TMO])) break; if (_sp > XB_SPIN_CAP) { atomicAdd(&(bar)[XB_TMO], 1u); break; } } } } while (0)
struct XcdBarrier { unsigned* bar; unsigned x; volatile LAS unsigned* st; };
DEVI XcdBarrier xcd_barrier_post(unsigned* bar, volatile LAS unsigned* st) {
  XcdBarrier b; b.bar = bar; b.x = xb_xcc_id(); b.st = st;
  if (threadIdx.x == 0) (void)xb_add(&bar[XB_XCNT(b.x)], 1u);
  return b;
}
DEVI void xcd_barrier_complete(unsigned* bar, unsigned x, unsigned& nloc, unsigned& nx) {
  const unsigned G = gridDim.x * gridDim.y * gridDim.z;
  unsigned sum, cnt, mine, sp = 0u;
  for (;;) {
    sum = 0u; cnt = 0u; mine = 0u;
#pragma unroll
    for (unsigned j = 0; j < 16; ++j) { const unsigned c = xb_ld(&bar[XB_XCNT(j)]); sum += c; cnt += (c > 0u) ? 1u : 0u; mine = (j == x) ? c : mine; }
    if (sum == G) break;
    __builtin_amdgcn_s_sleep(1);
    if ((++sp & 255u) == 0u) { if (xb_ld(&bar[XB_TMO])) break; if (sp > XB_SPIN_CAP) { atomicAdd(&bar[XB_TMO], 1u); break; } }
  }
  nloc = mine > 0u ? mine : 1u; nx = cnt > 0u ? cnt : 1u;
}
DEVI void xcd_barrier(const XcdBarrier& b) {
  asm volatile("s_waitcnt vmcnt(0)" ::: "memory");
  __syncthreads();
  if (threadIdx.x == 0) {
    unsigned* bar = b.bar;
    __builtin_amdgcn_s_waitcnt(0);
    unsigned nloc = b.st[0], nx = b.st[1];
    if (nloc == 0u) { xcd_barrier_complete(bar, b.x, nloc, nx); b.st[0] = nloc; b.st[1] = nx; }
    const unsigned old = xb_add(&bar[XB_XSUB(b.x)], 1u);
    const unsigned gen = old / nloc;
    if (old + 1u == (gen + 1u) * nloc) {
      __builtin_amdgcn_fence(__ATOMIC_RELEASE, "agent");
      asm volatile("s_waitcnt vmcnt(0)" ::: "memory");
      const unsigned og = xb_add(&bar[XB_TOP], 1u);
      const unsigned tg = og / nx;
      if (og + 1u == (tg + 1u) * nx) xb_add(&bar[XB_TOPGEN], 1u);
      else XB_SPIN(xb_ld(&bar[XB_TOPGEN]) == tg, bar);
      __builtin_amdgcn_fence(__ATOMIC_ACQUIRE, "agent");
      xb_add(&bar[XB_XGEN(b.x)], 1u);
      asm volatile("s_waitcnt vmcnt(0)" ::: "memory");
    } else {
      XB_SPIN(xb_ld(&bar[XB_XGEN(b.x)]) == gen, bar);
      __builtin_amdgcn_fence(__ATOMIC_ACQUIRE, "agent");
      asm volatile("s_waitcnt vmcnt(0)" ::: "memory");
    }
  }
  __syncthreads();
}

DEVI void sub_barrier(unsigned* word, unsigned expected) {
  asm volatile("s_waitcnt vmcnt(0)" ::: "memory");
  __syncthreads();
  if (threadIdx.x == 0) {
    __builtin_amdgcn_fence(__ATOMIC_RELEASE, "agent");
    asm volatile("s_waitcnt vmcnt(0)" ::: "memory");
    xb_add(word, 1u);
    unsigned sp = 0;
    while (xb_ld(word) < expected) { __builtin_amdgcn_s_sleep(1); if (++sp > XB_SPIN_CAP) break; }
    __builtin_amdgcn_fence(__ATOMIC_ACQUIRE, "agent");
    asm volatile("s_waitcnt vmcnt(0)" ::: "memory");
  }
  __syncthreads();
}

#ifndef PROBE_RW
#define PROBE_RW 0
#endif
#ifndef PROBE_GD
#define PROBE_GD 0
#endif
#ifndef PROBE_HY
#define PROBE_HY 0
#endif
#ifndef REP_HYPREP
#define REP_HYPREP 1
#endif
#ifndef REP_POST
#define REP_POST 1
#endif
#ifndef REP_ATT
#define REP_ATT 1
#endif
#ifndef REP_NORM
#define REP_NORM 1
#endif
#ifndef REP_P0
#define REP_P0 1
#endif
#ifndef REP_SYNC
#define REP_SYNC 0
#endif
#ifndef REP_MIX
#define REP_MIX 1
#endif
#ifndef REP_G1
#define REP_G1 1
#endif
#ifndef EN_HY
#define EN_HY 1
#endif
#ifndef EN_RW
#define EN_RW 1
#endif
#ifndef EN_GD
#define EN_GD 1
#endif
#ifndef EN_XA
#define EN_XA 1
#endif

__global__ void __launch_bounds__(NTHR, 2) fwd_megakernel(Params p_unused) {
  __shared__ __attribute__((aligned(16))) char smem[SMEM_BYTES];
  const KP kp0 = (KP)__builtin_amdgcn_kernarg_segment_ptr();
#define p (opqk(kp0))
  cg::grid_group grid = cg::this_grid();
  __shared__ uint4 xb_words;
  if (threadIdx.x == 0) xb_words = make_uint4(0u, 0u, 0u, 0u);
  __syncthreads();
  const XcdBarrier xb = xcd_barrier_post((unsigned*)(kp0->ws + OFF_BAR), (volatile LAS unsigned*)&xb_words);
  const int bid = blockIdx.x, nb = gridDim.x;
#define ws (p->ws)
#define WA ((u16*)(ws + OFF_WA))
#define WB ((u16*)(ws + OFF_WB))
#define WKV ((u16*)(ws + OFF_WKV))
#define MEMN ((u16*)(ws + OFF_MEMN))
#define HN ((u16*)(ws + OFF_HN))
#define BIG ((u16*)(ws + OFF_BIG))
#define X (p->out)

  {
  for (int l = 0; l < 2; ++l) {
    convert_phase(p->in[I_WK] + (size_t)l * DM * DM, nullptr, DM, DM, DM, WKV + (size_t)(l * 2 + 0) * DM * DM, smem, bid, nb);
    convert_phase(p->in[I_WV] + (size_t)l * DM * DM, nullptr, DM, DM, DM, WKV + (size_t)(l * 2 + 1) * DM * DM, smem, bid, nb);
  }
  rmsnorm_phase<false>(p->in[I_MEM], p->in[I_MEMNORM], MEMN, 1024, bid, nb);
  if (gridDim.x == 0x7fffffffu) grid.sync();
  xcd_barrier(xb);
  for (int l = 0; l < 2; ++l) {
    run_gemm(smem, MEMN, WKV + (size_t)(l * 2 + 0) * DM * DM, 1024, 1024, DM,
             pg8::EpiBf16{(u16*)(ws + OFF_KM) + (size_t)l * DM * DM, DM, DM}, bid, (l * 32) % nb, 16);
    run_gemm(smem, WKV + (size_t)(l * 2 + 1) * DM * DM, MEMN, 1024, 1024, DM,
             pg8::EpiBf16{(u16*)(ws + OFF_VT) + (size_t)l * DM * DM, DM, DM}, bid, (l * 32 + 16) % nb, 16);
  }
  xcd_barrier(xb);
  }
  for (int rs_ = 0; rs_ < REP_SYNC; ++rs_) xcd_barrier(xb);

  for (int l = 0; l < 2; ++l) {
    int bid_l = blockIdx.x; asm volatile("" : "+s"(bid_l));
    const float* xin = (l == 0) ? p->in[I_X] : X;
    rmsnorm_phase<false>(xin, p->in[I_NFFN1] + l * DM, HN, T_, bid_l, nb);
    convert_phase(p->in[I_F1W1] + (size_t)l * DM * DFF, p->in[I_F1W3] + (size_t)l * DM * DFF, DM, 2 * DFF, 2 * DFF, WA, smem, bid_l, nb);
    convert_phase(p->in[I_F1W2] + (size_t)l * DFF * DM, nullptr, DFF, DM, DM, WB, smem, bid_l, nb);
    xcd_barrier(xb);
    for (int rep_ = 0; rep_ < REP_G1; ++rep_) {
      run_gemm(smem, HN, WA, T_, 2 * DFF, DM, pg8::EpiSwiglu{BIG, DFF}, bid_l, 0, nb);
      xcd_barrier(xb);
    }
    run_gemm(smem, BIG, WB, T_, DM, DFF, pg8::EpiResid{X, xin, 0.5f}, bid_l, 0, nb);
    xcd_barrier(xb);
    rmsnorm_phase<false>(X, p->in[I_NMIX] + l * DM, HN, T_, bid_l, nb);
    convert_phase(p->in[I_WIN] + (size_t)l * DM * INC, nullptr, DM, INC, INCP, WA, smem, bid_l, nb);
    convert_phase(p->in[I_WOUT] + (size_t)l * DM * DM, nullptr, DM, DM, DM, WB, smem, bid_l, nb);
    convert_phase(p->in[I_GLORA] + (size_t)l * 128 * 384, nullptr, 128, 384, 384, WKV, smem, (bid_l + 128) % nb, nb);
    xcd_barrier(xb);
    run_gemm(smem, HN, WA, T_, INCP, DM, pg8::EpiBf16{BIG, INC, INC}, bid_l, 0, nb);
    xcd_barrier(xb);
#define hy_own_prep (gridDim.x == 256u)
    if (!hy_own_prep) {
      hyprep_phase(p, l, smem, bid_l, nb);
      xcd_barrier(xb);
    }
    for (int rep_ = 0; rep_ < REP_MIX; ++rep_) {
      if (rep_ > 0) xcd_barrier(xb);
      const int t5 = otid();
      const int half = t5 >> 8, tl5 = t5 & 255;
      char* hsm = smem + half * SCAN_SMEM;
      int rb_ = bid_l; asm volatile("" : "+s"(rb_));
      for (int r = rb_; r < 256; r += nb) {
        if (r < 192) {
          const int q_ = (r < 96) ? r : r - 96;
          const int it_ = (((q_ >> 4) * 8 + (q_ & 7)) << 1) | ((q_ >> 3) & 1);
          if (r < 96) rwscan_pc_item(p, l, it_, smem);
          else gdscan_pc_item(p, l, it_, smem);
        }
        else if (EN_HY) {
          if (hy_own_prep) {
            hyfilter_phase(p, smem, r - 192, 64, l, OFF_YC);
            sub_barrier((unsigned*)(ws + OFF_BAR) + 3648 + 64 * l, 64u);
            hynorm_phase(p, smem, r - 192, 64, l, OFF_YC);
            hyprep_phase(p, l, smem, r - 192, 64);
            sub_barrier((unsigned*)(ws + OFF_BAR) + 3520 + 64 * l, 64u);
          }
          for (int c = r - 192; c < 256; c += 64) hyconv_item(p, l, c, smem);
        }
      }
    }
    xcd_barrier(xb);
    for (int rep_ = 0; rep_ < REP_POST; ++rep_) {
      for (int it = bid_l; it < 512; it += nb) post_tok_item(p, l, it, smem);
      xcd_barrier(xb);
    }
    run_gemm(smem, HN, WB, T_, DM, DM, pg8::EpiResid{X, X, 1.0f}, bid_l, 0, nb);
    xcd_barrier(xb);
    for (int rep_ = 0; rep_ < REP_NORM; ++rep_)
    rmsnorm_phase<false>(X, p->in[I_NXA] + l * DM, HN, T_, bid_l, nb);
    convert_phase(p->in[I_WQ] + (size_t)l * DM * DM, nullptr, DM, DM, DM, WA, smem, bid_l, nb);
    convert_phase(p->in[I_WO] + (size_t)l * DM * DM, nullptr, DM, DM, DM, WB, smem, bid_l, nb);
    xcd_barrier(xb);
#if EN_XA
    run_gemm(smem, HN, WA, T_, DM, DM, pg8::EpiBf16{BIG, DM, DM}, bid_l, 0, nb);
    xcd_barrier(xb);
    for (int rep_ = 0; rep_ < REP_ATT; ++rep_) {
      attn_phase(p, l, smem, bid_l, nb);
      xcd_barrier(xb);
    }
    run_gemm(smem, HN, WB, T_, DM, DM, pg8::EpiResid{X, X, 1.0f}, bid_l, 0, nb);
    xcd_barrier(xb);
#endif
    rmsnorm_phase<false>(X, p->in[I_NFFN2] + l * DM, HN, T_, bid_l, nb);
    convert_phase(p->in[I_F2W1] + (size_t)l * DM * DFF, p->in[I_F2W3] + (size_t)l * DM * DFF, DM, 2 * DFF, 2 * DFF, WA, smem, bid_l, nb);
    convert_phase(p->in[I_F2W2] + (size_t)l * DFF * DM, nullptr, DFF, DM, DM, WB, smem, bid_l, nb);
    xcd_barrier(xb);
    for (int rep_ = 0; rep_ < REP_G1; ++rep_) {
      run_gemm(smem, HN, WA, T_, 2 * DFF, DM, pg8::EpiSwiglu{BIG, DFF}, bid_l, 0, nb);
      xcd_barrier(xb);
    }
    run_gemm(smem, BIG, WB, T_, DM, DFF, pg8::EpiResid{X, X, 0.5f}, bid_l, 0, nb);
    xcd_barrier(xb);
  }
  rmsnorm_phase<true>(X, p->in[I_NFINAL], X, T_, bid, nb);
#undef p
#undef ws
#undef WA
#undef WB
#undef WKV
#undef MEMN
#undef HN
#undef BIG
#undef X
}

extern "C" void kernel_launch(void* const* d_in, const int* in_sizes, int n_in, void* d_out, int out_size, void* d_ws,
                              size_t ws_size, hipStream_t stream) {
  static int grid_blocks = 0;
  if (!grid_blocks) {
    int dev = 0, cus = 0, per_cu = 0;
    (void)hipGetDevice(&dev);
    (void)hipDeviceGetAttribute(&cus, hipDeviceAttributeMultiprocessorCount, dev);
    (void)hipOccupancyMaxActiveBlocksPerMultiprocessor(&per_cu, fwd_megakernel, NTHR, 0);
    if (per_cu != 1) per_cu = 1;
    grid_blocks = cus * per_cu;
  }
  Params p{};
  for (int i = 0; i < 46; ++i) p.in[i] = (const float*)d_in[i];
  p.out = (float*)d_out;
  p.ws = (char*)d_ws;
  (void)hipMemsetAsync((char*)d_ws + OFF_BAR, 0, 16384, stream);
  void* args[] = {&p};
  hipError_t e = hipLaunchCooperativeKernel((void*)fwd_megakernel, dim3(grid_blocks), dim3(NTHR), args, 0, stream);
  if (e != hipSuccess) fprintf(stderr, "cooperative launch failed: %s (grid %d)\n", hipGetErrorString(e), grid_blocks);
}
```

```cpp
#include <hip/hip_runtime.h>
#include <hip/hip_bf16.h>
#include <hip/hip_cooperative_groups.h>
#include <cstdio>
namespace cg = cooperative_groups;

typedef unsigned short u16;
using bf16x8 = __attribute__((ext_vector_type(8))) short;
using f32x4 = __attribute__((ext_vector_type(4))) float;

#define DEVI __device__ __forceinline__

constexpr int T_ = 32768, L_ = 8192, NB_ = 4, DM = 1024, DFF = 2816, INC = 3864, INCP = 4096;
constexpr int NTHR = 512, NWV = NTHR / 64;

constexpr size_t OFF_WA = 0;
constexpr size_t OFF_WB = OFF_WA + 11534336;
constexpr size_t OFF_WKV = OFF_WB + 5767168;
constexpr size_t OFF_MEMN = OFF_WKV + 8388608;
constexpr size_t OFF_KM = OFF_MEMN + 2097152;
constexpr size_t OFF_VT = OFF_KM + 4194304;
constexpr size_t OFF_RK = OFF_VT + 4194304;
constexpr size_t OFF_UB = OFF_RK + 16777216;
constexpr size_t OFF_YC = OFF_UB + 20971520;
constexpr size_t OFF_HN = OFF_YC + 16777216;
constexpr size_t OFF_YRW = OFF_HN + 67108864;
constexpr size_t OFF_YGD = OFF_YRW + 50331648;
constexpr size_t OFF_BIG = OFF_YGD + 50331648;
constexpr size_t OFF_BAR = OFF_BIG + 253231104;
constexpr size_t OFF_X0 = OFF_BAR + 16384;
constexpr int UBS = 10240;
constexpr int SCAN_SMEM = 75776;
constexpr int SMEM_BYTES = 2 * SCAN_SMEM;

struct Params {
  const float* in[46];
  float* out;
  char* ws;
};

typedef const __attribute__((address_space(4))) Params* KP;
DEVI KP opqk(KP k) { asm volatile("" : "+s"(k)); return k; }

enum {
  I_X = 0, I_MEM, I_NFFN1, I_F1W1, I_F1W3, I_F1W2, I_NMIX, I_WIN, I_WOUT, I_HYCW, I_HYCB, I_HYFREQ, I_HYW1, I_HYB1,
  I_HYW2, I_HYB2, I_HYW3, I_HYDEC, I_HYBIAS, I_MUP, I_MUN, I_WLORA, I_W0, I_ALORA, I_A0, I_GLORA, I_KK, I_KA, I_RK,
  I_GNW, I_GNB, I_GCW, I_GALOG, I_GDT, I_GNORM, I_NXA, I_WQ, I_WK, I_WV, I_WO, I_MEMNORM, I_NFFN2, I_F2W1, I_F2W3,
  I_F2W2, I_NFINAL
};

typedef __bf16 bf16x2_t __attribute__((ext_vector_type(2)));
DEVI unsigned cvtpk(float lo, float hi) { bf16x2_t v = {(__bf16)lo, (__bf16)hi}; return __builtin_bit_cast(unsigned, v); }
DEVI u16 f2bf(float f) { return (u16)(cvtpk(f, 0.f) & 0xffffu); }
DEVI float frcp(float x) { return __builtin_amdgcn_rcpf(x); }
DEVI float bf2f(u16 h) { return __uint_as_float(((unsigned)h) << 16); }
DEVI float bflo(unsigned v) { return __uint_as_float(v << 16); }
DEVI float bfhi(unsigned v) { return __uint_as_float(v & 0xffff0000u); }
DEVI unsigned pack2(float a, float b) { return cvtpk(a, b); }
DEVI float sigm(float x) { return frcp(1.f + __expf(-x)); }
DEVI float siluf(float x) { return x * frcp(1.f + __expf(-x)); }

DEVI void unpack8(uint4 v, float* f) {
  f[0] = bflo(v.x); f[1] = bfhi(v.x); f[2] = bflo(v.y); f[3] = bfhi(v.y);
  f[4] = bflo(v.z); f[5] = bfhi(v.z); f[6] = bflo(v.w); f[7] = bfhi(v.w);
}
DEVI uint4 pack8(const float* f) {
  uint4 v; v.x = pack2(f[0], f[1]); v.y = pack2(f[2], f[3]); v.z = pack2(f[4], f[5]); v.w = pack2(f[6], f[7]);
  return v;
}

template <int CTRL> DEVI float dppf(float x) {
  return __int_as_float(__builtin_amdgcn_update_dpp(0, __float_as_int(x), CTRL, 0xf, 0xf, true));
}
DEVI float allsum16(float x) {
  x += dppf<0xB1>(x);
  x += dppf<0x4E>(x);
  x += dppf<0x141>(x);
  x += dppf<0x140>(x);
  return x;
}
DEVI float allsum8(float x) {
  x += dppf<0xB1>(x);
  x += dppf<0x4E>(x);
  x += dppf<0x141>(x);
  return x;
}
DEVI int otid() { int t = threadIdx.x; asm volatile("" : "+v"(t)); return t; }
template <class Tp> DEVI const Tp* opq(const Tp* p) { asm volatile("" : "+v"(p)); return p; }
typedef float f32x2 __attribute__((ext_vector_type(2)));
DEVI float dot4(float s0, float s1, float s2, float s3, const float4& k) {
  f32x2 t = f32x2{s0, s1} * f32x2{k.x, k.y};
  t = __builtin_elementwise_fma(f32x2{s2, s3}, f32x2{k.z, k.w}, t);
  return t.x + t.y;
}
DEVI float wavesum(float x) {
  for (int o = 32; o > 0; o >>= 1) x += __shfl_xor(x, o, 64);
  return x;
}

DEVI void convert_phase(const float* __restrict__ W0, const float* __restrict__ W1, int K, int N, int Npad,
                              u16* __restrict__ Wt, char* smem, int bid, int nb) {
  float* tile = (float*)smem;
  const int tid = otid();
  const int kt = K / 64;
  const int ntiles = (Npad / 64) * kt;
  const int NW = W1 ? N / 2 : N;
  for (int t = bid; t < ntiles; t += nb) {
    const int n0 = (t / kt) * 64, k0 = (t % kt) * 64;
#pragma unroll 4
    for (int i = 0; i < 64 / NWV; ++i) {
      int kk = i * NWV + (tid >> 6), nn = tid & 63, R = n0 + nn;
      float v = 0.f;
      if (R < N) {
        if (W1) {
          int g = R >> 5, wi = R & 31;
          const float* src = (wi < 16) ? W0 : W1;
          v = src[(size_t)(k0 + kk) * NW + g * 16 + (wi & 15)];
        } else {
          v = W0[(size_t)(k0 + kk) * NW + R];
        }
      }
      tile[kk * 65 + nn] = v;
    }
    __syncthreads();
#pragma unroll 4
    for (int i = 0; i < 64 / NWV; ++i) {
      int nn = i * NWV + (tid >> 6), kk = tid & 63;
      Wt[(size_t)(n0 + nn) * K + k0 + kk] = f2bf(tile[kk * 65 + nn]);
    }
    __syncthreads();
  }
}

template <bool OUT_F32>
DEVI void rmsnorm_phase(const float* __restrict__ x, const float* __restrict__ g, void* outp, int rows, int bid,
                              int nb) {
  const int tid_ = otid();
  const int lane = tid_ & 63, wv = tid_ >> 6;
  for (int r = bid * NWV + wv; r < rows; r += nb * NWV) {
    const float* xr = x + (size_t)r * DM;
    float4 v[4];
    float ss = 0.f;
#pragma unroll
    for (int i = 0; i < 4; ++i) {
      v[i] = *(const float4*)(xr + i * 256 + lane * 4);
      ss += v[i].x * v[i].x + v[i].y * v[i].y + v[i].z * v[i].z + v[i].w * v[i].w;
    }
    ss = wavesum(ss);
    const float sc = rsqrtf(ss * (1.f / DM) + 1e-6f);
#pragma unroll
    for (int i = 0; i < 4; ++i) {
      float4 gg = *(const float4*)(g + i * 256 + lane * 4);
      float a = v[i].x * sc * gg.x, b = v[i].y * sc * gg.y, c = v[i].z * sc * gg.z, d = v[i].w * sc * gg.w;
      if (OUT_F32) {
        *(float4*)((float*)outp + (size_t)r * DM + i * 256 + lane * 4) = make_float4(a, b, c, d);
      } else {
        uint2 o; o.x = pack2(a, b); o.y = pack2(c, d);
        *(uint2*)((u16*)outp + (size_t)r * DM + i * 256 + lane * 4) = o;
      }
    }
  }
}

namespace pg8 {
#define PG8_LAS __attribute__((address_space(3)))
typedef unsigned u32x4 __attribute__((ext_vector_type(4)));
constexpr int BM = 256, BK = 64, HALF = 128, HTB = HALF * BK * 2, NXCD = 8, WGM = 8;
DEVI int lds_byte(int r, int c) { const int st = (r >> 4) * 2 + (c >> 5), rr = r & 15, cc = c & 31, ob = rr * 64 + cc * 2; return st * 1024 + (ob ^ (((ob >> 9) & 1) << 5)); }
DEVI void stage_rc(int b, int& R, int& C) { const int st = b / 1024, sb = b % 1024, swz = sb ^ (((sb >> 9) & 1) << 5); R = (st >> 1) * 16 + swz / 64; C = (st & 1) * 32 + (swz % 64) / 2; }
DEVI int perm32(int rho) { const int n = rho >> 4, i = rho & 15; return 8 * (i >> 2) + 4 * n + (i & 3); }
struct Unit { int pm, pn; };
struct Gemm { const u16* A; const u16* Bt; int M, N, K; };
struct StaticOrder {
  int nM, nN, nwg, G, c;
  DEVI void init(int M, int N, int G_, int c_) { nM = M / BM; nN = N / BM; nwg = nM * nN; G = G_; c = c_; }
  DEVI bool next(int i, Unit& u) const {
    const long L = (long)i * G + c; if (L >= nwg) return false;
    int wgid = (int)L; { const int q = nwg / NXCD, r = nwg % NXCD, xcd = wgid % NXCD, off = wgid / NXCD; wgid = (xcd < r ? xcd * (q + 1) : r * (q + 1) + (xcd - r) * q) + off; }
    const int nig = WGM * nN, gid = wgid / nig, fm = gid * WGM, gsz = (nM - fm) < WGM ? (nM - fm) : WGM;
    u.pm = fm + ((wgid % nig) % gsz); u.pn = (wgid % nig) / gsz; return true;
  }
};
DEVI unsigned cvt_pk_bf16(float lo, float hi) { return cvtpk(lo, hi); }

struct EpiBf16 {
  static constexpr bool PERM = true;
  u16* O; int ldc; int N;
  DEVI void operator()(const f32x4 (&acc)[2][2][4][2], const Unit& u, int wr, int wc, int fr, int fq) const {
    const int row0 = u.pm * BM + wr * 64 + fr, col0 = u.pn * BM + wc * 32 + 8 * fq;
#pragma unroll
    for (int ai = 0; ai < 2; ++ai)
#pragma unroll
      for (int m = 0; m < 4; ++m) {
        u16* rowp = O + (size_t)(row0 + ai * HALF + m * 16) * ldc + col0;
#pragma unroll
        for (int bj = 0; bj < 2; ++bj) {
          const f32x4 v0 = acc[ai][bj][m][0], v1 = acc[ai][bj][m][1];
          u32x4 w; w.x = cvt_pk_bf16(v0[0], v0[1]); w.y = cvt_pk_bf16(v0[2], v0[3]); w.z = cvt_pk_bf16(v1[0], v1[1]); w.w = cvt_pk_bf16(v1[2], v1[3]);
          if (col0 + bj * HALF < N) *(u32x4*)(rowp + bj * HALF) = w;
        }
      }
  }
};
struct EpiSwiglu {
  static constexpr bool PERM = false;
  u16* U; int ldu;
  DEVI void operator()(const f32x4 (&acc)[2][2][4][2], const Unit& u, int wr, int wc, int fr, int fq) const {
    const int row0 = u.pm * BM + wr * 64 + fr;
#pragma unroll
    for (int ai = 0; ai < 2; ++ai)
#pragma unroll
      for (int m = 0; m < 4; ++m) {
        u16* rowp = U + (size_t)(row0 + ai * HALF + m * 16) * ldu;
#pragma unroll
        for (int bj = 0; bj < 2; ++bj) {
          const int g32 = (u.pn * BM + bj * HALF + wc * 32) >> 5;
          const f32x4 a = acc[ai][bj][m][0], b = acc[ai][bj][m][1];
          uint2 w;
          w.x = cvt_pk_bf16(siluf(a[0]) * b[0], siluf(a[1]) * b[1]);
          w.y = cvt_pk_bf16(siluf(a[2]) * b[2], siluf(a[3]) * b[3]);
          *(uint2*)(rowp + g32 * 16 + 4 * fq) = w;
        }
      }
  }
};
struct EpiResid {
  static constexpr bool PERM = false;
  float* X; const float* Xin; float scale;
  DEVI void operator()(const f32x4 (&acc)[2][2][4][2], const Unit& u, int wr, int wc, int fr, int fq) const {
    const int row0 = u.pm * BM + wr * 64 + fr, col0 = u.pn * BM + wc * 32 + 4 * fq;
#pragma unroll
    for (int ai = 0; ai < 2; ++ai)
#pragma unroll
      for (int m = 0; m < 4; ++m) {
        const size_t ro = (size_t)(row0 + ai * HALF + m * 16) * DM + col0;
#pragma unroll
        for (int bj = 0; bj < 2; ++bj)
#pragma unroll
          for (int n = 0; n < 2; ++n) {
            const f32x4 xi = *(const f32x4*)(Xin + ro + bj * HALF + n * 16);
            *(f32x4*)(X + ro + bj * HALF + n * 16) = xi + acc[ai][bj][m][n] * scale;
          }
      }
  }
};

template <class Epi>
DEVI void gemm_phase(PG8_LAS unsigned char* lds, const Gemm g, const StaticOrder& S, const Epi& E) {
  const int tid = otid(), wid = __builtin_amdgcn_readfirstlane(tid >> 6), lane = tid & 63, wr = wid >> 2, wc = wid & 3, fr = lane & 15, fq = lane >> 4;
  const int K = g.K, nt = K / BK;
  unsigned voffA[2], voffB[2];
#pragma unroll
  for (int i = 0; i < 2; ++i) { int R, C; stage_rc(tid * 16 + i * 8192, R, C); const int Rb = Epi::PERM ? ((R & ~31) + perm32(R & 31)) : R;
    voffA[i] = (unsigned)(R * K + C) * 2u; voffB[i] = (unsigned)(Rb * K + C) * 2u; }
  const size_t kstep = (size_t)(BK * 2);
  const size_t hstep = (size_t)HALF * K * 2;
  const size_t tstep = 2 * hstep;
  const unsigned ldsw = (unsigned)wid * 1024u;
  const int aoff = lds_byte(wr * 64 + fr, fq * 8), boff = lds_byte(wc * 32 + fr, fq * 8);
#define PG8_SA(b, h) (((b) * 2 + (h)) * HTB)
#define PG8_SB(b, h) ((4 + (b) * 2 + (h)) * HTB)
#define PG8_STAGE(bufoff, gbase, voff) do { _Pragma("unroll") for (int _i = 0; _i < 2; ++_i) \
    __builtin_amdgcn_global_load_lds((const unsigned*)((const char*)(gbase) + (voff)[_i]), (PG8_LAS unsigned*)(lds + (bufoff) + ldsw + _i * 8192), 16, 0, 0); } while (0)
#define PG8_LDA(dst, b, h) do { _Pragma("unroll") for (int m = 0; m < 4; ++m) _Pragma("unroll") for (int k = 0; k < 2; ++k) dst[m][k] = *(const PG8_LAS bf16x8*)(lds + PG8_SA(b, h) + aoff + m * 2048 + k * 1024); } while (0)
#define PG8_LDB(dst, b, h) do { _Pragma("unroll") for (int n = 0; n < 2; ++n) _Pragma("unroll") for (int k = 0; k < 2; ++k) dst[n][k] = *(const PG8_LAS bf16x8*)(lds + PG8_SB(b, h) + boff + n * 2048 + k * 1024); } while (0)
#define PG8_MMA(ai, bj, At, Bt) do { __builtin_amdgcn_s_setprio(1); _Pragma("unroll") for (int m = 0; m < 4; ++m) _Pragma("unroll") for (int n = 0; n < 2; ++n) _Pragma("unroll") for (int k = 0; k < 2; ++k) \
    acc[ai][bj][m][n] = __builtin_amdgcn_mfma_f32_16x16x32_bf16(Bt[n][k], At[m][k], acc[ai][bj][m][n], 0, 0, 0); __builtin_amdgcn_s_setprio(0); } while (0)
#define PG8_WAIT_V(n) asm volatile("s_waitcnt vmcnt(" #n ")" ::: "memory")
#define PG8_WAIT_L(n) asm volatile("s_waitcnt lgkmcnt(" #n ")" ::: "memory")
#define PG8_BAR __builtin_amdgcn_s_barrier()
#define PG8_SCHED __builtin_amdgcn_sched_barrier(0)
  Unit cur, nxt; int ui = 0;
  if (!S.next(0, cur)) return;
  f32x4 acc[2][2][4][2];
#pragma unroll
  for (int a = 0; a < 2; ++a)
#pragma unroll
    for (int b = 0; b < 2; ++b)
#pragma unroll
      for (int m = 0; m < 4; ++m)
#pragma unroll
        for (int n = 0; n < 2; ++n) acc[a][b][m][n] = (f32x4){0.f, 0.f, 0.f, 0.f};
  bf16x8 At[4][2], B0[2][2], B1[2][2];
  const char* cA = (const char*)g.A + (size_t)cur.pm * tstep; const char* cB = (const char*)g.Bt + (size_t)cur.pn * tstep;
  PG8_STAGE(PG8_SB(0, 0), cB, voffB); PG8_STAGE(PG8_SA(0, 0), cA, voffA); PG8_STAGE(PG8_SB(0, 1), cB + hstep, voffB); PG8_STAGE(PG8_SA(0, 1), cA + hstep, voffA);
  if (wr == 1) PG8_BAR;
  PG8_WAIT_V(4); PG8_BAR;
  PG8_STAGE(PG8_SB(1, 0), cB + kstep, voffB); PG8_STAGE(PG8_SA(1, 0), cA + kstep, voffA); PG8_STAGE(PG8_SB(1, 1), cB + hstep + kstep, voffB);
  PG8_WAIT_V(6); PG8_BAR;
  for (;;) {
    const bool has_next = S.next(ui + 1, nxt);
    const char* nA = has_next ? (const char*)g.A + (size_t)nxt.pm * tstep : cA; const char* nB = has_next ? (const char*)g.Bt + (size_t)nxt.pn * tstep : cB;
    for (int t = 0; t < nt; t += 2) {
      const bool last = (t == nt - 2);
      const char* a1 = cA + (size_t)(t + 1) * kstep;
      const char* a2 = last ? nA : cA + (size_t)(t + 2) * kstep; const char* b2 = last ? nB : cB + (size_t)(t + 2) * kstep;
      const char* a3 = a2 + kstep; const char* b3 = b2 + kstep;
      PG8_LDB(B0, 0, 0); PG8_SCHED; PG8_LDA(At, 0, 0); PG8_STAGE(PG8_SA(1, 1), a1 + hstep, voffA);
      PG8_WAIT_L(8); PG8_BAR; PG8_WAIT_L(0); PG8_MMA(0, 0, At, B0); PG8_BAR; PG8_SCHED;
      PG8_LDB(B1, 0, 1); PG8_STAGE(PG8_SB(0, 0), b2, voffB);
      PG8_BAR; PG8_WAIT_L(0); PG8_MMA(0, 1, At, B1); PG8_BAR;
      PG8_LDA(At, 0, 1); PG8_STAGE(PG8_SA(0, 0), a2, voffA);
      PG8_BAR; PG8_WAIT_L(0); PG8_MMA(1, 0, At, B0); PG8_BAR; PG8_SCHED;
      PG8_STAGE(PG8_SB(0, 1), b2 + hstep, voffB);
      PG8_WAIT_V(6); PG8_BAR; PG8_MMA(1, 1, At, B1); PG8_BAR;
      PG8_LDB(B0, 1, 0); PG8_SCHED; PG8_LDA(At, 1, 0); PG8_STAGE(PG8_SA(0, 1), a2 + hstep, voffA);
      PG8_WAIT_L(8); PG8_BAR; PG8_WAIT_L(0); PG8_MMA(0, 0, At, B0); PG8_BAR; PG8_SCHED;
      PG8_LDB(B1, 1, 1); PG8_STAGE(PG8_SB(1, 0), b3, voffB);
      PG8_BAR; PG8_WAIT_L(0); PG8_MMA(0, 1, At, B1); PG8_BAR;
      PG8_LDA(At, 1, 1); PG8_STAGE(PG8_SA(1, 0), a3, voffA);
      PG8_BAR; PG8_WAIT_L(0); PG8_MMA(1, 0, At, B0); PG8_BAR; PG8_SCHED;
      PG8_STAGE(PG8_SB(1, 1), b3 + hstep, voffB);
      PG8_WAIT_V(6); PG8_BAR; PG8_MMA(1, 1, At, B1); PG8_BAR;
    }
    E(acc, cur, wr, wc, fr, fq);
    if (!has_next) break;
#pragma unroll
    for (int a = 0; a < 2; ++a)
#pragma unroll
      for (int b = 0; b < 2; ++b)
#pragma unroll
        for (int m = 0; m < 4; ++m)
#pragma unroll
          for (int n = 0; n < 2; ++n) acc[a][b][m][n] = (f32x4){0.f, 0.f, 0.f, 0.f};
    cur = nxt; cA = nA; cB = nB; ++ui;
  }
  PG8_WAIT_V(0);
  if (wr == 0) PG8_BAR;
  PG8_BAR;
#undef PG8_SA
#undef PG8_SB
#undef PG8_STAGE
#undef PG8_LDA
#undef PG8_LDB
#undef PG8_MMA
#undef PG8_WAIT_V
#undef PG8_WAIT_L
#undef PG8_BAR
#undef PG8_SCHED
}
}

template <class Epi>
DEVI void run_gemm(char* smem, const u16* A, const u16* Bt, int M, int N, int K, const Epi& E, int bid, int b0, int G) {
  pg8::StaticOrder S;
  asm volatile("" : "+s"(bid));
  const int c = (bid >= b0 && bid < b0 + G) ? (bid - b0) : (1 << 28);
  S.init(M, N, G, c);
  pg8::Gemm g{A, Bt, M, N, K};
  pg8::gemm_phase<Epi>((PG8_LAS unsigned char*)smem, g, S, E);
}

DEVI void hyfilter_phase(KP p, char* smem, int bid, int nb, int l_only = -1, size_t hoff = OFF_YRW) {
  float* z = (float*)smem;
  float* h1 = z + 16 * 33;
  float* h2 = h1 + 16 * 64;
  float* HRAW = (float*)(p->ws + hoff);
  const int tid = otid();
  for (int it = bid; it < 512; it += nb) {
    const int l = l_only, t0 = it * 16;
    const int slot_ = 0;
    const float* freq = p->in[I_HYFREQ] + l * 64;
    const float* w1 = p->in[I_HYW1] + l * 33 * 64;
    const float* b1 = p->in[I_HYB1] + l * 64;
    const float* w2 = p->in[I_HYW2] + l * 64 * 64;
    const float* b2 = p->in[I_HYB2] + l * 64;
    const float* w3 = p->in[I_HYW3] + l * 64 * 512;
    const float* dec = p->in[I_HYDEC] + l * 512;
    for (int e = tid; e < 16 * 33; e += NTHR) {
      int pos = e / 33, f = e % 33;
      int i = t0 + pos;
      float v;
      if (f == 0) {
        v = (float)i / (float)(L_ - 1);
      } else {
        int m = (f - 1) & 15;
        float band = 1e-4f + (float)m * ((15.f - 1e-4f) / 15.f);
        float ang = 6.283185307179586f * (float)i / (float)L_;
        float a = band * ang;
        v = (f <= 16) ? cosf(a) : -sinf(a);
      }
      z[pos * 33 + f] = v;
    }
    __syncthreads();
    {
      const int o = tid & 63;
      const float fo = freq[o], bo = b1[o];
#pragma unroll
      for (int i = 0; i < 16 / NWV; ++i) {
        int pos = (tid >> 6) + NWV * i;
        float s = bo;
#pragma unroll 11
        for (int f = 0; f < 33; ++f) s += z[pos * 33 + f] * w1[f * 64 + o];
        h1[pos * 64 + o] = sinf(fo * s);
      }
    }
    __syncthreads();
    {
      const int o = tid & 63;
      const float fo = freq[o], bo = b2[o];
#pragma unroll
      for (int i = 0; i < 16 / NWV; ++i) {
        int pos = (tid >> 6) + NWV * i;
        float s = bo;
#pragma unroll 16
        for (int f = 0; f < 64; ++f) s += h1[pos * 64 + f] * w2[f * 64 + o];
        h2[pos * 64 + o] = sinf(fo * s);
      }
    }
    __syncthreads();
#pragma unroll 1
    for (int cc = 0; cc < 512 / NTHR; ++cc) {
      const int ch = tid + NTHR * cc;
      float acc[16];
#pragma unroll
      for (int q = 0; q < 16; ++q) acc[q] = 0.f;
#pragma unroll 8
      for (int o = 0; o < 64; ++o) {
        float w = w3[o * 512 + ch];
#pragma unroll
        for (int q = 0; q < 16; ++q) acc[q] += h2[q * 64 + o] * w;
      }
      const float dc = dec[ch];
      float* dst = HRAW + ((size_t)(slot_ * 512 + ch)) * L_ + t0;
#pragma unroll
      for (int q = 0; q < 16; ++q) {
        float tp = (float)(t0 + q) / (float)(L_ - 1);
        dst[q] = acc[q] * __expf(-tp * dc);
      }
    }
    __syncthreads();
  }
}

DEVI void hynorm_phase(KP p, char* smem, int bid, int nb, int l_only = -1, size_t hoff = OFF_YRW) {
  float* red = (float*)smem;
  const float* HRAW = (const float*)(p->ws + hoff);
  u16* RK = (u16*)(p->ws + OFF_RK);
  const int tid = otid();
  for (int it0_ = bid; it0_ < 256; it0_ += nb) {
    const int l = l_only, c = it0_;
    const int slot_ = 0;
    const int it = l * 256 + c;
    const float* hf = HRAW + ((size_t)(slot_ * 512 + c)) * L_;
    const float* hb = HRAW + ((size_t)(slot_ * 512 + 256 + c)) * L_;
    float s = 0.f;
    for (int t = tid; t < L_; t += NTHR) {
      s += fabsf(hf[t]);
      if (t > 0) s += fabsf(hb[t]);
    }
    s = wavesum(s);
    if ((tid & 63) == 0) red[tid >> 6] = s;
    __syncthreads();
    float tot = 0.f;
    for (int w = 0; w < NWV; ++w) tot += red[w];
    const float inv = 1.f / tot;
    u16* dst = RK + (size_t)it * 16384;
    for (int i = tid; i < 16384; i += NTHR) {
      int m = i - 8192;
      float v;
      if (m == -8192) v = 0.f;
      else if (m <= 0) v = hf[-m] * inv;
      else v = hb[m] * inv;
      dst[i] = f2bf(v);
    }
    __syncthreads();
  }
}

DEVI float ldP(const u16* P, int b, int t, int col) {
  return (t >= 0 && t < L_) ? bf2f(P[((size_t)(b * L_ + t)) * INC + col]) : 0.f;
}
DEVI uint4 ldrow8(const u16* P, int b, int t, int col);
DEVI void ld8f(const float* __restrict__ g, float* o);
DEVI void hyprep_phase(KP p, int l, char* smem, int bid, int nb) {
  float* tileU = (float*)smem;
  float* tileX = tileU + 64 * 65;
  const u16* P = (const u16*)(p->ws + OFF_BIG);
  u16* UB = (u16*)(p->ws + OFF_UB);
  u16* X0 = (u16*)(p->ws + OFF_X0);
  const float* cw = p->in[I_HYCW] + l * 3 * 768;
  const float* cb = p->in[I_HYCB] + l * 768;
  const int tid = otid();
  for (int it = bid; it < 2048; it += nb) {
    const int ct = it & 3, tt = (it >> 2) & 127, b = it >> 9;
    const int c0 = ct * 64, t0 = tt * 64;
    {
      const int tl = tid >> 3, cg = tid & 7, t = t0 + tl, c = c0 + cg * 8;
      float xs[3][8];
#pragma unroll
      for (int a3 = 0; a3 < 3; ++a3) {
        float pm[8], p0[8], pp[8], w0[8], w1[8], w2[8], bb[8];
        unpack8(ldrow8(P, b, t - 1, a3 * 256 + c), pm);
        unpack8(ldrow8(P, b, t, a3 * 256 + c), p0);
        unpack8(ldrow8(P, b, t + 1, a3 * 256 + c), pp);
        ld8f(cw + a3 * 256 + c, w0); ld8f(cw + 768 + a3 * 256 + c, w1); ld8f(cw + 1536 + a3 * 256 + c, w2);
        ld8f(cb + a3 * 256 + c, bb);
#pragma unroll
        for (int e = 0; e < 8; ++e) xs[a3][e] = w0[e] * pm[e] + w1[e] * p0[e] + w2[e] * pp[e] + bb[e];
      }
#pragma unroll
      for (int e = 0; e < 8; ++e) {
        tileU[tl * 65 + cg * 8 + e] = xs[1][e] * xs[2][e];
        tileX[tl * 65 + cg * 8 + e] = xs[0][e];
      }
    }
    __syncthreads();
    {
      const int cc = tid >> 3, tq = tid & 7;
      float u8[8], x8[8];
#pragma unroll
      for (int e = 0; e < 8; ++e) { u8[e] = tileU[(tq * 8 + e) * 65 + cc]; x8[e] = tileX[(tq * 8 + e) * 65 + cc]; }
      *(uint4*)(UB + ((size_t)((c0 + cc) * 4 + b)) * UBS + 1024 + t0 + tq * 8) = pack8(u8);
      *(uint4*)(X0 + ((size_t)((c0 + cc) * 4 + b)) * L_ + t0 + tq * 8) = pack8(x8);
    }
    if (tt == 0 || tt == 127) {
      const int poff = (tt == 0) ? 0 : (1024 + L_);
      for (int e = tid; e < 64 * 128; e += NTHR) {
        int cc = e >> 7, q = e & 127;
        *(uint4*)(UB + ((size_t)((c0 + cc) * 4 + b)) * UBS + poff + q * 8) = make_uint4(0, 0, 0, 0);
      }
    }
    __syncthreads();
  }
}

DEVI void hyconv_item(KP p, int l, int item, char* smem) {
  const int tid_ = otid();
  const int lane = tid_ & 63, wv = tid_ >> 6;
  const int fr = lane & 15, fq = lane >> 4;
  const int c = item, it32 = wv;
  const int a = it32 * 32;
  u16* sU = (u16*)smem;
  unsigned* sK = (unsigned*)(smem + 4 * UBS * 2);
  {
    const uint4* gu = (const uint4*)((const u16*)(p->ws + OFF_UB) + (size_t)(c * 4) * UBS);
    const uint4* gk = (const uint4*)((const u16*)(p->ws + OFF_RK) + (size_t)(l * 256 + c) * 16384);
    __syncthreads();
    for (int i = tid_; i < 4 * UBS / 8; i += NTHR) ((uint4*)sU)[i] = gu[i];
    for (int i = tid_; i < 16384 / 8; i += NTHR) ((uint4*)sK)[i] = gk[i];
    __syncthreads();
  }
  f32x4 acc[2][8];
#pragma unroll
  for (int m = 0; m < 2; ++m)
#pragma unroll
    for (int n = 0; n < 8; ++n) acc[m][n] = f32x4{0.f, 0.f, 0.f, 0.f};
#pragma unroll 1
  for (int D = a + 31; D >= a - 255; --D) {
    bf16x8 af[2];
#pragma unroll
    for (int mt = 0; mt < 2; ++mt) {
      int idx = fq * 8 - (mt * 16 + fr) - 32 * D + 8192;
      int bd = idx >> 1;
      unsigned sh = (idx & 1) * 16;
      unsigned d0 = sK[bd], d1 = sK[bd + 1], d2 = sK[bd + 2], d3 = sK[bd + 3], d4 = sK[bd + 4];
      union { unsigned u[4]; bf16x8 v; } cv;
      cv.u[0] = __builtin_amdgcn_alignbit(d1, d0, sh);
      cv.u[1] = __builtin_amdgcn_alignbit(d2, d1, sh);
      cv.u[2] = __builtin_amdgcn_alignbit(d3, d2, sh);
      cv.u[3] = __builtin_amdgcn_alignbit(d4, d3, sh);
      af[mt] = cv.v;
    }
#pragma unroll
    for (int n = 0; n < 8; ++n) {
      const int b = n >> 1, ct = n & 1;
      const int i1 = a + ct * 16 + fr;
      bf16x8 bf = *(const bf16x8*)(sU + b * UBS + 1024 + (i1 - D) * 32 + fq * 8);
      acc[0][n] = __builtin_amdgcn_mfma_f32_16x16x32_bf16(af[0], bf, acc[0][n], 0, 0, 0);
      acc[1][n] = __builtin_amdgcn_mfma_f32_16x16x32_bf16(af[1], bf, acc[1][n], 0, 0, 0);
    }
  }
  const u16* X0 = (const u16*)(p->ws + OFF_X0) + (size_t)(c * 4) * L_;
  u16* Yo = (u16*)(p->ws + OFF_HN);
  const float bias = p->in[I_HYBIAS][l * 256 + c];
#pragma unroll
  for (int n = 0; n < 8; ++n) {
    const int b = n >> 1, ct = n & 1;
    const int i1 = a + ct * 16 + fr;
#pragma unroll
    for (int mt = 0; mt < 2; ++mt) {
      const int t = i1 * 32 + mt * 16 + fq * 4;
      const uint2 xr = *(const uint2*)(X0 + (size_t)b * L_ + t);
      const uint2 ur = *(const uint2*)(sU + b * UBS + 1024 + t);
      const float x0[4] = {bflo(xr.x), bfhi(xr.x), bflo(xr.y), bfhi(xr.y)};
      const float uu[4] = {bflo(ur.x), bfhi(ur.x), bflo(ur.y), bfhi(ur.y)};
#pragma unroll
      for (int j = 0; j < 4; ++j)
        Yo[((size_t)(b * L_ + t + j)) * DM + c] = f2bf(x0[j] * (acc[mt][n][j] + bias * uu[j]));
    }
  }
}

DEVI uint4 ldrow8(const u16* P, int b, int t, int col) {
  if (t < 0 || t >= L_) return make_uint4(0, 0, 0, 0);
  return *(const uint4*)(P + ((size_t)(b * L_ + t)) * INC + col);
}
DEVI void shift8(uint4 pm, uint4 p0, uint4 pp, const float* __restrict__ mup, const float* __restrict__ mun,
                 float* out) {
  float a[8], u[8], n[8];
  unpack8(pm, a); unpack8(p0, u); unpack8(pp, n);
  float4 m0 = *(const float4*)mup, m1 = *(const float4*)(mup + 4);
  float4 n0 = *(const float4*)mun, n1 = *(const float4*)(mun + 4);
  float mp[8] = {m0.x, m0.y, m0.z, m0.w, m1.x, m1.y, m1.z, m1.w};
  float mn[8] = {n0.x, n0.y, n0.z, n0.w, n1.x, n1.y, n1.z, n1.w};
#pragma unroll
  for (int e = 0; e < 8; ++e) out[e] = u[e] + mp[e] * (a[e] - u[e]) + mn[e] * (n[e] - u[e]);
}
DEVI void ld8f(const float* __restrict__ g, float* o) {
  float4 a = *(const float4*)g, b = *(const float4*)(g + 4);
  o[0] = a.x; o[1] = a.y; o[2] = a.z; o[3] = a.w; o[4] = b.x; o[5] = b.y; o[6] = b.z; o[7] = b.w;
}
DEVI void st8f(float* s, const float* v) {
  *(float4*)s = make_float4(v[0], v[1], v[2], v[3]);
  *(float4*)(s + 4) = make_float4(v[4], v[5], v[6], v[7]);
}

DEVI float dot8(const f32x2 (&S)[4], const float4& a, const float4& b) {
  f32x2 t = S[0] * f32x2{a.x, a.y};
  f32x2 u = S[1] * f32x2{a.z, a.w};
  t = __builtin_elementwise_fma(S[2], f32x2{b.x, b.y}, t);
  u = __builtin_elementwise_fma(S[3], f32x2{b.z, b.w}, u);
  t += u;
  return t.x + t.y;
}

DEVI void rwscan_pc_item(KP p, int l, int item, char* smem) {
  const int tid = otid();
  const int lane = tid & 63, wv = tid >> 6;
  const bool cons = wv < 4;
  const int fr = lane & 15, fq = lane >> 4;
  const int rg2 = item & 1, d = (item >> 1) & 1, bh = item >> 2, h = bh % 6, b = bh / 6;
  constexpr int BUFF = 12352;
  float* s_buf = (float*)smem;
  float* s_a = s_buf + 2 * BUFF;
  u16* s_lw = (u16*)(s_a + 2048);
  u16* s_la = s_lw + 32 * 72;
  float* s_y = (float*)(s_la + 32 * 72);
  float* s_mu = s_y + 1024;
  const u16* P = (const u16*)(p->ws + OFF_BIG);
  u16* Yd = (u16*)(p->ws + OFF_YRW) + (size_t)d * T_ * 384;
  const float* mup = p->in[I_MUP] + l * 1536;
  const float* mun = p->in[I_MUN] + l * 1536;
  const int pt = tid & 255, tl = pt >> 3, jg = pt & 7, pw = wv & 3;
  const int cr = 768 + h * 64 + jg * 8, ck = 1152 + h * 64 + jg * 8, cvv = 1536 + h * 64 + jg * 8;
  const int clw = 1920 + d * 64 + jg * 8, cla = 2048 + d * 64 + jg * 8;
  bf16x8 fW[2], fA[2];
  {
    const float* Wl = p->in[I_WLORA] + (size_t)(l * 2 + d) * 64 * 384 + h * 64 + pw * 16 + fr;
    const float* Al = p->in[I_ALORA] + (size_t)(l * 2 + d) * 64 * 384 + h * 64 + pw * 16 + fr;
#pragma unroll
    for (int ks = 0; ks < 2; ++ks) {
#pragma unroll
      for (int e = 0; e < 8; ++e) {
        int r = ks * 32 + fq * 8 + e;
        fW[ks][e] = (short)f2bf(Wl[r * 384]);
        fA[ks][e] = (short)f2bf(Al[r * 384]);
      }
    }
  }
  const float w0v = p->in[I_W0][(l * 2 + d) * 384 + h * 64 + pw * 16 + fr];
  const float a0v = p->in[I_A0][(l * 2 + d) * 384 + h * 64 + pw * 16 + fr];
  for (int e = tid; e < 768; e += NTHR) {
    float v;
    if (e < 640) {
      const int a5 = (e % 320) >> 6, j = e & 63;
      const int base = (a5 < 3) ? (a5 * 384 + h * 64) : (1152 + (a5 - 3) * 128 + d * 64);
      v = ((e < 320) ? mup : mun)[base + j];
    } else {
      v = ((e < 704) ? p->in[I_KK] : p->in[I_KA])[l * 384 + h * 64 + (e & 63)];
    }
    s_mu[e] = v;
  }
  __syncthreads();
  const int row8 = lane >> 3, e8 = lane & 7;
  const int rowi = rg2 * 32 + pw * 8 + row8;
  const int j8 = e8 * 8;
  f32x2 S[4];
#pragma unroll
  for (int i = 0; i < 4; ++i) S[i] = f32x2{0.f, 0.f};

  uint4 q[15];
#pragma unroll
  for (int i = 0; i < 15; ++i) q[i] = make_uint4(0, 0, 0, 0);
  if (!cons) {
    int t = d ? (L_ - 1 - tl) : tl;
#pragma unroll
    for (int dt = 0; dt < 3; ++dt) {
      q[0 + dt] = ldrow8(P, b, t + dt - 1, cr);
      q[3 + dt] = ldrow8(P, b, t + dt - 1, ck);
      q[6 + dt] = ldrow8(P, b, t + dt - 1, cvv);
      q[9 + dt] = ldrow8(P, b, t + dt - 1, clw);
      q[12 + dt] = ldrow8(P, b, t + dt - 1, cla);
    }
  }
  float kv[8], kkn[8];
#pragma unroll
  for (int e = 0; e < 8; ++e) { kv[e] = 0.f; kkn[e] = 0.f; }
  float yacc = 0.f;

  struct RwOps { float4 ka, kb, ra, rb; float vi; float2 sc; };
  struct RwUpd { float4 da, db, ba, bb, wa, wb; };
  auto scan_seg = [&](const float* cb, int seg) {
    auto ldops = [&](int s) {
      RwOps r;
      const float* o = cb + 2048 + s * 64 + j8;
      r.ka = *(const float4*)(o); r.kb = *(const float4*)(o + 4);
      r.ra = *(const float4*)(o - 2048); r.rb = *(const float4*)(o - 2048 + 4);
      r.vi = cb[10240 + s * 64 + rowi];
      r.sc = *(const float2*)(cb + 12288 + s * 2);
      return r;
    };
    auto ldupd = [&](int s) {
      RwUpd r;
      const float* o = cb + 2048 + s * 64 + j8;
      r.da = *(const float4*)(o + 2048); r.db = *(const float4*)(o + 2048 + 4);
      r.ba = *(const float4*)(o + 4096); r.bb = *(const float4*)(o + 4096 + 4);
      r.wa = *(const float4*)(o + 6144); r.wb = *(const float4*)(o + 6144 + 4);
      return r;
    };
    RwOps cur = ldops(seg * 8);
#pragma unroll
    for (int i_ = 0; i_ < 8; ++i_) {
      const int s = seg * 8 + i_;
      const RwUpd up = ldupd(s);
      const RwOps nxt = ldops(seg * 8 + ((i_ + 1) & 7));
      float dA = dot8(S, cur.ka, cur.kb);
      float dB = dot8(S, cur.ra, cur.rb);
      const f32x2 vi2 = f32x2{cur.vi, cur.vi};
      const f32x2 A0 = __builtin_elementwise_fma(S[0], f32x2{up.wa.x, up.wa.y}, vi2 * f32x2{up.da.x, up.da.y});
      const f32x2 A1 = __builtin_elementwise_fma(S[1], f32x2{up.wa.z, up.wa.w}, vi2 * f32x2{up.da.z, up.da.w});
      const f32x2 A2 = __builtin_elementwise_fma(S[2], f32x2{up.wb.x, up.wb.y}, vi2 * f32x2{up.db.x, up.db.y});
      const f32x2 A3 = __builtin_elementwise_fma(S[3], f32x2{up.wb.z, up.wb.w}, vi2 * f32x2{up.db.z, up.db.w});
      const float sa = allsum8(dA);
      dB = allsum8(dB);
      const float y = dB + sa * cur.sc.x + cur.vi * cur.sc.y;
      const f32x2 sa2 = f32x2{sa, sa};
      S[0] = __builtin_elementwise_fma(sa2, f32x2{up.ba.x, up.ba.y}, A0);
      S[1] = __builtin_elementwise_fma(sa2, f32x2{up.ba.z, up.ba.w}, A1);
      S[2] = __builtin_elementwise_fma(sa2, f32x2{up.bb.x, up.bb.y}, A2);
      S[3] = __builtin_elementwise_fma(sa2, f32x2{up.bb.z, up.bb.w}, A3);
      yacc = (e8 == i_) ? y : yacc;
      cur = nxt;
    }
    s_y[(seg * 8 + e8) * 32 + pw * 8 + row8] = yacc;
  };

  constexpr int NC = L_ / 32;
  if (cons) {
    for (int c = 0; c <= NC; ++c) {
      const float* cb = s_buf + ((c + 1) & 1) * BUFF;
      const bool cact = c >= 1;
      if (cact) scan_seg(cb, 0);
      __syncthreads();
      if (cact) scan_seg(cb, 1);
      __syncthreads();
      if (cact) scan_seg(cb, 2);
      __syncthreads();
    if (cact) {
        scan_seg(cb, 3);
        const int t2 = lane >> 1, hf = lane & 1;
        const float4 o4 = *(const float4*)(s_y + t2 * 32 + pw * 8 + hf * 4);
        const int ts = (c - 1) * 32 + t2;
        const int t = d ? (L_ - 1 - ts) : ts;
        uint2 o; o.x = pack2(o4.x, o4.y); o.y = pack2(o4.z, o4.w);
        *(uint2*)(Yd + ((size_t)(b * L_ + t)) * 384 + h * 64 + rg2 * 32 + pw * 8 + hf * 4) = o;
      }
    __syncthreads();
    }
  } else {
    const float* mp_ = s_mu + jg * 8;
    const float* mn_ = s_mu + 320 + jg * 8;
    for (int c = 0; c <= NC; ++c) {
      float* pb = s_buf + (c & 1) * BUFF;
      const bool pact = c < NC;
      const bool pnext = c + 1 < NC;
      const int tn_ = (c + 1) * 32 + tl;
      const int tnx = d ? (L_ - 1 - tn_) : tn_;
      const u16* rw0_ = P + ((size_t)(b * L_ + tnx)) * INC;
      const u16* rk0 = rw0_ + (h * 64 + jg * 8);
      const u16* rl0 = rw0_ + (d * 64 + jg * 8);
      const bool edge = pnext && (c + 1 == NC - 1);
      const bool zm = edge && (tnx - 1 < 0), zp = edge && (tnx + 1 >= L_);
      const uint4 zero4 = make_uint4(0, 0, 0, 0);
      if (pact) {
        float rr[8], lw[8], la[8];
        shift8(q[9], q[10], q[11], mp_ + 192, mn_ + 192, lw);
        shift8(q[12], q[13], q[14], mp_ + 256, mn_ + 256, la);
        shift8(q[0], q[1], q[2], mp_, mn_, rr);
#pragma unroll
        for (int e = 0; e < 8; ++e) lw[e] = 1.f - 2.f * frcp(1.f + __expf(2.f * lw[e]));
        *(uint4*)(s_lw + tl * 72 + jg * 8) = pack8(lw);
        *(uint4*)(s_la + tl * 72 + jg * 8) = pack8(la);
        st8f(pb + tl * 64 + jg * 8, rr);
      }
      if (pnext) {
        q[9] = *(const uint4*)(rl0 + 1920 - INC); q[10] = *(const uint4*)(rl0 + 1920); q[11] = *(const uint4*)(rl0 + 1920 + INC);
        q[12] = *(const uint4*)(rl0 + 2048 - INC); q[13] = *(const uint4*)(rl0 + 2048); q[14] = *(const uint4*)(rl0 + 2048 + INC);
        q[0] = *(const uint4*)(rk0 + 768 - INC); q[1] = *(const uint4*)(rk0 + 768); q[2] = *(const uint4*)(rk0 + 768 + INC);
        if (edge) {
          if (zm) { q[9] = zero4; q[12] = zero4; q[0] = zero4; }
          if (zp) { q[11] = zero4; q[14] = zero4; q[2] = zero4; }
        }
      }
      __syncthreads();
      if (pact) {
#pragma unroll
        for (int mt = 0; mt < 2; ++mt) {
          f32x4 aw = {0.f, 0.f, 0.f, 0.f}, aa = {0.f, 0.f, 0.f, 0.f};
#pragma unroll
          for (int ks = 0; ks < 2; ++ks) {
            bf16x8 xw = *(const bf16x8*)(s_lw + (mt * 16 + fr) * 72 + ks * 32 + fq * 8);
            bf16x8 xa = *(const bf16x8*)(s_la + (mt * 16 + fr) * 72 + ks * 32 + fq * 8);
            aw = __builtin_amdgcn_mfma_f32_16x16x32_bf16(xw, fW[ks], aw, 0, 0, 0);
            aa = __builtin_amdgcn_mfma_f32_16x16x32_bf16(xa, fA[ks], aa, 0, 0, 0);
          }
#pragma unroll
          for (int j = 0; j < 4; ++j) {
            int t2 = mt * 16 + fq * 4 + j, jj = pw * 16 + fr;
            pb[8192 + t2 * 64 + jj] = __expf(-0.606531f * sigm(aw[j] + w0v));
            s_a[t2 * 64 + jj] = sigm(aa[j] + a0v);
          }
        }
        float vv[8];
        shift8(q[6], q[7], q[8], mp_ + 128, mn_ + 128, vv);
        st8f(pb + 10240 + tl * 64 + jg * 8, vv);
      }
      if (pnext) {
        q[6] = *(const uint4*)(rk0 + 1536 - INC); q[7] = *(const uint4*)(rk0 + 1536); q[8] = *(const uint4*)(rk0 + 1536 + INC);
        if (edge) { if (zm) q[6] = zero4; if (zp) q[8] = zero4; }
      }
      __syncthreads();
      if (pact) {
        shift8(q[3], q[4], q[5], mp_ + 64, mn_ + 64, kv);
        float kkc[8];
        ld8f(s_mu + 640 + jg * 8, kkc);
        float ss = 0.f;
#pragma unroll
        for (int e = 0; e < 8; ++e) { kkn[e] = kv[e] * kkc[e]; ss += kkn[e] * kkn[e]; }
        ss = allsum8(ss);
        const float inv = rsqrtf(ss + 1e-6f);
        float nk[8];
#pragma unroll
        for (int e = 0; e < 8; ++e) { kkn[e] *= inv; nk[e] = -kkn[e]; }
        st8f(pb + 2048 + tl * 64 + jg * 8, nk);
      }
      if (pnext) {
        q[3] = *(const uint4*)(rk0 + 1152 - INC); q[4] = *(const uint4*)(rk0 + 1152); q[5] = *(const uint4*)(rk0 + 1152 + INC);
        if (edge) { if (zm) q[3] = zero4; if (zp) q[5] = zero4; }
      }
      __syncthreads();
      if (pact) {
        float av[8], kac[8], kd[8], bb[8], rr[8], wv8[8];
        ld8f(s_a + tl * 64 + jg * 8, av);
        ld8f(pb + tl * 64 + jg * 8, rr);
        ld8f(pb + 8192 + tl * 64 + jg * 8, wv8);
        ld8f(s_mu + 704 + jg * 8, kac);
        float br = 0.f, kr = 0.f;
#pragma unroll
        for (int e = 0; e < 8; ++e) {
          kd[e] = kv[e] * (1.f + (av[e] - 1.f) * kac[e]);
          bb[e] = kkn[e] * av[e];
          br += bb[e] * rr[e];
          kr += kd[e] * rr[e];
          rr[e] *= wv8[e];
        }
        br = allsum8(br);
        kr = allsum8(kr);
        st8f(pb + 4096 + tl * 64 + jg * 8, kd);
        st8f(pb + 6144 + tl * 64 + jg * 8, bb);
        st8f(pb + tl * 64 + jg * 8, rr);
        if (jg == 0) *(float2*)(pb + 12288 + tl * 2) = make_float2(br, kr);
      }
      __syncthreads();
    }
  }
}

DEVI void gdscan_pc_item(KP p, int l, int item, char* smem) {
  const int tid = otid();
  const int lane = tid & 63, wv = tid >> 6;
  const bool cons = wv < 4;
  const int rg2 = item & 1, d = (item >> 1) & 1, bh = item >> 2, h = bh % 6, b = bh / 6;
  constexpr int BUFF = 6272;
  float* s_buf = (float*)smem;
  float* s_y = s_buf + 2 * BUFF;
  const u16* P = (const u16*)(p->ws + OFF_BIG);
  u16* Yd = (u16*)(p->ws + OFF_YGD) + (size_t)d * T_ * 384;
  const float* cw = p->in[I_GCW] + l * 3 * 1152;
  const int pt = tid & 255, tl = pt >> 3, jg = pt & 7, pw = wv & 3;
  const int lq = h * 64 + jg * 8, lk = 384 + lq, lv = 768 + lq;
  const float negA = -__expf(p->in[I_GALOG][(l * 2 + d) * 6 + h]);
  const float dtb = p->in[I_GDT][(l * 2 + d) * 6 + h];
  const int cag = 3840 + d * 6 + h, cbg = 3852 + d * 6 + h;
  const int row8 = lane >> 3, e8 = lane & 7;
  const int col_e = rg2 * 32 + pw * 8 + row8;
  const int j8 = e8 * 8;
  f32x2 S[4];
#pragma unroll
  for (int i = 0; i < 4; ++i) S[i] = f32x2{0.f, 0.f};
  float yacc = 0.f;

  uint4 q[9];
#pragma unroll
  for (int i = 0; i < 9; ++i) q[i] = make_uint4(0, 0, 0, 0);
  u16 rag = 0, rbg = 0;
  if (!cons) {
    int t = d ? (L_ - 1 - tl) : tl;
#pragma unroll
    for (int dt = 0; dt < 3; ++dt) {
      q[0 + dt] = ldrow8(P, b, t + dt - 1, 2304 + lq);
      q[3 + dt] = ldrow8(P, b, t + dt - 1, 2304 + lk);
      q[6 + dt] = ldrow8(P, b, t + dt - 1, 2304 + lv);
    }
    { const u16* pr_ = P + ((size_t)(b * L_ + t)) * INC; rag = pr_[cag]; rbg = pr_[cbg]; }
  }
  struct GdOps { float4 ka, kb, qa, qb, sc; float ve; };
  auto scan_seg = [&](const float* cb, int seg) {
    auto ldops = [&](int s) {
      GdOps r;
      const float* o = cb + 2048 + s * 64 + j8;
      r.ka = *(const float4*)(o); r.kb = *(const float4*)(o + 4);
      r.qa = *(const float4*)(o - 2048); r.qb = *(const float4*)(o - 2048 + 4);
      r.ve = cb[4096 + s * 64 + col_e];
      r.sc = *(const float4*)(cb + 6144 + s * 4);
      return r;
    };
    GdOps cur = ldops(seg * 16);
#pragma unroll
    for (int i_ = 0; i_ < 16; ++i_) {
      const int s = seg * 16 + i_;
      const GdOps nxt = ldops(seg * 16 + ((i_ + 1) & 15));
      const float al = cur.sc.x, be = cur.sc.y, qk = cur.sc.z, nab = cur.sc.w;
      float d1 = dot8(S, cur.ka, cur.kb);
      float d2 = dot8(S, cur.qa, cur.qb);
      const f32x2 al2 = f32x2{al, al};
      const f32x2 A0 = S[0] * al2, A1 = S[1] * al2, A2 = S[2] * al2, A3 = S[3] * al2;
      const float bv = be * cur.ve;
      d1 = allsum8(d1);
      d2 = allsum8(d2);
      const float vn = __builtin_fmaf(nab, d1, bv);
      const float ov = al * d2 + qk * vn;
      const f32x2 vn2 = f32x2{vn, vn};
      S[0] = __builtin_elementwise_fma(vn2, f32x2{cur.ka.x, cur.ka.y}, A0);
      S[1] = __builtin_elementwise_fma(vn2, f32x2{cur.ka.z, cur.ka.w}, A1);
      S[2] = __builtin_elementwise_fma(vn2, f32x2{cur.kb.x, cur.kb.y}, A2);
      S[3] = __builtin_elementwise_fma(vn2, f32x2{cur.kb.z, cur.kb.w}, A3);
      yacc = (e8 == (i_ & 7)) ? ov : yacc;
      if ((i_ & 7) == 7) s_y[(s - 7 + e8) * 32 + pw * 8 + row8] = yacc;
      cur = nxt;
    }
  };
  __syncthreads();
  constexpr int NC = L_ / 32;
  for (int c = 0; c <= NC; ++c) {
    float* pb = s_buf + (c & 1) * BUFF;
    const float* cb = s_buf + ((c + 1) & 1) * BUFF;
    const bool pact = !cons && c < NC, cact = cons && c >= 1;
    if (pact) {
      float qq[8], kk[8], vv[8];
#pragma unroll
      for (int arr = 0; arr < 3; ++arr) {
        float a[8], u[8], n[8], w0[8], w1[8], w2[8];
        unpack8(q[arr * 3 + 0], a); unpack8(q[arr * 3 + 1], u); unpack8(q[arr * 3 + 2], n);
        const int lc = (arr == 0) ? lq : (arr == 1 ? lk : lv);
        ld8f(cw + lc, w0); ld8f(cw + 1152 + lc, w1); ld8f(cw + 2304 + lc, w2);
        float* o = (arr == 0) ? qq : (arr == 1 ? kk : vv);
#pragma unroll
        for (int e = 0; e < 8; ++e) o[e] = siluf(w0[e] * a[e] + w1[e] * u[e] + w2[e] * n[e]);
      }
      float sq = 0.f, sk = 0.f;
#pragma unroll
      for (int e = 0; e < 8; ++e) { sq += qq[e] * qq[e]; sk += kk[e] * kk[e]; }
      sq = allsum8(sq); sk = allsum8(sk);
      const float iq = rsqrtf(sq + 1e-6f) * 0.125f, ik = rsqrtf(sk + 1e-6f);
      float qk = 0.f;
#pragma unroll
      for (int e = 0; e < 8; ++e) { qq[e] *= iq; kk[e] *= ik; qk += qq[e] * kk[e]; }
      qk = allsum8(qk);
      st8f(pb + tl * 64 + jg * 8, qq);
      st8f(pb + 2048 + tl * 64 + jg * 8, kk);
      st8f(pb + 4096 + tl * 64 + jg * 8, vv);
      if (jg == 0) {
        float x = bf2f(rag) + dtb;
        float sp = (x > 20.f) ? x : log1pf(__expf(x));
        const float al_ = __expf(negA * sp), be_ = sigm(bf2f(rbg));
        *(float4*)(pb + 6144 + tl * 4) = make_float4(al_, be_, qk, -al_ * be_);
      }
    }
    if (cact) scan_seg(cb, 0);
    __syncthreads();
    if (!cons && c + 1 < NC) {
      int tn = (c + 1) * 32 + tl;
      int t = d ? (L_ - 1 - tn) : tn;
#pragma unroll
      for (int dt = 0; dt < 3; ++dt) {
        q[0 + dt] = ldrow8(P, b, t + dt - 1, 2304 + lq);
        q[3 + dt] = ldrow8(P, b, t + dt - 1, 2304 + lk);
        q[6 + dt] = ldrow8(P, b, t + dt - 1, 2304 + lv);
      }
      { const u16* pr_ = P + ((size_t)(b * L_ + t)) * INC; rag = pr_[cag]; rbg = pr_[cbg]; }
    }
    if (cact) {
      scan_seg(cb, 1);
      const int t2 = lane >> 1, hf = lane & 1;
      const float4 o4 = *(const float4*)(s_y + t2 * 32 + pw * 8 + hf * 4);
      const int ts = (c - 1) * 32 + t2;
      const int t = d ? (L_ - 1 - ts) : ts;
      uint2 o; o.x = pack2(o4.x, o4.y); o.y = pack2(o4.z, o4.w);
      *(uint2*)(Yd + ((size_t)(b * L_ + t)) * 384 + h * 64 + rg2 * 32 + pw * 8 + hf * 4) = o;
    }
    __syncthreads();
  }
}

DEVI void post_tok_item(KP p, int l, int item, char* smem) {
  const int tid = otid();
  const int tl = tid >> 3, jg = tid & 7;
  u16* s_sg = (u16*)smem;
  float* s_gate = (float*)(smem + 64 * 136 * 2);
  const u16* P = (const u16*)(p->ws + OFF_BIG);
  const u16* YR = (const u16*)(p->ws + OFF_YRW);
  const u16* YG = (const u16*)(p->ws + OFF_YGD);
  u16* Yo = (u16*)(p->ws + OFF_HN);
  const float* mup = p->in[I_MUP] + l * 1536;
  const float* mun = p->in[I_MUN] + l * 1536;
  const int tok = item * 64 + tl;
  const int b = tok / L_, t = tok % L_;
#pragma unroll
  for (int half = 0; half < 2; ++half) {
    const int col = 2176 + jg * 16 + half * 8;
    float lg[8];
    shift8(ldrow8(P, b, t - 1, col), ldrow8(P, b, t, col), ldrow8(P, b, t + 1, col), mup + (col - 768),
           mun + (col - 768), lg);
#pragma unroll
    for (int e = 0; e < 8; ++e) lg[e] = sigm(lg[e]);
    *(uint4*)(s_sg + tl * 136 + jg * 16 + half * 8) = pack8(lg);
  }
  __syncthreads();
  {
    const int lane = tid & 63, wv = tid >> 6, fr = lane & 15, fq = lane >> 4;
    const u16* GT = (const u16*)(p->ws + OFF_WKV);
    f32x4 acc[4][3];
#pragma unroll
    for (int m = 0; m < 4; ++m)
#pragma unroll
      for (int n = 0; n < 3; ++n) acc[m][n] = f32x4{0.f, 0.f, 0.f, 0.f};
#pragma unroll
    for (int ks = 0; ks < 4; ++ks) {
      bf16x8 af[4], bfr[3];
#pragma unroll
      for (int m = 0; m < 4; ++m) af[m] = *(const bf16x8*)(s_sg + (m * 16 + fr) * 136 + ks * 32 + fq * 8);
#pragma unroll
      for (int n = 0; n < 3; ++n) bfr[n] = *(const bf16x8*)(GT + ((wv * 3 + n) * 16 + fr) * 128 + ks * 32 + fq * 8);
#pragma unroll
      for (int m = 0; m < 4; ++m)
#pragma unroll
        for (int n = 0; n < 3; ++n) acc[m][n] = __builtin_amdgcn_mfma_f32_16x16x32_bf16(af[m], bfr[n], acc[m][n], 0, 0, 0);
    }
#pragma unroll
    for (int m = 0; m < 4; ++m)
#pragma unroll
      for (int n = 0; n < 3; ++n)
#pragma unroll
        for (int j = 0; j < 4; ++j) s_gate[(m * 16 + fq * 4 + j) * 388 + (wv * 3 + n) * 16 + fr] = acc[m][n][j];
  }
  __syncthreads();
  for (int h = 0; h < 6; ++h) {
    const int hc = h * 64 + jg * 8;
    {
      float y[8], yb8[8];
      unpack8(*(const uint4*)(YR + (size_t)tok * 384 + hc), y);
      unpack8(*(const uint4*)(YR + (size_t)(T_ + tok) * 384 + hc), yb8);
#pragma unroll
      for (int e = 0; e < 8; ++e) y[e] += yb8[e];
      float s = 0.f;
#pragma unroll
      for (int e = 0; e < 8; ++e) s += y[e];
      const float mu = allsum8(s) * (1.f / 64.f);
      float vs = 0.f;
#pragma unroll
      for (int e = 0; e < 8; ++e) { y[e] -= mu; vs += y[e] * y[e]; }
      const float rstd = rsqrtf(allsum8(vs) * (1.f / 64.f) + 64e-5f);
      float gw[8], gb[8], rk[8], rr[8], kv[8], vv[8];
      ld8f(p->in[I_GNW] + l * 384 + hc, gw);
      ld8f(p->in[I_GNB] + l * 384 + hc, gb);
      ld8f(p->in[I_RK] + l * 384 + hc, rk);
      const int cr = 768 + hc, ck = 1152 + hc, cv = 1536 + hc;
      shift8(ldrow8(P, b, t - 1, cr), ldrow8(P, b, t, cr), ldrow8(P, b, t + 1, cr), mup + hc, mun + hc, rr);
      shift8(ldrow8(P, b, t - 1, ck), ldrow8(P, b, t, ck), ldrow8(P, b, t + 1, ck), mup + 384 + hc, mun + 384 + hc, kv);
      shift8(ldrow8(P, b, t - 1, cv), ldrow8(P, b, t, cv), ldrow8(P, b, t + 1, cv), mup + 768 + hc, mun + 768 + hc, vv);
      float bs = 0.f;
#pragma unroll
      for (int e = 0; e < 8; ++e) bs += rr[e] * kv[e] * rk[e];
      bs = allsum8(bs);
      float gate[8];
      ld8f(s_gate + tl * 388 + hc, gate);
      float o[8];
#pragma unroll
      for (int e = 0; e < 8; ++e) o[e] = (y[e] * rstd * gw[e] + gb[e] + bs * vv[e]) * gate[e];
      *(uint4*)(Yo + (size_t)tok * DM + 256 + hc) = pack8(o);
    }
    {
      float o[8], nw[8], zg[8], ob8[8];
      unpack8(*(const uint4*)(YG + (size_t)tok * 384 + hc), o);
      unpack8(*(const uint4*)(YG + (size_t)(T_ + tok) * 384 + hc), ob8);
#pragma unroll
      for (int e = 0; e < 8; ++e) o[e] += ob8[e];
      float ms = 0.f;
#pragma unroll
      for (int e = 0; e < 8; ++e) ms += o[e] * o[e];
      const float rs = rsqrtf(allsum8(ms) * (1.f / 64.f) + 1e-6f);
      ld8f(p->in[I_GNORM] + l * 64 + jg * 8, nw);
      unpack8(ldrow8(P, b, t, 3456 + hc), zg);
#pragma unroll
      for (int e = 0; e < 8; ++e) o[e] = o[e] * rs * nw[e] * siluf(zg[e]);
      *(uint4*)(Yo + (size_t)tok * DM + 640 + hc) = pack8(o);
    }
  }
  __syncthreads();
}

DEVI void attn_phase(KP p, int l, char* smem, int bid, int nb) {
  u16* sKV = (u16*)smem;
  u16* sP = sKV + 64 * 264;
  const int tid = otid(), lane = tid & 63, wv = tid >> 6, fr = lane & 15, fq = lane >> 4;
  const u16* Q = (const u16*)(p->ws + OFF_BIG);
  const u16* KM = (const u16*)(p->ws + OFF_KM) + (size_t)l * 1024 * 1024;
  const u16* VT = (const u16*)(p->ws + OFF_VT) + (size_t)l * 1024 * 1024;
  u16* O = (u16*)(p->ws + OFF_HN);
  u16* myP = sP + wv * 16 * 264;
  for (int it = bid; it < 1024; it += nb) {
    const int h = it & 3, qt = (it >> 2) & 63, b = it >> 8;
    const int tok0 = b * L_ + qt * 128 + wv * 16;
    uint4 R0, R1, R2, R3;
    const int lrow = tid >> 5, lc = (tid & 31) * 8;
    const u16* kbase = KM + (size_t)(b * 256 + lrow) * DM + h * 256 + lc;
    const u16* vbase = VT + (size_t)(h * 256 + lrow) * 1024 + b * 256 + lc;
#define ATT_LDK(ch_) do { const u16* g_ = kbase + (size_t)(ch_) * 64 * DM; R0 = *(const uint4*)(g_); R1 = *(const uint4*)(g_ + 16 * DM); \
      R2 = *(const uint4*)(g_ + 32 * DM); R3 = *(const uint4*)(g_ + 48 * DM); } while (0)
#define ATT_LDV(dc_) do { const u16* g_ = vbase + (size_t)(dc_) * 64 * 1024; R0 = *(const uint4*)(g_); R1 = *(const uint4*)(g_ + 16 * 1024); \
      R2 = *(const uint4*)(g_ + 32 * 1024); R3 = *(const uint4*)(g_ + 48 * 1024); } while (0)
#define ATT_ST() do { u16* d_ = sKV + lrow * 264 + lc; *(uint4*)(d_) = R0; *(uint4*)(d_ + 16 * 264) = R1; \
      *(uint4*)(d_ + 32 * 264) = R2; *(uint4*)(d_ + 48 * 264) = R3; } while (0)
    ATT_LDK(0);
    bf16x8 qf[8];
#pragma unroll
    for (int ks = 0; ks < 8; ++ks)
      qf[ks] = *(const bf16x8*)(Q + (size_t)(tok0 + fr) * DM + h * 256 + ks * 32 + fq * 8);
    f32x4 sc[16];
#pragma unroll
    for (int i = 0; i < 16; ++i) sc[i] = f32x4{0.f, 0.f, 0.f, 0.f};
#pragma unroll
    for (int ch = 0; ch < 4; ++ch) {
      __syncthreads();
      ATT_ST();
      __syncthreads();
      if (ch < 3) ATT_LDK(ch + 1); else ATT_LDV(0);
#pragma unroll
      for (int nt = 0; nt < 4; ++nt) {
#pragma unroll
        for (int ks = 0; ks < 8; ++ks) {
          bf16x8 kf = *(const bf16x8*)(sKV + (nt * 16 + fr) * 264 + ks * 32 + fq * 8);
          sc[ch * 4 + nt] = __builtin_amdgcn_mfma_f32_16x16x32_bf16(qf[ks], kf, sc[ch * 4 + nt], 0, 0, 0);
        }
      }
    }
#pragma unroll
    for (int j = 0; j < 4; ++j) {
      float mx = -1e30f;
#pragma unroll
      for (int i = 0; i < 16; ++i) mx = fmaxf(mx, sc[i][j]);
#pragma unroll
      for (int o = 1; o < 16; o <<= 1) mx = fmaxf(mx, __shfl_xor(mx, o, 64));
      float sum = 0.f;
#pragma unroll
      for (int i = 0; i < 16; ++i) {
        float e = __expf((sc[i][j] - mx) * 0.0625f);
        sc[i][j] = e;
        sum += e;
      }
      sum = allsum16(sum);
      const float inv = frcp(sum);
#pragma unroll
      for (int i = 0; i < 16; ++i) myP[(fq * 4 + j) * 264 + i * 16 + fr] = f2bf(sc[i][j] * inv);
    }
#pragma unroll
    for (int dc = 0; dc < 4; ++dc) {
      __syncthreads();
      ATT_ST();
      __syncthreads();
      if (dc < 3) ATT_LDV(dc + 1);
      f32x4 oa[4];
#pragma unroll
      for (int nt = 0; nt < 4; ++nt) oa[nt] = f32x4{0.f, 0.f, 0.f, 0.f};
#pragma unroll
      for (int ks = 0; ks < 8; ++ks) {
        bf16x8 pf = *(const bf16x8*)(myP + fr * 264 + ks * 32 + fq * 8);
#pragma unroll
        for (int nt = 0; nt < 4; ++nt) {
          bf16x8 vf = *(const bf16x8*)(sKV + (nt * 16 + fr) * 264 + ks * 32 + fq * 8);
          oa[nt] = __builtin_amdgcn_mfma_f32_16x16x32_bf16(pf, vf, oa[nt], 0, 0, 0);
        }
      }
#pragma unroll
      for (int nt = 0; nt < 4; ++nt)
#pragma unroll
        for (int j = 0; j < 4; ++j)
          O[(size_t)(tok0 + fq * 4 + j) * DM + h * 256 + dc * 64 + nt * 16 + fr] = f2bf(oa[nt][j]);
    }
    __syncthreads();
#undef ATT_LDK
#undef ATT_LDV
#undef ATT_ST
  }
}


#define XB_TMO      128
#define XB_XCNT(j)  (256  + 64 * (j))
#define XB_XSUB(j)  (1280 + 64 * (j))
#define XB_XGEN(j)  (2304 + 64 * (j))
#define XB_TOP      3328
#define XB_TOPGEN   3392
#define XCD_BAR_WORDS 3456
#define XB_SPIN_CAP (1u << 24)
#define LAS __attribute__((address_space(3)))
DEVI unsigned xb_ld(unsigned* p) { return __hip_atomic_load(p, __ATOMIC_RELAXED, __HIP_MEMORY_SCOPE_AGENT); }
DEVI unsigned xb_add(unsigned* p, unsigned v) { return __hip_atomic_fetch_add(p, v, __ATOMIC_RELAXED, __HIP_MEMORY_SCOPE_AGENT); }
DEVI unsigned xb_xcc_id() { return (unsigned)__builtin_amdgcn_s_getreg((3 << 11) | 20) & 0xFu; }
#define XB_SPIN(cond, bar) do { unsigned _sp = 0; while (cond) { __builtin_amdgcn_s_sleep(1); \
    if ((++_sp & 255u) == 0u) { if (xb_ld(&(bar)[XB_TMO])) break; if (_sp > XB_SPIN_CAP) { atomicAdd(&(bar)[XB_TMO], 1u); break; } } } } while (0)
struct XcdBarrier { unsigned* bar; unsigned x; volatile LAS unsigned* st; };
DEVI XcdBarrier xcd_barrier_post(unsigned* bar, volatile LAS unsigned* st) {
  XcdBarrier b; b.bar = bar; b.x = xb_xcc_id(); b.st = st;
  if (threadIdx.x == 0) (void)xb_add(&bar[XB_XCNT(b.x)], 1u);
  return b;
}
DEVI void xcd_barrier_complete(unsigned* bar, unsigned x, unsigned& nloc, unsigned& nx) {
  const unsigned G = gridDim.x * gridDim.y * gridDim.z;
  unsigned sum, cnt, mine, sp = 0u;
  for (;;) {
    sum = 0u; cnt = 0u; mine = 0u;
#pragma unroll
    for (unsigned j = 0; j < 16; ++j) { const unsigned c = xb_ld(&bar[XB_XCNT(j)]); sum += c; cnt += (c > 0u) ? 1u : 0u; mine = (j == x) ? c : mine; }
    if (sum == G) break;
    __builtin_amdgcn_s_sleep(1);
    if ((++sp & 255u) == 0u) { if (xb_ld(&bar[XB_TMO])) break; if (sp > XB_SPIN_CAP) { atomicAdd(&bar[XB_TMO], 1u); break; } }
  }
  nloc = mine > 0u ? mine : 1u; nx = cnt > 0u ? cnt : 1u;
}
DEVI void xcd_barrier(const XcdBarrier& b) {
  asm volatile("s_waitcnt vmcnt(0)" ::: "memory");
  __syncthreads();
  if (threadIdx.x == 0) {
    unsigned* bar = b.bar;
    __builtin_amdgcn_s_waitcnt(0);
    unsigned nloc = b.st[0], nx = b.st[1];
    if (nloc == 0u) { xcd_barrier_complete(bar, b.x, nloc, nx); b.st[0] = nloc; b.st[1] = nx; }
    const unsigned old = xb_add(&bar[XB_XSUB(b.x)], 1u);
    const unsigned gen = old / nloc;
    if (old + 1u == (gen + 1u) * nloc) {
      __builtin_amdgcn_fence(__ATOMIC_RELEASE, "agent");
      asm volatile("s_waitcnt vmcnt(0)" ::: "memory");
      const unsigned og = xb_add(&bar[XB_TOP], 1u);
      const unsigned tg = og / nx;
      if (og + 1u == (tg + 1u) * nx) xb_add(&bar[XB_TOPGEN], 1u);
      else XB_SPIN(xb_ld(&bar[XB_TOPGEN]) == tg, bar);
      __builtin_amdgcn_fence(__ATOMIC_ACQUIRE, "agent");
      xb_add(&bar[XB_XGEN(b.x)], 1u);
      asm volatile("s_waitcnt vmcnt(0)" ::: "memory");
    } else {
      XB_SPIN(xb_ld(&bar[XB_XGEN(b.x)]) == gen, bar);
      __builtin_amdgcn_fence(__ATOMIC_ACQUIRE, "agent");
      asm volatile("s_waitcnt vmcnt(0)" ::: "memory");
    }
  }
  __syncthreads();
}

DEVI void sub_barrier(unsigned* word, unsigned expected) {
  asm volatile("s_waitcnt vmcnt(0)" ::: "memory");
  __syncthreads();
  if (threadIdx.x == 0) {
    __builtin_amdgcn_fence(__ATOMIC_RELEASE, "agent");
    asm volatile("s_waitcnt vmcnt(0)" ::: "memory");
    xb_add(word, 1u);
    unsigned sp = 0;
    while (xb_ld(word) < expected) { __builtin_amdgcn_s_sleep(1); if (++sp > XB_SPIN_CAP) break; }
    __builtin_amdgcn_fence(__ATOMIC_ACQUIRE, "agent");
    asm volatile("s_waitcnt vmcnt(0)" ::: "memory");
  }
  __syncthreads();
}

#ifndef PROBE_RW
#define PROBE_RW 0
#endif
#ifndef PROBE_GD
#define PROBE_GD 0
#endif
#ifndef PROBE_HY
#define PROBE_HY 0
#endif
#ifndef REP_HYPREP
#define REP_HYPREP 1
#endif
#ifndef REP_POST
#define REP_POST 1
#endif
#ifndef REP_ATT
#define REP_ATT 1
#endif
#ifndef REP_NORM
#define REP_NORM 1
#endif
#ifndef REP_P0
#define REP_P0 1
#endif
#ifndef REP_SYNC
#define REP_SYNC 0
#endif
#ifndef REP_MIX
#define REP_MIX 1
#endif
#ifndef REP_G1
#define REP_G1 1
#endif
#ifndef EN_HY
#define EN_HY 1
#endif
#ifndef EN_RW
#define EN_RW 1
#endif
#ifndef EN_GD
#define EN_GD 1
#endif
#ifndef EN_XA
#define EN_XA 1
#endif

__global__ void __launch_bounds__(NTHR, 2) fwd_megakernel(Params p_unused) {
  __shared__ __attribute__((aligned(16))) char smem[SMEM_BYTES];
  const KP kp0 = (KP)__builtin_amdgcn_kernarg_segment_ptr();
#define p (opqk(kp0))
  cg::grid_group grid = cg::this_grid();
  __shared__ uint4 xb_words;
  if (threadIdx.x == 0) xb_words = make_uint4(0u, 0u, 0u, 0u);
  __syncthreads();
  const XcdBarrier xb = xcd_barrier_post((unsigned*)(kp0->ws + OFF_BAR), (volatile LAS unsigned*)&xb_words);
  const int bid = blockIdx.x, nb = gridDim.x;
#define ws (p->ws)
#define WA ((u16*)(ws + OFF_WA))
#define WB ((u16*)(ws + OFF_WB))
#define WKV ((u16*)(ws + OFF_WKV))
#define MEMN ((u16*)(ws + OFF_MEMN))
#define HN ((u16*)(ws + OFF_HN))
#define BIG ((u16*)(ws + OFF_BIG))
#define X (p->out)

  if (gridDim.x == 0x7fffffffu) grid.sync();
  for (int rs_ = 0; rs_ < REP_SYNC; ++rs_) xcd_barrier(xb);

  for (int l = 0; l < 2; ++l) {
    int bid_l = blockIdx.x; asm volatile("" : "+s"(bid_l));
    const float* xin = (l == 0) ? p->in[I_X] : X;
    rmsnorm_phase<false>(xin, p->in[I_NFFN1] + l * DM, HN, T_, bid_l, nb);
    convert_phase(p->in[I_F1W1] + (size_t)l * DM * DFF, p->in[I_F1W3] + (size_t)l * DM * DFF, DM, 2 * DFF, 2 * DFF, WA, smem, bid_l, nb);
    convert_phase(p->in[I_F1W2] + (size_t)l * DFF * DM, nullptr, DFF, DM, DM, WB, smem, bid_l, nb);
    xcd_barrier(xb);
    for (int rep_ = 0; rep_ < REP_G1; ++rep_) {
      run_gemm(smem, HN, WA, T_, 2 * DFF, DM, pg8::EpiSwiglu{BIG, DFF}, bid_l, 0, nb);
      xcd_barrier(xb);
    }
    run_gemm(smem, BIG, WB, T_, DM, DFF, pg8::EpiResid{X, xin, 0.5f}, bid_l, 0, nb);
    xcd_barrier(xb);
    rmsnorm_phase<false>(X, p->in[I_NMIX] + l * DM, HN, T_, bid_l, nb);
    convert_phase(p->in[I_WIN] + (size_t)l * DM * INC, nullptr, DM, INC, INCP, WA, smem, bid_l, nb);
    convert_phase(p->in[I_WOUT] + (size_t)l * DM * DM, nullptr, DM, DM, DM, WB, smem, bid_l, nb);
    convert_phase(p->in[I_GLORA] + (size_t)l * 128 * 384, nullptr, 128, 384, 384, WKV, smem, (bid_l + 128) % nb, nb);
    xcd_barrier(xb);
    run_gemm(smem, HN, WA, T_, INCP, DM, pg8::EpiBf16{BIG, INC, INC}, bid_l, 0, nb);
    xcd_barrier(xb);
#define hy_own_prep (gridDim.x == 256u)
    if (!hy_own_prep) {
      hyprep_phase(p, l, smem, bid_l, nb);
      xcd_barrier(xb);
    }
    for (int rep_ = 0; rep_ < REP_MIX; ++rep_) {
      if (rep_ > 0) xcd_barrier(xb);
      const int t5 = otid();
      const int half = t5 >> 8, tl5 = t5 & 255;
      char* hsm = smem + half * SCAN_SMEM;
      int rb_ = bid_l; asm volatile("" : "+s"(rb_));
      for (int r = rb_; r < 256; r += nb) {
        if (r < 192) {
          const int q_ = (r < 96) ? r : r - 96;
          const int it_ = (((q_ >> 4) * 8 + (q_ & 7)) << 1) | ((q_ >> 3) & 1);
          if (r < 96) rwscan_pc_item(p, l, it_, smem);
          else {
            gdscan_pc_item(p, l, it_, smem);
            if (hy_own_prep) {
              const int gb = r - 96;
              u16* wk_t = (u16*)(ws + OFF_WKV + (2u << 20));
              u16* wv_t = (u16*)(ws + OFF_WKV + (4u << 20));
              __syncthreads();
              convert_phase(p->in[I_WK] + (size_t)l * DM * DM, nullptr, DM, DM, DM, wk_t, smem, gb, 96);
              convert_phase(p->in[I_WV] + (size_t)l * DM * DM, nullptr, DM, DM, DM, wv_t, smem, gb, 96);
              if (l == 0) rmsnorm_phase<false>(p->in[I_MEM], p->in[I_MEMNORM], MEMN, 1024, gb, 96);
              sub_barrier((unsigned*)(ws + OFF_BAR) + 3776 + 64 * l, 96u);
              run_gemm(smem, MEMN, wk_t, 1024, 1024, DM, pg8::EpiBf16{(u16*)(ws + OFF_KM) + (size_t)l * DM * DM, DM, DM}, gb, 0, 16);
              run_gemm(smem, wv_t, MEMN, 1024, 1024, DM, pg8::EpiBf16{(u16*)(ws + OFF_VT) + (size_t)l * DM * DM, DM, DM}, gb, 16, 16);
            }
          }
        }
        else if (EN_HY) {
          if (hy_own_prep) {
            hyfilter_phase(p, smem, r - 192, 64, l, OFF_YC);
            sub_barrier((unsigned*)(ws + OFF_BAR) + 3648 + 64 * l, 64u);
            hynorm_phase(p, smem, r - 192, 64, l, OFF_YC);
            hyprep_phase(p, l, smem, r - 192, 64);
            sub_barrier((unsigned*)(ws + OFF_BAR) + 3520 + 64 * l, 64u);
          }
          for (int c = r - 192; c < 256; c += 64) hyconv_item(p, l, c, smem);
        }
      }
    }
    xcd_barrier(xb);
    for (int rep_ = 0; rep_ < REP_POST; ++rep_) {
      for (int it = bid_l; it < 512; it += nb) post_tok_item(p, l, it, smem);
      xcd_barrier(xb);
    }
    run_gemm(smem, HN, WB, T_, DM, DM, pg8::EpiResid{X, X, 1.0f}, bid_l, 0, nb);
    xcd_barrier(xb);
    for (int rep_ = 0; rep_ < REP_NORM; ++rep_)
    rmsnorm_phase<false>(X, p->in[I_NXA] + l * DM, HN, T_, bid_l, nb);
    convert_phase(p->in[I_WQ] + (size_t)l * DM * DM, nullptr, DM, DM, DM, WA, smem, bid_l, nb);
    convert_phase(p->in[I_WO] + (size_t)l * DM * DM, nullptr, DM, DM, DM, WB, smem, bid_l, nb);
    xcd_barrier(xb);
#if EN_XA
    run_gemm(smem, HN, WA, T_, DM, DM, pg8::EpiBf16{BIG, DM, DM}, bid_l, 0, nb);
    xcd_barrier(xb);
    for (int rep_ = 0; rep_ < REP_ATT; ++rep_) {
      attn_phase(p, l, smem, bid_l, nb);
      xcd_barrier(xb);
    }
    run_gemm(smem, HN, WB, T_, DM, DM, pg8::EpiResid{X, X, 1.0f}, bid_l, 0, nb);
    xcd_barrier(xb);
#endif
    rmsnorm_phase<false>(X, p->in[I_NFFN2] + l * DM, HN, T_, bid_l, nb);
    convert_phase(p->in[I_F2W1] + (size_t)l * DM * DFF, p->in[I_F2W3] + (size_t)l * DM * DFF, DM, 2 * DFF, 2 * DFF, WA, smem, bid_l, nb);
    convert_phase(p->in[I_F2W2] + (size_t)l * DFF * DM, nullptr, DFF, DM, DM, WB, smem, bid_l, nb);
    xcd_barrier(xb);
    for (int rep_ = 0; rep_ < REP_G1; ++rep_) {
      run_gemm(smem, HN, WA, T_, 2 * DFF, DM, pg8::EpiSwiglu{BIG, DFF}, bid_l, 0, nb);
      xcd_barrier(xb);
    }
    run_gemm(smem, BIG, WB, T_, DM, DFF, pg8::EpiResid{X, X, 0.5f}, bid_l, 0, nb);
    xcd_barrier(xb);
  }
  rmsnorm_phase<true>(X, p->in[I_NFINAL], X, T_, bid, nb);
#undef p
#undef ws
#undef WA
#undef WB
#undef WKV
#undef MEMN
#undef HN
#undef BIG
#undef X
}

extern "C" void kernel_launch(void* const* d_in, const int* in_sizes, int n_in, void* d_out, int out_size, void* d_ws,
                              size_t ws_size, hipStream_t stream) {
  static int grid_blocks = 0;
  if (!grid_blocks) {
    int dev = 0, cus = 0, per_cu = 0;
    (void)hipGetDevice(&dev);
    (void)hipDeviceGetAttribute(&cus, hipDeviceAttributeMultiprocessorCount, dev);
    (void)hipOccupancyMaxActiveBlocksPerMultiprocessor(&per_cu, fwd_megakernel, NTHR, 0);
    if (per_cu != 1) per_cu = 1;
    grid_blocks = cus * per_cu;
  }
  Params p{};
  for (int i = 0; i < 46; ++i) p.in[i] = (const float*)d_in[i];
  p.out = (float*)d_out;
  p.ws = (char*)d_ws;
  (void)hipMemsetAsync((char*)d_ws + OFF_BAR, 0, 16384, stream);
  void* args[] = {&p};
  hipError_t e = hipLaunchCooperativeKernel((void*)fwd_megakernel, dim3(grid_blocks), dim3(NTHR), args, 0, stream);
  if (e != hipSuccess) fprintf(stderr, "cooperative launch failed: %s (grid %d)\n", hipGetErrorString(e), grid_blocks);
}
```

```cpp
#include <hip/hip_runtime.h>
#include <hip/hip_bf16.h>
#include <hip/hip_cooperative_groups.h>
#include <cstdio>
namespace cg = cooperative_groups;

typedef unsigned short u16;
using bf16x8 = __attribute__((ext_vector_type(8))) short;
using f32x4 = __attribute__((ext_vector_type(4))) float;

#define DEVI __device__ __forceinline__

constexpr int T_ = 32768, L_ = 8192, NB_ = 4, DM = 1024, DFF = 2816, INC = 3864, INCP = 4096;
constexpr int NTHR = 512, NWV = NTHR / 64;

constexpr size_t OFF_WA = 0;
constexpr size_t OFF_WB = OFF_WA + 11534336;
constexpr size_t OFF_WKV = OFF_WB + 5767168;
constexpr size_t OFF_MEMN = OFF_WKV + 8388608;
constexpr size_t OFF_KM = OFF_MEMN + 2097152;
constexpr size_t OFF_VT = OFF_KM + 4194304;
constexpr size_t OFF_RK = OFF_VT + 4194304;
constexpr size_t OFF_UB = OFF_RK + 16777216;
constexpr size_t OFF_YC = OFF_UB + 20971520;
constexpr size_t OFF_HN = OFF_YC + 16777216;
constexpr size_t OFF_YRW = OFF_HN + 67108864;
constexpr size_t OFF_YGD = OFF_YRW + 50331648;
constexpr size_t OFF_BIG = OFF_YGD + 50331648;
constexpr size_t OFF_BAR = OFF_BIG + 253231104;
constexpr size_t OFF_X0 = OFF_BAR + 16384;
constexpr int UBS = 10240;
constexpr int SCAN_SMEM = 75776;
constexpr int SMEM_BYTES = 2 * SCAN_SMEM;

struct Params {
  const float* in[46];
  float* out;
  char* ws;
};

typedef const __attribute__((address_space(4))) Params* KP;
DEVI KP opqk(KP k) { asm volatile("" : "+s"(k)); return k; }

enum {
  I_X = 0, I_MEM, I_NFFN1, I_F1W1, I_F1W3, I_F1W2, I_NMIX, I_WIN, I_WOUT, I_HYCW, I_HYCB, I_HYFREQ, I_HYW1, I_HYB1,
  I_HYW2, I_HYB2, I_HYW3, I_HYDEC, I_HYBIAS, I_MUP, I_MUN, I_WLORA, I_W0, I_ALORA, I_A0, I_GLORA, I_KK, I_KA, I_RK,
  I_GNW, I_GNB, I_GCW, I_GALOG, I_GDT, I_GNORM, I_NXA, I_WQ, I_WK, I_WV, I_WO, I_MEMNORM, I_NFFN2, I_F2W1, I_F2W3,
  I_F2W2, I_NFINAL
};

typedef __bf16 bf16x2_t __attribute__((ext_vector_type(2)));
DEVI unsigned cvtpk(float lo, float hi) { bf16x2_t v = {(__bf16)lo, (__bf16)hi}; return __builtin_bit_cast(unsigned, v); }
DEVI u16 f2bf(float f) { return (u16)(cvtpk(f, 0.f) & 0xffffu); }
DEVI float frcp(float x) { return __builtin_amdgcn_rcpf(x); }
DEVI float bf2f(u16 h) { return __uint_as_float(((unsigned)h) << 16); }
DEVI float bflo(unsigned v) { return __uint_as_float(v << 16); }
DEVI float bfhi(unsigned v) { return __uint_as_float(v & 0xffff0000u); }
DEVI unsigned pack2(float a, float b) { return cvtpk(a, b); }
DEVI float sigm(float x) { return frcp(1.f + __expf(-x)); }
DEVI float siluf(float x) { return x * frcp(1.f + __expf(-x)); }

DEVI void unpack8(uint4 v, float* f) {
  f[0] = bflo(v.x); f[1] = bfhi(v.x); f[2] = bflo(v.y); f[3] = bfhi(v.y);
  f[4] = bflo(v.z); f[5] = bfhi(v.z); f[6] = bflo(v.w); f[7] = bfhi(v.w);
}
DEVI uint4 pack8(const float* f) {
  uint4 v; v.x = pack2(f[0], f[1]); v.y = pack2(f[2], f[3]); v.z = pack2(f[4], f[5]); v.w = pack2(f[6], f[7]);
  return v;
}

template <int CTRL> DEVI float dppf(float x) {
  return __int_as_float(__builtin_amdgcn_update_dpp(0, __float_as_int(x), CTRL, 0xf, 0xf, true));
}
DEVI float allsum16(float x) {
  x += dppf<0xB1>(x);
  x += dppf<0x4E>(x);
  x += dppf<0x141>(x);
  x += dppf<0x140>(x);
  return x;
}
DEVI float allsum8(float x) {
  x += dppf<0xB1>(x);
  x += dppf<0x4E>(x);
  x += dppf<0x141>(x);
  return x;
}
DEVI int otid() { int t = threadIdx.x; asm volatile("" : "+v"(t)); return t; }
template <class Tp> DEVI const Tp* opq(const Tp* p) { asm volatile("" : "+v"(p)); return p; }
typedef float f32x2 __attribute__((ext_vector_type(2)));
DEVI float dot4(float s0, float s1, float s2, float s3, const float4& k) {
  f32x2 t = f32x2{s0, s1} * f32x2{k.x, k.y};
  t = __builtin_elementwise_fma(f32x2{s2, s3}, f32x2{k.z, k.w}, t);
  return t.x + t.y;
}
DEVI float wavesum(float x) {
  for (int o = 32; o > 0; o >>= 1) x += __shfl_xor(x, o, 64);
  return x;
}

DEVI void convert_phase(const float* __restrict__ W0, const float* __restrict__ W1, int K, int N, int Npad,
                              u16* __restrict__ Wt, char* smem, int bid, int nb) {
  float* tile = (float*)smem;
  const int tid = otid();
  const int kt = K / 64;
  const int ntiles = (Npad / 64) * kt;
  const int NW = W1 ? N / 2 : N;
  for (int t = bid; t < ntiles; t += nb) {
    const int n0 = (t / kt) * 64, k0 = (t % kt) * 64;
#pragma unroll 4
    for (int i = 0; i < 64 / NWV; ++i) {
      int kk = i * NWV + (tid >> 6), nn = tid & 63, R = n0 + nn;
      float v = 0.f;
      if (R < N) {
        if (W1) {
          int g = R >> 5, wi = R & 31;
          const float* src = (wi < 16) ? W0 : W1;
          v = src[(size_t)(k0 + kk) * NW + g * 16 + (wi & 15)];
        } else {
          v = W0[(size_t)(k0 + kk) * NW + R];
        }
      }
      tile[kk * 65 + nn] = v;
    }
    __syncthreads();
#pragma unroll 4
    for (int i = 0; i < 64 / NWV; ++i) {
      int nn = i * NWV + (tid >> 6), kk = tid & 63;
      Wt[(size_t)(n0 + nn) * K + k0 + kk] = f2bf(tile[kk * 65 + nn]);
    }
    __syncthreads();
  }
}

template <bool OUT_F32>
DEVI void rmsnorm_phase(const float* __restrict__ x, const float* __restrict__ g, void* outp, int rows, int bid,
                              int nb) {
  const int tid_ = otid();
  const int lane = tid_ & 63, wv = tid_ >> 6;
  for (int r = bid * NWV + wv; r < rows; r += nb * NWV) {
    const float* xr = x + (size_t)r * DM;
    float4 v[4];
    float ss = 0.f;
#pragma unroll
    for (int i = 0; i < 4; ++i) {
      v[i] = *(const float4*)(xr + i * 256 + lane * 4);
      ss += v[i].x * v[i].x + v[i].y * v[i].y + v[i].z * v[i].z + v[i].w * v[i].w;
    }
    ss = wavesum(ss);
    const float sc = rsqrtf(ss * (1.f / DM) + 1e-6f);
#pragma unroll
    for (int i = 0; i < 4; ++i) {
      float4 gg = *(const float4*)(g + i * 256 + lane * 4);
      float a = v[i].x * sc * gg.x, b = v[i].y * sc * gg.y, c = v[i].z * sc * gg.z, d = v[i].w * sc * gg.w;
      if (OUT_F32) {
        *(float4*)((float*)outp + (size_t)r * DM + i * 256 + lane * 4) = make_float4(a, b, c, d);
      } else {
        uint2 o; o.x = pack2(a, b); o.y = pack2(c, d);
        *(uint2*)((u16*)outp + (size_t)r * DM + i * 256 + lane * 4) = o;
      }
    }
  }
}

namespace pg8 {
#define PG8_LAS __attribute__((address_space(3)))
typedef unsigned u32x4 __attribute__((ext_vector_type(4)));
constexpr int BM = 256, BK = 64, HALF = 128, HTB = HALF * BK * 2, NXCD = 8, WGM = 8;
DEVI int lds_byte(int r, int c) { const int st = (r >> 4) * 2 + (c >> 5), rr = r & 15, cc = c & 31, ob = rr * 64 + cc * 2; return st * 1024 + (ob ^ (((ob >> 9) & 1) << 5)); }
DEVI void stage_rc(int b, int& R, int& C) { const int st = b / 1024, sb = b % 1024, swz = sb ^ (((sb >> 9) & 1) << 5); R = (st >> 1) * 16 + swz / 64; C = (st & 1) * 32 + (swz % 64) / 2; }
DEVI int perm32(int rho) { const int n = rho >> 4, i = rho & 15; return 8 * (i >> 2) + 4 * n + (i & 3); }
struct Unit { int pm, pn; };
struct Gemm { const u16* A; const u16* Bt; int M, N, K; };
struct StaticOrder {
  int nM, nN, nwg, G, c;
  DEVI void init(int M, int N, int G_, int c_) { nM = M / BM; nN = N / BM; nwg = nM * nN; G = G_; c = c_; }
  DEVI bool next(int i, Unit& u) const {
    const long L = (long)i * G + c; if (L >= nwg) return false;
    int wgid = (int)L; { const int q = nwg / NXCD, r = nwg % NXCD, xcd = wgid % NXCD, off = wgid / NXCD; wgid = (xcd < r ? xcd * (q + 1) : r * (q + 1) + (xcd - r) * q) + off; }
    const int nig = WGM * nN, gid = wgid / nig, fm = gid * WGM, gsz = (nM - fm) < WGM ? (nM - fm) : WGM;
    u.pm = fm + ((wgid % nig) % gsz); u.pn = (wgid % nig) / gsz; return true;
  }
};
DEVI unsigned cvt_pk_bf16(float lo, float hi) { return cvtpk(lo, hi); }

struct EpiBf16 {
  static constexpr bool PERM = true;
  u16* O; int ldc; int N;
  DEVI void operator()(const f32x4 (&acc)[2][2][4][2], const Unit& u, int wr, int wc, int fr, int fq) const {
    const int row0 = u.pm * BM + wr * 64 + fr, col0 = u.pn * BM + wc * 32 + 8 * fq;
#pragma unroll
    for (int ai = 0; ai < 2; ++ai)
#pragma unroll
      for (int m = 0; m < 4; ++m) {
        u16* rowp = O + (size_t)(row0 + ai * HALF + m * 16) * ldc + col0;
#pragma unroll
        for (int bj = 0; bj < 2; ++bj) {
          const f32x4 v0 = acc[ai][bj][m][0], v1 = acc[ai][bj][m][1];
          u32x4 w; w.x = cvt_pk_bf16(v0[0], v0[1]); w.y = cvt_pk_bf16(v0[2], v0[3]); w.z = cvt_pk_bf16(v1[0], v1[1]); w.w = cvt_pk_bf16(v1[2], v1[3]);
          if (col0 + bj * HALF < N) *(u32x4*)(rowp + bj * HALF) = w;
        }
      }
  }
};
struct EpiSwiglu {
  static constexpr bool PERM = false;
  u16* U; int ldu;
  DEVI void operator()(const f32x4 (&acc)[2][2][4][2], const Unit& u, int wr, int wc, int fr, int fq) const {
    const int row0 = u.pm * BM + wr * 64 + fr;
#pragma unroll
    for (int ai = 0; ai < 2; ++ai)
#pragma unroll
      for (int m = 0; m < 4; ++m) {
        u16* rowp = U + (size_t)(row0 + ai * HALF + m * 16) * ldu;
#pragma unroll
        for (int bj = 0; bj < 2; ++bj) {
          const int g32 = (u.pn * BM + bj * HALF + wc * 32) >> 5;
          const f32x4 a = acc[ai][bj][m][0], b = acc[ai][bj][m][1];
          uint2 w;
          w.x = cvt_pk_bf16(siluf(a[0]) * b[0], siluf(a[1]) * b[1]);
          w.y = cvt_pk_bf16(siluf(a[2]) * b[2], siluf(a[3]) * b[3]);
          *(uint2*)(rowp + g32 * 16 + 4 * fq) = w;
        }
      }
  }
};
struct EpiResid {
  static constexpr bool PERM = false;
  float* X; const float* Xin; float scale;
  DEVI void operator()(const f32x4 (&acc)[2][2][4][2], const Unit& u, int wr, int wc, int fr, int fq) const {
    const int row0 = u.pm * BM + wr * 64 + fr, col0 = u.pn * BM + wc * 32 + 4 * fq;
#pragma unroll
    for (int ai = 0; ai < 2; ++ai)
#pragma unroll
      for (int m = 0; m < 4; ++m) {
        const size_t ro = (size_t)(row0 + ai * HALF + m * 16) * DM + col0;
#pragma unroll
        for (int bj = 0; bj < 2; ++bj)
#pragma unroll
          for (int n = 0; n < 2; ++n) {
            const f32x4 xi = *(const f32x4*)(Xin + ro + bj * HALF + n * 16);
            *(f32x4*)(X + ro + bj * HALF + n * 16) = xi + acc[ai][bj][m][n] * scale;
          }
      }
  }
};

template <class Epi>
DEVI void gemm_phase(PG8_LAS unsigned char* lds, const Gemm g, const StaticOrder& S, const Epi& E) {
  const int tid = otid(), wid = __builtin_amdgcn_readfirstlane(tid >> 6), lane = tid & 63, wr = wid >> 2, wc = wid & 3, fr = lane & 15, fq = lane >> 4;
  const int K = g.K, nt = K / BK;
  unsigned voffA[2], voffB[2];
#pragma unroll
  for (int i = 0; i < 2; ++i) { int R, C; stage_rc(tid * 16 + i * 8192, R, C); const int Rb = Epi::PERM ? ((R & ~31) + perm32(R & 31)) : R;
    voffA[i] = (unsigned)(R * K + C) * 2u; voffB[i] = (unsigned)(Rb * K + C) * 2u; }
  const size_t kstep = (size_t)(BK * 2);
  const size_t hstep = (size_t)HALF * K * 2;
  const size_t tstep = 2 * hstep;
  const unsigned ldsw = (unsigned)wid * 1024u;
  const int aoff = lds_byte(wr * 64 + fr, fq * 8), boff = lds_byte(wc * 32 + fr, fq * 8);
#define PG8_SA(b, h) (((b) * 2 + (h)) * HTB)
#define PG8_SB(b, h) ((4 + (b) * 2 + (h)) * HTB)
#define PG8_STAGE(bufoff, gbase, voff) do { _Pragma("unroll") for (int _i = 0; _i < 2; ++_i) \
    __builtin_amdgcn_global_load_lds((const unsigned*)((const char*)(gbase) + (voff)[_i]), (PG8_LAS unsigned*)(lds + (bufoff) + ldsw + _i * 8192), 16, 0, 0); } while (0)
#define PG8_LDA(dst, b, h) do { _Pragma("unroll") for (int m = 0; m < 4; ++m) _Pragma("unroll") for (int k = 0; k < 2; ++k) dst[m][k] = *(const PG8_LAS bf16x8*)(lds + PG8_SA(b, h) + aoff + m * 2048 + k * 1024); } while (0)
#define PG8_LDB(dst, b, h) do { _Pragma("unroll") for (int n = 0; n < 2; ++n) _Pragma("unroll") for (int k = 0; k < 2; ++k) dst[n][k] = *(const PG8_LAS bf16x8*)(lds + PG8_SB(b, h) + boff + n * 2048 + k * 1024); } while (0)
#define PG8_MMA(ai, bj, At, Bt) do { __builtin_amdgcn_s_setprio(1); _Pragma("unroll") for (int m = 0; m < 4; ++m) _Pragma("unroll") for (int n = 0; n < 2; ++n) _Pragma("unroll") for (int k = 0; k < 2; ++k) \
    acc[ai][bj][m][n] = __builtin_amdgcn_mfma_f32_16x16x32_bf16(Bt[n][k], At[m][k], acc[ai][bj][m][n], 0, 0, 0); __builtin_amdgcn_s_setprio(0); } while (0)
#define PG8_WAIT_V(n) asm volatile("s_waitcnt vmcnt(" #n ")" ::: "memory")
#define PG8_WAIT_L(n) asm volatile("s_waitcnt lgkmcnt(" #n ")" ::: "memory")
#define PG8_BAR __builtin_amdgcn_s_barrier()
#define PG8_SCHED __builtin_amdgcn_sched_barrier(0)
  Unit cur, nxt; int ui = 0;
  if (!S.next(0, cur)) return;
  f32x4 acc[2][2][4][2];
#pragma unroll
  for (int a = 0; a < 2; ++a)
#pragma unroll
    for (int b = 0; b < 2; ++b)
#pragma unroll
      for (int m = 0; m < 4; ++m)
#pragma unroll
        for (int n = 0; n < 2; ++n) acc[a][b][m][n] = (f32x4){0.f, 0.f, 0.f, 0.f};
  bf16x8 At[4][2], B0[2][2], B1[2][2];
  const char* cA = (const char*)g.A + (size_t)cur.pm * tstep; const char* cB = (const char*)g.Bt + (size_t)cur.pn * tstep;
  PG8_STAGE(PG8_SB(0, 0), cB, voffB); PG8_STAGE(PG8_SA(0, 0), cA, voffA); PG8_STAGE(PG8_SB(0, 1), cB + hstep, voffB); PG8_STAGE(PG8_SA(0, 1), cA + hstep, voffA);
  if (wr == 1) PG8_BAR;
  PG8_WAIT_V(4); PG8_BAR;
  PG8_STAGE(PG8_SB(1, 0), cB + kstep, voffB); PG8_STAGE(PG8_SA(1, 0), cA + kstep, voffA); PG8_STAGE(PG8_SB(1, 1), cB + hstep + kstep, voffB);
  PG8_WAIT_V(6); PG8_BAR;
  for (;;) {
    const bool has_next = S.next(ui + 1, nxt);
    const char* nA = has_next ? (const char*)g.A + (size_t)nxt.pm * tstep : cA; const char* nB = has_next ? (const char*)g.Bt + (size_t)nxt.pn * tstep : cB;
    for (int t = 0; t < nt; t += 2) {
      const bool last = (t == nt - 2);
      const char* a1 = cA + (size_t)(t + 1) * kstep;
      const char* a2 = last ? nA : cA + (size_t)(t + 2) * kstep; const char* b2 = last ? nB : cB + (size_t)(t + 2) * kstep;
      const char* a3 = a2 + kstep; const char* b3 = b2 + kstep;
      PG8_LDB(B0, 0, 0); PG8_SCHED; PG8_LDA(At, 0, 0); PG8_STAGE(PG8_SA(1, 1), a1 + hstep, voffA);
      PG8_WAIT_L(8); PG8_BAR; PG8_WAIT_L(0); PG8_MMA(0, 0, At, B0); PG8_BAR; PG8_SCHED;
      PG8_LDB(B1, 0, 1); PG8_STAGE(PG8_SB(0, 0), b2, voffB);
      PG8_BAR; PG8_WAIT_L(0); PG8_MMA(0, 1, At, B1); PG8_BAR;
      PG8_LDA(At, 0, 1); PG8_STAGE(PG8_SA(0, 0), a2, voffA);
      PG8_BAR; PG8_WAIT_L(0); PG8_MMA(1, 0, At, B0); PG8_BAR; PG8_SCHED;
      PG8_STAGE(PG8_SB(0, 1), b2 + hstep, voffB);
      PG8_WAIT_V(6); PG8_BAR; PG8_MMA(1, 1, At, B1); PG8_BAR;
      PG8_LDB(B0, 1, 0); PG8_SCHED; PG8_LDA(At, 1, 0); PG8_STAGE(PG8_SA(0, 1), a2 + hstep, voffA);
      PG8_WAIT_L(8); PG8_BAR; PG8_WAIT_L(0); PG8_MMA(0, 0, At, B0); PG8_BAR; PG8_SCHED;
      PG8_LDB(B1, 1, 1); PG8_STAGE(PG8_SB(1, 0), b3, voffB);
      PG8_BAR; PG8_WAIT_L(0); PG8_MMA(0, 1, At, B1); PG8_BAR;
      PG8_LDA(At, 1, 1); PG8_STAGE(PG8_SA(1, 0), a3, voffA);
      PG8_BAR; PG8_WAIT_L(0); PG8_MMA(1, 0, At, B0); PG8_BAR; PG8_SCHED;
      PG8_STAGE(PG8_SB(1, 1), b3 + hstep, voffB);
      PG8_WAIT_V(6); PG8_BAR; PG8_MMA(1, 1, At, B1); PG8_BAR;
    }
    E(acc, cur, wr, wc, fr, fq);
    if (!has_next) break;
#pragma unroll
    for (int a = 0; a < 2; ++a)
#pragma unroll
      for (int b = 0; b < 2; ++b)
#pragma unroll
        for (int m = 0; m < 4; ++m)
#pragma unroll
          for (int n = 0; n < 2; ++n) acc[a][b][m][n] = (f32x4){0.f, 0.f, 0.f, 0.f};
    cur = nxt; cA = nA; cB = nB; ++ui;
  }
  PG8_WAIT_V(0);
  if (wr == 0) PG8_BAR;
  PG8_BAR;
#undef PG8_SA
#undef PG8_SB
#undef PG8_STAGE
#undef PG8_LDA
#undef PG8_LDB
#undef PG8_MMA
#undef PG8_WAIT_V
#undef PG8_WAIT_L
#undef PG8_BAR
#undef PG8_SCHED
}
}

template <class Epi>
DEVI void run_gemm(char* smem, const u16* A, const u16* Bt, int M, int N, int K, const Epi& E, int bid, int b0, int G) {
  pg8::StaticOrder S;
  asm volatile("" : "+s"(bid));
  const int c = (bid >= b0 && bid < b0 + G) ? (bid - b0) : (1 << 28);
  S.init(M, N, G, c);
  pg8::Gemm g{A, Bt, M, N, K};
  pg8::gemm_phase<Epi>((PG8_LAS unsigned char*)smem, g, S, E);
}

DEVI void hyfilter_phase(KP p, char* smem, int bid, int nb, int l_only = -1, size_t hoff = OFF_YRW) {
  float* z = (float*)smem;
  float* h1 = z + 16 * 33;
  float* h2 = h1 + 16 * 64;
  float* HRAW = (float*)(p->ws + hoff);
  const int tid = otid();
  for (int it = bid; it < 512; it += nb) {
    const int l = l_only, t0 = it * 16;
    const int slot_ = 0;
    const float* freq = p->in[I_HYFREQ] + l * 64;
    const float* w1 = p->in[I_HYW1] + l * 33 * 64;
    const float* b1 = p->in[I_HYB1] + l * 64;
    const float* w2 = p->in[I_HYW2] + l * 64 * 64;
    const float* b2 = p->in[I_HYB2] + l * 64;
    const float* w3 = p->in[I_HYW3] + l * 64 * 512;
    const float* dec = p->in[I_HYDEC] + l * 512;
    for (int e = tid; e < 16 * 33; e += NTHR) {
      int pos = e / 33, f = e % 33;
      int i = t0 + pos;
      float v;
      if (f == 0) {
        v = (float)i / (float)(L_ - 1);
      } else {
        int m = (f - 1) & 15;
        float band = 1e-4f + (float)m * ((15.f - 1e-4f) / 15.f);
        float ang = 6.283185307179586f * (float)i / (float)L_;
        float a = band * ang;
        v = (f <= 16) ? cosf(a) : -sinf(a);
      }
      z[pos * 33 + f] = v;
    }
    __syncthreads();
    {
      const int o = tid & 63;
      const float fo = freq[o], bo = b1[o];
#pragma unroll
      for (int i = 0; i < 16 / NWV; ++i) {
        int pos = (tid >> 6) + NWV * i;
        float s = bo;
#pragma unroll 11
        for (int f = 0; f < 33; ++f) s += z[pos * 33 + f] * w1[f * 64 + o];
        h1[pos * 64 + o] = sinf(fo * s);
      }
    }
    __syncthreads();
    {
      const int o = tid & 63;
      const float fo = freq[o], bo = b2[o];
#pragma unroll
      for (int i = 0; i < 16 / NWV; ++i) {
        int pos = (tid >> 6) + NWV * i;
        float s = bo;
#pragma unroll 16
        for (int f = 0; f < 64; ++f) s += h1[pos * 64 + f] * w2[f * 64 + o];
        h2[pos * 64 + o] = sinf(fo * s);
      }
    }
    __syncthreads();
#pragma unroll 1
    for (int cc = 0; cc < 512 / NTHR; ++cc) {
      const int ch = tid + NTHR * cc;
      float acc[16];
#pragma unroll
      for (int q = 0; q < 16; ++q) acc[q] = 0.f;
#pragma unroll 8
      for (int o = 0; o < 64; ++o) {
        float w = w3[o * 512 + ch];
#pragma unroll
        for (int q = 0; q < 16; ++q) acc[q] += h2[q * 64 + o] * w;
      }
      const float dc = dec[ch];
      float* dst = HRAW + ((size_t)(slot_ * 512 + ch)) * L_ + t0;
#pragma unroll
      for (int q = 0; q < 16; ++q) {
        float tp = (float)(t0 + q) / (float)(L_ - 1);
        dst[q] = acc[q] * __expf(-tp * dc);
      }
    }
    __syncthreads();
  }
}

DEVI void hynorm_phase(KP p, char* smem, int bid, int nb, int l_only = -1, size_t hoff = OFF_YRW) {
  float* red = (float*)smem;
  const float* HRAW = (const float*)(p->ws + hoff);
  u16* RK = (u16*)(p->ws + OFF_RK);
  const int tid = otid();
  for (int it0_ = bid; it0_ < 256; it0_ += nb) {
    const int l = l_only, c = it0_;
    const int slot_ = 0;
    const int it = l * 256 + c;
    const float* hf = HRAW + ((size_t)(slot_ * 512 + c)) * L_;
    const float* hb = HRAW + ((size_t)(slot_ * 512 + 256 + c)) * L_;
    float s = 0.f;
    for (int t = tid; t < L_; t += NTHR) {
      s += fabsf(hf[t]);
      if (t > 0) s += fabsf(hb[t]);
    }
    s = wavesum(s);
    if ((tid & 63) == 0) red[tid >> 6] = s;
    __syncthreads();
    float tot = 0.f;
    for (int w = 0; w < NWV; ++w) tot += red[w];
    const float inv = 1.f / tot;
    u16* dst = RK + (size_t)it * 16384;
    for (int i = tid; i < 16384; i += NTHR) {
      int m = i - 8192;
      float v;
      if (m == -8192) v = 0.f;
      else if (m <= 0) v = hf[-m] * inv;
      else v = hb[m] * inv;
      dst[i] = f2bf(v);
    }
    __syncthreads();
  }
}

DEVI float ldP(const u16* P, int b, int t, int col) {
  return (t >= 0 && t < L_) ? bf2f(P[((size_t)(b * L_ + t)) * INC + col]) : 0.f;
}
DEVI uint4 ldrow8(const u16* P, int b, int t, int col);
DEVI void ld8f(const float* __restrict__ g, float* o);
DEVI void hyprep_phase(KP p, int l, char* smem, int bid, int nb) {
  float* tileU = (float*)smem;
  float* tileX = tileU + 64 * 65;
  const u16* P = (const u16*)(p->ws + OFF_BIG);
  u16* UB = (u16*)(p->ws + OFF_UB);
  u16* X0 = (u16*)(p->ws + OFF_X0);
  const float* cw = p->in[I_HYCW] + l * 3 * 768;
  const float* cb = p->in[I_HYCB] + l * 768;
  const int tid = otid();
  for (int it = bid; it < 2048; it += nb) {
    const int ct = it & 3, tt = (it >> 2) & 127, b = it >> 9;
    const int c0 = ct * 64, t0 = tt * 64;
    {
      const int tl = tid >> 3, cg = tid & 7, t = t0 + tl, c = c0 + cg * 8;
      float xs[3][8];
#pragma unroll
      for (int a3 = 0; a3 < 3; ++a3) {
        float pm[8], p0[8], pp[8], w0[8], w1[8], w2[8], bb[8];
        unpack8(ldrow8(P, b, t - 1, a3 * 256 + c), pm);
        unpack8(ldrow8(P, b, t, a3 * 256 + c), p0);
        unpack8(ldrow8(P, b, t + 1, a3 * 256 + c), pp);
        ld8f(cw + a3 * 256 + c, w0); ld8f(cw + 768 + a3 * 256 + c, w1); ld8f(cw + 1536 + a3 * 256 + c, w2);
        ld8f(cb + a3 * 256 + c, bb);
#pragma unroll
        for (int e = 0; e < 8; ++e) xs[a3][e] = w0[e] * pm[e] + w1[e] * p0[e] + w2[e] * pp[e] + bb[e];
      }
#pragma unroll
      for (int e = 0; e < 8; ++e) {
        tileU[tl * 65 + cg * 8 + e] = xs[1][e] * xs[2][e];
        tileX[tl * 65 + cg * 8 + e] = xs[0][e];
      }
    }
    __syncthreads();
    {
      const int cc = tid >> 3, tq = tid & 7;
      float u8[8], x8[8];
#pragma unroll
      for (int e = 0; e < 8; ++e) { u8[e] = tileU[(tq * 8 + e) * 65 + cc]; x8[e] = tileX[(tq * 8 + e) * 65 + cc]; }
      *(uint4*)(UB + ((size_t)((c0 + cc) * 4 + b)) * UBS + 1024 + t0 + tq * 8) = pack8(u8);
      *(uint4*)(X0 + ((size_t)((c0 + cc) * 4 + b)) * L_ + t0 + tq * 8) = pack8(x8);
    }
    if (tt == 0 || tt == 127) {
      const int poff = (tt == 0) ? 0 : (1024 + L_);
      for (int e = tid; e < 64 * 128; e += NTHR) {
        int cc = e >> 7, q = e & 127;
        *(uint4*)(UB + ((size_t)((c0 + cc) * 4 + b)) * UBS + poff + q * 8) = make_uint4(0, 0, 0, 0);
      }
    }
    __syncthreads();
  }
}

DEVI void hyconv_item(KP p, int l, int item, char* smem) {
  const int tid_ = otid();
  const int lane = tid_ & 63, wv = tid_ >> 6;
  const int fr = lane & 15, fq = lane >> 4;
  const int c = item, it32 = wv;
  const int a = it32 * 32;
  u16* sU = (u16*)smem;
  unsigned* sK = (unsigned*)(smem + 4 * UBS * 2);
  {
    const uint4* gu = (const uint4*)((const u16*)(p->ws + OFF_UB) + (size_t)(c * 4) * UBS);
    const uint4* gk = (const uint4*)((const u16*)(p->ws + OFF_RK) + (size_t)(l * 256 + c) * 16384);
    __syncthreads();
    for (int i = tid_; i < 4 * UBS / 8; i += NTHR) ((uint4*)sU)[i] = gu[i];
    for (int i = tid_; i < 16384 / 8; i += NTHR) ((uint4*)sK)[i] = gk[i];
    __syncthreads();
  }
  f32x4 acc[2][8];
#pragma unroll
  for (int m = 0; m < 2; ++m)
#pragma unroll
    for (int n = 0; n < 8; ++n) acc[m][n] = f32x4{0.f, 0.f, 0.f, 0.f};
#pragma unroll 1
  for (int D = a + 31; D >= a - 255; --D) {
    bf16x8 af[2];
#pragma unroll
    for (int mt = 0; mt < 2; ++mt) {
      int idx = fq * 8 - (mt * 16 + fr) - 32 * D + 8192;
      int bd = idx >> 1;
      unsigned sh = (idx & 1) * 16;
      unsigned d0 = sK[bd], d1 = sK[bd + 1], d2 = sK[bd + 2], d3 = sK[bd + 3], d4 = sK[bd + 4];
      union { unsigned u[4]; bf16x8 v; } cv;
      cv.u[0] = __builtin_amdgcn_alignbit(d1, d0, sh);
      cv.u[1] = __builtin_amdgcn_alignbit(d2, d1, sh);
      cv.u[2] = __builtin_amdgcn_alignbit(d3, d2, sh);
      cv.u[3] = __builtin_amdgcn_alignbit(d4, d3, sh);
      af[mt] = cv.v;
    }
#pragma unroll
    for (int n = 0; n < 8; ++n) {
      const int b = n >> 1, ct = n & 1;
      const int i1 = a + ct * 16 + fr;
      bf16x8 bf = *(const bf16x8*)(sU + b * UBS + 1024 + (i1 - D) * 32 + fq * 8);
      acc[0][n] = __builtin_amdgcn_mfma_f32_16x16x32_bf16(af[0], bf, acc[0][n], 0, 0, 0);
      acc[1][n] = __builtin_amdgcn_mfma_f32_16x16x32_bf16(af[1], bf, acc[1][n], 0, 0, 0);
    }
  }
  const u16* X0 = (const u16*)(p->ws + OFF_X0) + (size_t)(c * 4) * L_;
  u16* Yo = (u16*)(p->ws + OFF_HN);
  const float bias = p->in[I_HYBIAS][l * 256 + c];
#pragma unroll
  for (int n = 0; n < 8; ++n) {
    const int b = n >> 1, ct = n & 1;
    const int i1 = a + ct * 16 + fr;
#pragma unroll
    for (int mt = 0; mt < 2; ++mt) {
      const int t = i1 * 32 + mt * 16 + fq * 4;
      const uint2 xr = *(const uint2*)(X0 + (size_t)b * L_ + t);
      const uint2 ur = *(const uint2*)(sU + b * UBS + 1024 + t);
      const float x0[4] = {bflo(xr.x), bfhi(xr.x), bflo(xr.y), bfhi(xr.y)};
      const float uu[4] = {bflo(ur.x), bfhi(ur.x), bflo(ur.y), bfhi(ur.y)};
#pragma unroll
      for (int j = 0; j < 4; ++j)
        Yo[((size_t)(b * L_ + t + j)) * DM + c] = f2bf(x0[j] * (acc[mt][n][j] + bias * uu[j]));
    }
  }
}

DEVI uint4 ldrow8(const u16* P, int b, int t, int col) {
  if (t < 0 || t >= L_) return make_uint4(0, 0, 0, 0);
  return *(const uint4*)(P + ((size_t)(b * L_ + t)) * INC + col);
}
DEVI void shift8(uint4 pm, uint4 p0, uint4 pp, const float* __restrict__ mup, const float* __restrict__ mun,
                 float* out) {
  float a[8], u[8], n[8];
  unpack8(pm, a); unpack8(p0, u); unpack8(pp, n);
  float4 m0 = *(const float4*)mup, m1 = *(const float4*)(mup + 4);
  float4 n0 = *(const float4*)mun, n1 = *(const float4*)(mun + 4);
  float mp[8] = {m0.x, m0.y, m0.z, m0.w, m1.x, m1.y, m1.z, m1.w};
  float mn[8] = {n0.x, n0.y, n0.z, n0.w, n1.x, n1.y, n1.z, n1.w};
#pragma unroll
  for (int e = 0; e < 8; ++e) out[e] = u[e] + mp[e] * (a[e] - u[e]) + mn[e] * (n[e] - u[e]);
}
DEVI void ld8f(const float* __restrict__ g, float* o) {
  float4 a = *(const float4*)g, b = *(const float4*)(g + 4);
  o[0] = a.x; o[1] = a.y; o[2] = a.z; o[3] = a.w; o[4] = b.x; o[5] = b.y; o[6] = b.z; o[7] = b.w;
}
DEVI void st8f(float* s, const float* v) {
  *(float4*)s = make_float4(v[0], v[1], v[2], v[3]);
  *(float4*)(s + 4) = make_float4(v[4], v[5], v[6], v[7]);
}

DEVI float dot8(const f32x2 (&S)[4], const float4& a, const float4& b) {
  f32x2 t = S[0] * f32x2{a.x, a.y};
  f32x2 u = S[1] * f32x2{a.z, a.w};
  t = __builtin_elementwise_fma(S[2], f32x2{b.x, b.y}, t);
  u = __builtin_elementwise_fma(S[3], f32x2{b.z, b.w}, u);
  t += u;
  return t.x + t.y;
}

DEVI void rwscan_pc_item(KP p, int l, int item, char* smem) {
  const int tid = otid();
  const int lane = tid & 63, wv = tid >> 6;
  const bool cons = wv < 4;
  const int fr = lane & 15, fq = lane >> 4;
  const int rg2 = item & 1, d = (item >> 1) & 1, bh = item >> 2, h = bh % 6, b = bh / 6;
  constexpr int BUFF = 12352;
  float* s_buf = (float*)smem;
  float* s_a = s_buf + 2 * BUFF;
  u16* s_lw = (u16*)(s_a + 2048);
  u16* s_la = s_lw + 32 * 72;
  float* s_y = (float*)(s_la + 32 * 72);
  float* s_mu = s_y + 1024;
  const u16* P = (const u16*)(p->ws + OFF_BIG);
  u16* Yd = (u16*)(p->ws + OFF_YRW) + (size_t)d * T_ * 384;
  const float* mup = p->in[I_MUP] + l * 1536;
  const float* mun = p->in[I_MUN] + l * 1536;
  const int pt = tid & 255, tl = pt >> 3, jg = pt & 7, pw = wv & 3;
  const int cr = 768 + h * 64 + jg * 8, ck = 1152 + h * 64 + jg * 8, cvv = 1536 + h * 64 + jg * 8;
  const int clw = 1920 + d * 64 + jg * 8, cla = 2048 + d * 64 + jg * 8;
  bf16x8 fW[2], fA[2];
  {
    const float* Wl = p->in[I_WLORA] + (size_t)(l * 2 + d) * 64 * 384 + h * 64 + pw * 16 + fr;
    const float* Al = p->in[I_ALORA] + (size_t)(l * 2 + d) * 64 * 384 + h * 64 + pw * 16 + fr;
#pragma unroll
    for (int ks = 0; ks < 2; ++ks) {
#pragma unroll
      for (int e = 0; e < 8; ++e) {
        int r = ks * 32 + fq * 8 + e;
        fW[ks][e] = (short)f2bf(Wl[r * 384]);
        fA[ks][e] = (short)f2bf(Al[r * 384]);
      }
    }
  }
  const float w0v = p->in[I_W0][(l * 2 + d) * 384 + h * 64 + pw * 16 + fr];
  const float a0v = p->in[I_A0][(l * 2 + d) * 384 + h * 64 + pw * 16 + fr];
  for (int e = tid; e < 768; e += NTHR) {
    float v;
    if (e < 640) {
      const int a5 = (e % 320) >> 6, j = e & 63;
      const int base = (a5 < 3) ? (a5 * 384 + h * 64) : (1152 + (a5 - 3) * 128 + d * 64);
      v = ((e < 320) ? mup : mun)[base + j];
    } else {
      v = ((e < 704) ? p->in[I_KK] : p->in[I_KA])[l * 384 + h * 64 + (e & 63)];
    }
    s_mu[e] = v;
  }
  __syncthreads();
  const int row8 = lane >> 3, e8 = lane & 7;
  const int rowi = rg2 * 32 + pw * 8 + row8;
  const int j8 = e8 * 8;
  f32x2 S[4];
#pragma unroll
  for (int i = 0; i < 4; ++i) S[i] = f32x2{0.f, 0.f};

  uint4 q[15];
#pragma unroll
  for (int i = 0; i < 15; ++i) q[i] = make_uint4(0, 0, 0, 0);
  if (!cons) {
    int t = d ? (L_ - 1 - tl) : tl;
#pragma unroll
    for (int dt = 0; dt < 3; ++dt) {
      q[0 + dt] = ldrow8(P, b, t + dt - 1, cr);
      q[3 + dt] = ldrow8(P, b, t + dt - 1, ck);
      q[6 + dt] = ldrow8(P, b, t + dt - 1, cvv);
      q[9 + dt] = ldrow8(P, b, t + dt - 1, clw);
      q[12 + dt] = ldrow8(P, b, t + dt - 1, cla);
    }
  }
  float kv[8], kkn[8];
#pragma unroll
  for (int e = 0; e < 8; ++e) { kv[e] = 0.f; kkn[e] = 0.f; }
  float yacc = 0.f;

  struct RwOps { float4 ka, kb, ra, rb; float vi; float2 sc; };
  struct RwUpd { float4 da, db, ba, bb, wa, wb; };
  auto scan_seg = [&](const float* cb, int seg) {
    auto ldops = [&](int s) {
      RwOps r;
      const float* o = cb + 2048 + s * 64 + j8;
      r.ka = *(const float4*)(o); r.kb = *(const float4*)(o + 4);
      r.ra = *(const float4*)(o - 2048); r.rb = *(const float4*)(o - 2048 + 4);
      r.vi = cb[10240 + s * 64 + rowi];
      r.sc = *(const float2*)(cb + 12288 + s * 2);
      return r;
    };
    auto ldupd = [&](int s) {
      RwUpd r;
      const float* o = cb + 2048 + s * 64 + j8;
      r.da = *(const float4*)(o + 2048); r.db = *(const float4*)(o + 2048 + 4);
      r.ba = *(const float4*)(o + 4096); r.bb = *(const float4*)(o + 4096 + 4);
      r.wa = *(const float4*)(o + 6144); r.wb = *(const float4*)(o + 6144 + 4);
      return r;
    };
    RwOps cur = ldops(seg * 8);
#pragma unroll
    for (int i_ = 0; i_ < 8; ++i_) {
      const int s = seg * 8 + i_;
      const RwUpd up = ldupd(s);
      const RwOps nxt = ldops(seg * 8 + ((i_ + 1) & 7));
      float dA = dot8(S, cur.ka, cur.kb);
      float dB = dot8(S, cur.ra, cur.rb);
      const f32x2 vi2 = f32x2{cur.vi, cur.vi};
      const f32x2 A0 = __builtin_elementwise_fma(S[0], f32x2{up.wa.x, up.wa.y}, vi2 * f32x2{up.da.x, up.da.y});
      const f32x2 A1 = __builtin_elementwise_fma(S[1], f32x2{up.wa.z, up.wa.w}, vi2 * f32x2{up.da.z, up.da.w});
      const f32x2 A2 = __builtin_elementwise_fma(S[2], f32x2{up.wb.x, up.wb.y}, vi2 * f32x2{up.db.x, up.db.y});
      const f32x2 A3 = __builtin_elementwise_fma(S[3], f32x2{up.wb.z, up.wb.w}, vi2 * f32x2{up.db.z, up.db.w});
      const float sa = allsum8(dA);
      dB = allsum8(dB);
      const float y = dB + sa * cur.sc.x + cur.vi * cur.sc.y;
      const f32x2 sa2 = f32x2{sa, sa};
      S[0] = __builtin_elementwise_fma(sa2, f32x2{up.ba.x, up.ba.y}, A0);
      S[1] = __builtin_elementwise_fma(sa2, f32x2{up.ba.z, up.ba.w}, A1);
      S[2] = __builtin_elementwise_fma(sa2, f32x2{up.bb.x, up.bb.y}, A2);
      S[3] = __builtin_elementwise_fma(sa2, f32x2{up.bb.z, up.bb.w}, A3);
      yacc = (e8 == i_) ? y : yacc;
      cur = nxt;
    }
    s_y[(seg * 8 + e8) * 32 + pw * 8 + row8] = yacc;
  };

  constexpr int NC = L_ / 32;
  if (cons) {
    for (int c = 0; c <= NC; ++c) {
      const float* cb = s_buf + ((c + 1) & 1) * BUFF;
      const bool cact = c >= 1;
      if (cact) scan_seg(cb, 0);
      __syncthreads();
      if (cact) scan_seg(cb, 1);
      __syncthreads();
      if (cact) scan_seg(cb, 2);
      __syncthreads();
    if (cact) {
        scan_seg(cb, 3);
        const int t2 = lane >> 1, hf = lane & 1;
        const float4 o4 = *(const float4*)(s_y + t2 * 32 + pw * 8 + hf * 4);
        const int ts = (c - 1) * 32 + t2;
        const int t = d ? (L_ - 1 - ts) : ts;
        uint2 o; o.x = pack2(o4.x, o4.y); o.y = pack2(o4.z, o4.w);
        *(uint2*)(Yd + ((size_t)(b * L_ + t)) * 384 + h * 64 + rg2 * 32 + pw * 8 + hf * 4) = o;
      }
    __syncthreads();
    }
  } else {
    const float* mp_ = s_mu + jg * 8;
    const float* mn_ = s_mu + 320 + jg * 8;
    for (int c = 0; c <= NC; ++c) {
      float* pb = s_buf + (c & 1) * BUFF;
      const bool pact = c < NC;
      const bool pnext = c + 1 < NC;
      const int tn_ = (c + 1) * 32 + tl;
      const int tnx = d ? (L_ - 1 - tn_) : tn_;
      const u16* rw0_ = P + ((size_t)(b * L_ + tnx)) * INC;
      const u16* rk0 = rw0_ + (h * 64 + jg * 8);
      const u16* rl0 = rw0_ + (d * 64 + jg * 8);
      const bool edge = pnext && (c + 1 == NC - 1);
      const bool zm = edge && (tnx - 1 < 0), zp = edge && (tnx + 1 >= L_);
      const uint4 zero4 = make_uint4(0, 0, 0, 0);
      if (pact) {
        float rr[8], lw[8], la[8];
        shift8(q[9], q[10], q[11], mp_ + 192, mn_ + 192, lw);
        shift8(q[12], q[13], q[14], mp_ + 256, mn_ + 256, la);
        shift8(q[0], q[1], q[2], mp_, mn_, rr);
#pragma unroll
        for (int e = 0; e < 8; ++e) lw[e] = 1.f - 2.f * frcp(1.f + __expf(2.f * lw[e]));
        *(uint4*)(s_lw + tl * 72 + jg * 8) = pack8(lw);
        *(uint4*)(s_la + tl * 72 + jg * 8) = pack8(la);
        st8f(pb + tl * 64 + jg * 8, rr);
      }
      if (pnext) {
        q[9] = *(const uint4*)(rl0 + 1920 - INC); q[10] = *(const uint4*)(rl0 + 1920); q[11] = *(const uint4*)(rl0 + 1920 + INC);
        q[12] = *(const uint4*)(rl0 + 2048 - INC); q[13] = *(const uint4*)(rl0 + 2048); q[14] = *(const uint4*)(rl0 + 2048 + INC);
        q[0] = *(const uint4*)(rk0 + 768 - INC); q[1] = *(const uint4*)(rk0 + 768); q[2] = *(const uint4*)(rk0 + 768 + INC);
        if (edge) {
          if (zm) { q[9] = zero4; q[12] = zero4; q[0] = zero4; }
          if (zp) { q[11] = zero4; q[14] = zero4; q[2] = zero4; }
        }
      }
      __syncthreads();
      if (pact) {
#pragma unroll
        for (int mt = 0; mt < 2; ++mt) {
          f32x4 aw = {0.f, 0.f, 0.f, 0.f}, aa = {0.f, 0.f, 0.f, 0.f};
#pragma unroll
          for (int ks = 0; ks < 2; ++ks) {
            bf16x8 xw = *(const bf16x8*)(s_lw + (mt * 16 + fr) * 72 + ks * 32 + fq * 8);
            bf16x8 xa = *(const bf16x8*)(s_la + (mt * 16 + fr) * 72 + ks * 32 + fq * 8);
            aw = __builtin_amdgcn_mfma_f32_16x16x32_bf16(xw, fW[ks], aw, 0, 0, 0);
            aa = __builtin_amdgcn_mfma_f32_16x16x32_bf16(xa, fA[ks], aa, 0, 0, 0);
          }
#pragma unroll
          for (int j = 0; j < 4; ++j) {
            int t2 = mt * 16 + fq * 4 + j, jj = pw * 16 + fr;
            pb[8192 + t2 * 64 + jj] = __expf(-0.606531f * sigm(aw[j] + w0v));
            s_a[t2 * 64 + jj] = sigm(aa[j] + a0v);
          }
        }
        float vv[8];
        shift8(q[6], q[7], q[8], mp_ + 128, mn_ + 128, vv);
        st8f(pb + 10240 + tl * 64 + jg * 8, vv);
      }
      if (pnext) {
        q[6] = *(const uint4*)(rk0 + 1536 - INC); q[7] = *(const uint4*)(rk0 + 1536); q[8] = *(const uint4*)(rk0 + 1536 + INC);
        if (edge) { if (zm) q[6] = zero4; if (zp) q[8] = zero4; }
      }
      __syncthreads();
      if (pact) {
        shift8(q[3], q[4], q[5], mp_ + 64, mn_ + 64, kv);
        float kkc[8];
        ld8f(s_mu + 640 + jg * 8, kkc);
        float ss = 0.f;
#pragma unroll
        for (int e = 0; e < 8; ++e) { kkn[e] = kv[e] * kkc[e]; ss += kkn[e] * kkn[e]; }
        ss = allsum8(ss);
        const float inv = rsqrtf(ss + 1e-6f);
        float nk[8];
#pragma unroll
        for (int e = 0; e < 8; ++e) { kkn[e] *= inv; nk[e] = -kkn[e]; }
        st8f(pb + 2048 + tl * 64 + jg * 8, nk);
      }
      if (pnext) {
        q[3] = *(const uint4*)(rk0 + 1152 - INC); q[4] = *(const uint4*)(rk0 + 1152); q[5] = *(const uint4*)(rk0 + 1152 + INC);
        if (edge) { if (zm) q[3] = zero4; if (zp) q[5] = zero4; }
      }
      __syncthreads();
      if (pact) {
        float av[8], kac[8], kd[8], bb[8], rr[8], wv8[8];
        ld8f(s_a + tl * 64 + jg * 8, av);
        ld8f(pb + tl * 64 + jg * 8, rr);
        ld8f(pb + 8192 + tl * 64 + jg * 8, wv8);
        ld8f(s_mu + 704 + jg * 8, kac);
        float br = 0.f, kr = 0.f;
#pragma unroll
        for (int e = 0; e < 8; ++e) {
          kd[e] = kv[e] * (1.f + (av[e] - 1.f) * kac[e]);
          bb[e] = kkn[e] * av[e];
          br += bb[e] * rr[e];
          kr += kd[e] * rr[e];
          rr[e] *= wv8[e];
        }
        br = allsum8(br);
        kr = allsum8(kr);
        st8f(pb + 4096 + tl * 64 + jg * 8, kd);
        st8f(pb + 6144 + tl * 64 + jg * 8, bb);
        st8f(pb + tl * 64 + jg * 8, rr);
        if (jg == 0) *(float2*)(pb + 12288 + tl * 2) = make_float2(br, kr);
      }
      __syncthreads();
    }
  }
}

DEVI void gdscan_pc_item(KP p, int l, int item, char* smem) {
  const int tid = otid();
  const int lane = tid & 63, wv = tid >> 6;
  const bool cons = wv < 4;
  const int rg2 = item & 1, d = (item >> 1) & 1, bh = item >> 2, h = bh % 6, b = bh / 6;
  constexpr int BUFF = 6272;
  float* s_buf = (float*)smem;
  float* s_y = s_buf + 2 * BUFF;
  const u16* P = (const u16*)(p->ws + OFF_BIG);
  u16* Yd = (u16*)(p->ws + OFF_YGD) + (size_t)d * T_ * 384;
  const float* cw = p->in[I_GCW] + l * 3 * 1152;
  const int pt = tid & 255, tl = pt >> 3, jg = pt & 7, pw = wv & 3;
  const int lq = h * 64 + jg * 8, lk = 384 + lq, lv = 768 + lq;
  const float negA = -__expf(p->in[I_GALOG][(l * 2 + d) * 6 + h]);
  const float dtb = p->in[I_GDT][(l * 2 + d) * 6 + h];
  const int cag = 3840 + d * 6 + h, cbg = 3852 + d * 6 + h;
  const int row8 = lane >> 3, e8 = lane & 7;
  const int col_e = rg2 * 32 + pw * 8 + row8;
  const int j8 = e8 * 8;
  f32x2 S[4];
#pragma unroll
  for (int i = 0; i < 4; ++i) S[i] = f32x2{0.f, 0.f};
  float yacc = 0.f;

  uint4 q[9];
#pragma unroll
  for (int i = 0; i < 9; ++i) q[i] = make_uint4(0, 0, 0, 0);
  u16 rag = 0, rbg = 0;
  if (!cons) {
    int t = d ? (L_ - 1 - tl) : tl;
#pragma unroll
    for (int dt = 0; dt < 3; ++dt) {
      q[0 + dt] = ldrow8(P, b, t + dt - 1, 2304 + lq);
      q[3 + dt] = ldrow8(P, b, t + dt - 1, 2304 + lk);
      q[6 + dt] = ldrow8(P, b, t + dt - 1, 2304 + lv);
    }
    { const u16* pr_ = P + ((size_t)(b * L_ + t)) * INC; rag = pr_[cag]; rbg = pr_[cbg]; }
  }
  struct GdOps { float4 ka, kb, qa, qb, sc; float ve; };
  auto scan_seg = [&](const float* cb, int seg) {
    auto ldops = [&](int s) {
      GdOps r;
      const float* o = cb + 2048 + s * 64 + j8;
      r.ka = *(const float4*)(o); r.kb = *(const float4*)(o + 4);
      r.qa = *(const float4*)(o - 2048); r.qb = *(const float4*)(o - 2048 + 4);
      r.ve = cb[4096 + s * 64 + col_e];
      r.sc = *(const float4*)(cb + 6144 + s * 4);
      return r;
    };
    GdOps cur = ldops(seg * 16);
#pragma unroll
    for (int i_ = 0; i_ < 16; ++i_) {
      const int s = seg * 16 + i_;
      const GdOps nxt = ldops(seg * 16 + ((i_ + 1) & 15));
      const float al = cur.sc.x, be = cur.sc.y, qk = cur.sc.z, nab = cur.sc.w;
      float d1 = dot8(S, cur.ka, cur.kb);
      float d2 = dot8(S, cur.qa, cur.qb);
      const f32x2 al2 = f32x2{al, al};
      const f32x2 A0 = S[0] * al2, A1 = S[1] * al2, A2 = S[2] * al2, A3 = S[3] * al2;
      const float bv = be * cur.ve;
      d1 = allsum8(d1);
      d2 = allsum8(d2);
      const float vn = __builtin_fmaf(nab, d1, bv);
      const float ov = al * d2 + qk * vn;
      const f32x2 vn2 = f32x2{vn, vn};
      S[0] = __builtin_elementwise_fma(vn2, f32x2{cur.ka.x, cur.ka.y}, A0);
      S[1] = __builtin_elementwise_fma(vn2, f32x2{cur.ka.z, cur.ka.w}, A1);
      S[2] = __builtin_elementwise_fma(vn2, f32x2{cur.kb.x, cur.kb.y}, A2);
      S[3] = __builtin_elementwise_fma(vn2, f32x2{cur.kb.z, cur.kb.w}, A3);
      yacc = (e8 == (i_ & 7)) ? ov : yacc;
      if ((i_ & 7) == 7) s_y[(s - 7 + e8) * 32 + pw * 8 + row8] = yacc;
      cur = nxt;
    }
  };
  __syncthreads();
  constexpr int NC = L_ / 32;
  for (int c = 0; c <= NC; ++c) {
    float* pb = s_buf + (c & 1) * BUFF;
    const float* cb = s_buf + ((c + 1) & 1) * BUFF;
    const bool pact = !cons && c < NC, cact = cons && c >= 1;
    if (pact) {
      float qq[8], kk[8], vv[8];
#pragma unroll
      for (int arr = 0; arr < 3; ++arr) {
        float a[8], u[8], n[8], w0[8], w1[8], w2[8];
        unpack8(q[arr * 3 + 0], a); unpack8(q[arr * 3 + 1], u); unpack8(q[arr * 3 + 2], n);
        const int lc = (arr == 0) ? lq : (arr == 1 ? lk : lv);
        ld8f(cw + lc, w0); ld8f(cw + 1152 + lc, w1); ld8f(cw + 2304 + lc, w2);
        float* o = (arr == 0) ? qq : (arr == 1 ? kk : vv);
#pragma unroll
        for (int e = 0; e < 8; ++e) o[e] = siluf(w0[e] * a[e] + w1[e] * u[e] + w2[e] * n[e]);
      }
      float sq = 0.f, sk = 0.f;
#pragma unroll
      for (int e = 0; e < 8; ++e) { sq += qq[e] * qq[e]; sk += kk[e] * kk[e]; }
      sq = allsum8(sq); sk = allsum8(sk);
      const float iq = rsqrtf(sq + 1e-6f) * 0.125f, ik = rsqrtf(sk + 1e-6f);
      float qk = 0.f;
#pragma unroll
      for (int e = 0; e < 8; ++e) { qq[e] *= iq; kk[e] *= ik; qk += qq[e] * kk[e]; }
      qk = allsum8(qk);
      st8f(pb + tl * 64 + jg * 8, qq);
      st8f(pb + 2048 + tl * 64 + jg * 8, kk);
      st8f(pb + 4096 + tl * 64 + jg * 8, vv);
      if (jg == 0) {
        float x = bf2f(rag) + dtb;
        float sp = (x > 20.f) ? x : log1pf(__expf(x));
        const float al_ = __expf(negA * sp), be_ = sigm(bf2f(rbg));
        *(float4*)(pb + 6144 + tl * 4) = make_float4(al_, be_, qk, -al_ * be_);
      }
    }
    if (cact) scan_seg(cb, 0);
    __syncthreads();
    if (!cons && c + 1 < NC) {
      int tn = (c + 1) * 32 + tl;
      int t = d ? (L_ - 1 - tn) : tn;
#pragma unroll
      for (int dt = 0; dt < 3; ++dt) {
        q[0 + dt] = ldrow8(P, b, t + dt - 1, 2304 + lq);
        q[3 + dt] = ldrow8(P, b, t + dt - 1, 2304 + lk);
        q[6 + dt] = ldrow8(P, b, t + dt - 1, 2304 + lv);
      }
      { const u16* pr_ = P + ((size_t)(b * L_ + t)) * INC; rag = pr_[cag]; rbg = pr_[cbg]; }
    }
    if (cact) {
      scan_seg(cb, 1);
      const int t2 = lane >> 1, hf = lane & 1;
      const float4 o4 = *(const float4*)(s_y + t2 * 32 + pw * 8 + hf * 4);
      const int ts = (c - 1) * 32 + t2;
      const int t = d ? (L_ - 1 - ts) : ts;
      uint2 o; o.x = pack2(o4.x, o4.y); o.y = pack2(o4.z, o4.w);
      *(uint2*)(Yd + ((size_t)(b * L_ + t)) * 384 + h * 64 + rg2 * 32 + pw * 8 + hf * 4) = o;
    }
    __syncthreads();
  }
}

#define hy_gdn_post (gridDim.x == 256u)
DEVI void post_gdn_item(KP p, int l, int item) {
  const int tid = otid();
  const int tl = tid >> 3, jg = tid & 7;
  const u16* P = (const u16*)(p->ws + OFF_BIG);
  const u16* YG = (const u16*)(p->ws + OFF_YGD);
  u16* Yo = (u16*)(p->ws + OFF_HN);
  const int tok = item * 64 + tl;
  const int b = tok / L_, t = tok % L_;
#pragma unroll 2
  for (int h = 0; h < 6; ++h) {
    const int hc = h * 64 + jg * 8;
    {
      float o[8], nw[8], zg[8], ob8[8];
      unpack8(*(const uint4*)(YG + (size_t)tok * 384 + hc), o);
      unpack8(*(const uint4*)(YG + (size_t)(T_ + tok) * 384 + hc), ob8);
#pragma unroll
      for (int e = 0; e < 8; ++e) o[e] += ob8[e];
      float ms = 0.f;
#pragma unroll
      for (int e = 0; e < 8; ++e) ms += o[e] * o[e];
      const float rs = rsqrtf(allsum8(ms) * (1.f / 64.f) + 1e-6f);
      ld8f(p->in[I_GNORM] + l * 64 + jg * 8, nw);
      unpack8(ldrow8(P, b, t, 3456 + hc), zg);
#pragma unroll
      for (int e = 0; e < 8; ++e) o[e] = o[e] * rs * nw[e] * siluf(zg[e]);
      *(uint4*)(Yo + (size_t)tok * DM + 640 + hc) = pack8(o);
    }
  }
}

DEVI void post_tok_item(KP p, int l, int item, char* smem) {
  const int tid = otid();
  const int tl = tid >> 3, jg = tid & 7;
  u16* s_sg = (u16*)smem;
  float* s_gate = (float*)(smem + 64 * 136 * 2);
  const u16* P = (const u16*)(p->ws + OFF_BIG);
  const u16* YR = (const u16*)(p->ws + OFF_YRW);
  const u16* YG = (const u16*)(p->ws + OFF_YGD);
  u16* Yo = (u16*)(p->ws + OFF_HN);
  const float* mup = p->in[I_MUP] + l * 1536;
  const float* mun = p->in[I_MUN] + l * 1536;
  const int tok = item * 64 + tl;
  const int b = tok / L_, t = tok % L_;
#pragma unroll
  for (int half = 0; half < 2; ++half) {
    const int col = 2176 + jg * 16 + half * 8;
    float lg[8];
    shift8(ldrow8(P, b, t - 1, col), ldrow8(P, b, t, col), ldrow8(P, b, t + 1, col), mup + (col - 768),
           mun + (col - 768), lg);
#pragma unroll
    for (int e = 0; e < 8; ++e) lg[e] = sigm(lg[e]);
    *(uint4*)(s_sg + tl * 136 + jg * 16 + half * 8) = pack8(lg);
  }
  __syncthreads();
  {
    const int lane = tid & 63, wv = tid >> 6, fr = lane & 15, fq = lane >> 4;
    const u16* GT = (const u16*)(p->ws + OFF_WKV);
    f32x4 acc[4][3];
#pragma unroll
    for (int m = 0; m < 4; ++m)
#pragma unroll
      for (int n = 0; n < 3; ++n) acc[m][n] = f32x4{0.f, 0.f, 0.f, 0.f};
#pragma unroll
    for (int ks = 0; ks < 4; ++ks) {
      bf16x8 af[4], bfr[3];
#pragma unroll
      for (int m = 0; m < 4; ++m) af[m] = *(const bf16x8*)(s_sg + (m * 16 + fr) * 136 + ks * 32 + fq * 8);
#pragma unroll
      for (int n = 0; n < 3; ++n) bfr[n] = *(const bf16x8*)(GT + ((wv * 3 + n) * 16 + fr) * 128 + ks * 32 + fq * 8);
#pragma unroll
      for (int m = 0; m < 4; ++m)
#pragma unroll
        for (int n = 0; n < 3; ++n) acc[m][n] = __builtin_amdgcn_mfma_f32_16x16x32_bf16(af[m], bfr[n], acc[m][n], 0, 0, 0);
    }
#pragma unroll
    for (int m = 0; m < 4; ++m)
#pragma unroll
      for (int n = 0; n < 3; ++n)
#pragma unroll
        for (int j = 0; j < 4; ++j) s_gate[(m * 16 + fq * 4 + j) * 388 + (wv * 3 + n) * 16 + fr] = acc[m][n][j];
  }
  __syncthreads();
  for (int h = 0; h < 6; ++h) {
    const int hc = h * 64 + jg * 8;
    {
      float y[8], yb8[8];
      unpack8(*(const uint4*)(YR + (size_t)tok * 384 + hc), y);
      unpack8(*(const uint4*)(YR + (size_t)(T_ + tok) * 384 + hc), yb8);
#pragma unroll
      for (int e = 0; e < 8; ++e) y[e] += yb8[e];
      float s = 0.f;
#pragma unroll
      for (int e = 0; e < 8; ++e) s += y[e];
      const float mu = allsum8(s) * (1.f / 64.f);
      float vs = 0.f;
#pragma unroll
      for (int e = 0; e < 8; ++e) { y[e] -= mu; vs += y[e] * y[e]; }
      const float rstd = rsqrtf(allsum8(vs) * (1.f / 64.f) + 64e-5f);
      float gw[8], gb[8], rk[8], rr[8], kv[8], vv[8];
      ld8f(p->in[I_GNW] + l * 384 + hc, gw);
      ld8f(p->in[I_GNB] + l * 384 + hc, gb);
      ld8f(p->in[I_RK] + l * 384 + hc, rk);
      const int cr = 768 + hc, ck = 1152 + hc, cv = 1536 + hc;
      shift8(ldrow8(P, b, t - 1, cr), ldrow8(P, b, t, cr), ldrow8(P, b, t + 1, cr), mup + hc, mun + hc, rr);
      shift8(ldrow8(P, b, t - 1, ck), ldrow8(P, b, t, ck), ldrow8(P, b, t + 1, ck), mup + 384 + hc, mun + 384 + hc, kv);
      shift8(ldrow8(P, b, t - 1, cv), ldrow8(P, b, t, cv), ldrow8(P, b, t + 1, cv), mup + 768 + hc, mun + 768 + hc, vv);
      float bs = 0.f;
#pragma unroll
      for (int e = 0; e < 8; ++e) bs += rr[e] * kv[e] * rk[e];
      bs = allsum8(bs);
      float gate[8];
      ld8f(s_gate + tl * 388 + hc, gate);
      float o[8];
#pragma unroll
      for (int e = 0; e < 8; ++e) o[e] = (y[e] * rstd * gw[e] + gb[e] + bs * vv[e]) * gate[e];
      *(uint4*)(Yo + (size_t)tok * DM + 256 + hc) = pack8(o);
    }
    if (!hy_gdn_post) {
      float o[8], nw[8], zg[8], ob8[8];
      unpack8(*(const uint4*)(YG + (size_t)tok * 384 + hc), o);
      unpack8(*(const uint4*)(YG + (size_t)(T_ + tok) * 384 + hc), ob8);
#pragma unroll
      for (int e = 0; e < 8; ++e) o[e] += ob8[e];
      float ms = 0.f;
#pragma unroll
      for (int e = 0; e < 8; ++e) ms += o[e] * o[e];
      const float rs = rsqrtf(allsum8(ms) * (1.f / 64.f) + 1e-6f);
      ld8f(p->in[I_GNORM] + l * 64 + jg * 8, nw);
      unpack8(ldrow8(P, b, t, 3456 + hc), zg);
#pragma unroll
      for (int e = 0; e < 8; ++e) o[e] = o[e] * rs * nw[e] * siluf(zg[e]);
      *(uint4*)(Yo + (size_t)tok * DM + 640 + hc) = pack8(o);
    }
  }
  __syncthreads();
}

DEVI void attn_phase(KP p, int l, char* smem, int bid, int nb) {
  u16* sKV = (u16*)smem;
  u16* sP = sKV + 64 * 264;
  const int tid = otid(), lane = tid & 63, wv = tid >> 6, fr = lane & 15, fq = lane >> 4;
  const u16* Q = (const u16*)(p->ws + OFF_BIG);
  const u16* KM = (const u16*)(p->ws + OFF_KM) + (size_t)l * 1024 * 1024;
  const u16* VT = (const u16*)(p->ws + OFF_VT) + (size_t)l * 1024 * 1024;
  u16* O = (u16*)(p->ws + OFF_HN);
  u16* myP = sP + wv * 16 * 264;
  for (int it = bid; it < 1024; it += nb) {
    const int h = it & 3, qt = (it >> 2) & 63, b = it >> 8;
    const int tok0 = b * L_ + qt * 128 + wv * 16;
    uint4 R0, R1, R2, R3;
    const int lrow = tid >> 5, lc = (tid & 31) * 8;
    const u16* kbase = KM + (size_t)(b * 256 + lrow) * DM + h * 256 + lc;
    const u16* vbase = VT + (size_t)(h * 256 + lrow) * 1024 + b * 256 + lc;
#define ATT_LDK(ch_) do { const u16* g_ = kbase + (size_t)(ch_) * 64 * DM; R0 = *(const uint4*)(g_); R1 = *(const uint4*)(g_ + 16 * DM); \
      R2 = *(const uint4*)(g_ + 32 * DM); R3 = *(const uint4*)(g_ + 48 * DM); } while (0)
#define ATT_LDV(dc_) do { const u16* g_ = vbase + (size_t)(dc_) * 64 * 1024; R0 = *(const uint4*)(g_); R1 = *(const uint4*)(g_ + 16 * 1024); \
      R2 = *(const uint4*)(g_ + 32 * 1024); R3 = *(const uint4*)(g_ + 48 * 1024); } while (0)
#define ATT_ST() do { u16* d_ = sKV + lrow * 264 + lc; *(uint4*)(d_) = R0; *(uint4*)(d_ + 16 * 264) = R1; \
      *(uint4*)(d_ + 32 * 264) = R2; *(uint4*)(d_ + 48 * 264) = R3; } while (0)
    ATT_LDK(0);
    bf16x8 qf[8];
#pragma unroll
    for (int ks = 0; ks < 8; ++ks)
      qf[ks] = *(const bf16x8*)(Q + (size_t)(tok0 + fr) * DM + h * 256 + ks * 32 + fq * 8);
    f32x4 sc[16];
#pragma unroll
    for (int i = 0; i < 16; ++i) sc[i] = f32x4{0.f, 0.f, 0.f, 0.f};
#pragma unroll
    for (int ch = 0; ch < 4; ++ch) {
      __syncthreads();
      ATT_ST();
      __syncthreads();
      if (ch < 3) ATT_LDK(ch + 1); else ATT_LDV(0);
#pragma unroll
      for (int nt = 0; nt < 4; ++nt) {
#pragma unroll
        for (int ks = 0; ks < 8; ++ks) {
          bf16x8 kf = *(const bf16x8*)(sKV + (nt * 16 + fr) * 264 + ks * 32 + fq * 8);
          sc[ch * 4 + nt] = __builtin_amdgcn_mfma_f32_16x16x32_bf16(qf[ks], kf, sc[ch * 4 + nt], 0, 0, 0);
        }
      }
    }
#pragma unroll
    for (int j = 0; j < 4; ++j) {
      float mx = -1e30f;
#pragma unroll
      for (int i = 0; i < 16; ++i) mx = fmaxf(mx, sc[i][j]);
#pragma unroll
      for (int o = 1; o < 16; o <<= 1) mx = fmaxf(mx, __shfl_xor(mx, o, 64));
      float sum = 0.f;
#pragma unroll
      for (int i = 0; i < 16; ++i) {
        float e = __expf((sc[i][j] - mx) * 0.0625f);
        sc[i][j] = e;
        sum += e;
      }
      sum = allsum16(sum);
      const float inv = frcp(sum);
#pragma unroll
      for (int i = 0; i < 16; ++i) myP[(fq * 4 + j) * 264 + i * 16 + fr] = f2bf(sc[i][j] * inv);
    }
#pragma unroll
    for (int dc = 0; dc < 4; ++dc) {
      __syncthreads();
      ATT_ST();
      __syncthreads();
      if (dc < 3) ATT_LDV(dc + 1);
      f32x4 oa[4];
#pragma unroll
      for (int nt = 0; nt < 4; ++nt) oa[nt] = f32x4{0.f, 0.f, 0.f, 0.f};
#pragma unroll
      for (int ks = 0; ks < 8; ++ks) {
        bf16x8 pf = *(const bf16x8*)(myP + fr * 264 + ks * 32 + fq * 8);
#pragma unroll
        for (int nt = 0; nt < 4; ++nt) {
          bf16x8 vf = *(const bf16x8*)(sKV + (nt * 16 + fr) * 264 + ks * 32 + fq * 8);
          oa[nt] = __builtin_amdgcn_mfma_f32_16x16x32_bf16(pf, vf, oa[nt], 0, 0, 0);
        }
      }
#pragma unroll
      for (int nt = 0; nt < 4; ++nt)
#pragma unroll
        for (int j = 0; j < 4; ++j)
          O[(size_t)(tok0 + fq * 4 + j) * DM + h * 256 + dc * 64 + nt * 16 + fr] = f2bf(oa[nt][j]);
    }
    __syncthreads();
#undef ATT_LDK
#undef ATT_LDV
#undef ATT_ST
  }
}


#define XB_TMO      128
#define XB_XCNT(j)  (256  + 64 * (j))
#define XB_XSUB(j)  (1280 + 64 * (j))
#define XB_XGEN(j)  (2304 + 64 * (j))
#define XB_TOP      3328
#define XB_TOPGEN   3392
#define XCD_BAR_WORDS 3456
#define XB_SPIN_CAP (1u << 24)
#define LAS __attribute__((address_space(3)))
DEVI unsigned xb_ld(unsigned* p) { return __hip_atomic_load(p, __ATOMIC_RELAXED, __HIP_MEMORY_SCOPE_AGENT); }
DEVI unsigned xb_add(unsigned* p, unsigned v) { return __hip_atomic_fetch_add(p, v, __ATOMIC_RELAXED, __HIP_MEMORY_SCOPE_AGENT); }
DEVI unsigned xb_xcc_id() { return (unsigned)__builtin_amdgcn_s_getreg((3 << 11) | 20) & 0xFu; }
#define XB_SPIN(cond, bar) do { unsigned _sp = 0; while (cond) { __builtin_amdgcn_s_sleep(1); \
    if ((++_sp & 255u) == 0u) { if (xb_ld(&(bar)[XB_TMO])) break; if (_sp > XB_SPIN_CAP) { atomicAdd(&(bar)[XB_TMO], 1u); break; } } } } while (0)
struct XcdBarrier { unsigned* bar; unsigned x; volatile LAS unsigned* st; };
DEVI XcdBarrier xcd_barrier_post(unsigned* bar, volatile LAS unsigned* st) {
  XcdBarrier b; b.bar = bar; b.x = xb_xcc_id(); b.st = st;
  if (threadIdx.x == 0) (void)xb_add(&bar[XB_XCNT(b.x)], 1u);
  return b;
}
DEVI void xcd_barrier_complete(unsigned* bar, unsigned x, unsigned& nloc, unsigned& nx) {
  const unsigned G = gridDim.x * gridDim.y * gridDim.z;
  unsigned sum, cnt, mine, sp = 0u;
  for (;;) {
    sum = 0u; cnt = 0u; mine = 0u;
#pragma unroll
    for (unsigned j = 0; j < 16; ++j) { const unsigned c = xb_ld(&bar[XB_XCNT(j)]); sum += c; cnt += (c > 0u) ? 1u : 0u; mine = (j == x) ? c : mine; }
    if (sum == G) break;
    __builtin_amdgcn_s_sleep(1);
    if ((++sp & 255u) == 0u) { if (xb_ld(&bar[XB_TMO])) break; if (sp > XB_SPIN_CAP) { atomicAdd(&bar[XB_TMO], 1u); break; } }
  }
  nloc = mine > 0u ? mine : 1u; nx = cnt > 0u ? cnt : 1u;
}
DEVI void xcd_barrier(const XcdBarrier& b) {
  asm volatile("s_waitcnt vmcnt(0)" ::: "memory");
  __syncthreads();
  if (threadIdx.x == 0) {
    unsigned* bar = b.bar;
    __builtin_amdgcn_s_waitcnt(0);
    unsigned nloc = b.st[0], nx = b.st[1];
    if (nloc == 0u) { xcd_barrier_complete(bar, b.x, nloc, nx); b.st[0] = nloc; b.st[1] = nx; }
    const unsigned old = xb_add(&bar[XB_XSUB(b.x)], 1u);
    const unsigned gen = old / nloc;
    if (old + 1u == (gen + 1u) * nloc) {
      __builtin_amdgcn_fence(__ATOMIC_RELEASE, "agent");
      asm volatile("s_waitcnt vmcnt(0)" ::: "memory");
      const unsigned og = xb_add(&bar[XB_TOP], 1u);
      const unsigned tg = og / nx;
      if (og + 1u == (tg + 1u) * nx) xb_add(&bar[XB_TOPGEN], 1u);
      else XB_SPIN(xb_ld(&bar[XB_TOPGEN]) == tg, bar);
      __builtin_amdgcn_fence(__ATOMIC_ACQUIRE, "agent");
      xb_add(&bar[XB_XGEN(b.x)], 1u);
      asm volatile("s_waitcnt vmcnt(0)" ::: "memory");
    } else {
      XB_SPIN(xb_ld(&bar[XB_XGEN(b.x)]) == gen, bar);
      __builtin_amdgcn_fence(__ATOMIC_ACQUIRE, "agent");
      asm volatile("s_waitcnt vmcnt(0)" ::: "memory");
    }
  }
  __syncthreads();
}

DEVI void sub_barrier(unsigned* word, unsigned expected) {
  asm volatile("s_waitcnt vmcnt(0)" ::: "memory");
  __syncthreads();
  if (threadIdx.x == 0) {
    __builtin_amdgcn_fence(__ATOMIC_RELEASE, "agent");
    asm volatile("s_waitcnt vmcnt(0)" ::: "memory");
    xb_add(word, 1u);
    unsigned sp = 0;
    while (xb_ld(word) < expected) { __builtin_amdgcn_s_sleep(1); if (++sp > XB_SPIN_CAP) break; }
    __builtin_amdgcn_fence(__ATOMIC_ACQUIRE, "agent");
    asm volatile("s_waitcnt vmcnt(0)" ::: "memory");
  }
  __syncthreads();
}

#ifndef PROBE_RW
#define PROBE_RW 0
#endif
#ifndef PROBE_GD
#define PROBE_GD 0
#endif
#ifndef PROBE_HY
#define PROBE_HY 0
#endif
#ifndef REP_HYPREP
#define REP_HYPREP 1
#endif
#ifndef REP_POST
#define REP_POST 1
#endif
#ifndef REP_ATT
#define REP_ATT 1
#endif
#ifndef REP_NORM
#define REP_NORM 1
#endif
#ifndef REP_P0
#define REP_P0 1
#endif
#ifndef REP_SYNC
#define REP_SYNC 0
#endif
#ifndef REP_MIX
#define REP_MIX 1
#endif
#ifndef REP_G1
#define REP_G1 1
#endif
#ifndef EN_HY
#define EN_HY 1
#endif
#ifndef EN_RW
#define EN_RW 1
#endif
#ifndef EN_GD
#define EN_GD 1
#endif
#ifndef EN_XA
#define EN_XA 1
#endif

__global__ void __launch_bounds__(NTHR, 2) fwd_megakernel(Params p_unused) {
  __shared__ __attribute__((aligned(16))) char smem[SMEM_BYTES];
  const KP kp0 = (KP)__builtin_amdgcn_kernarg_segment_ptr();
#define p (opqk(kp0))
  cg::grid_group grid = cg::this_grid();
  __shared__ uint4 xb_words;
  if (threadIdx.x == 0) xb_words = make_uint4(0u, 0u, 0u, 0u);
  __syncthreads();
  const XcdBarrier xb = xcd_barrier_post((unsigned*)(kp0->ws + OFF_BAR), (volatile LAS unsigned*)&xb_words);
  const int bid = blockIdx.x, nb = gridDim.x;
#define ws (p->ws)
#define WA ((u16*)(ws + OFF_WA))
#define WB ((u16*)(ws + OFF_WB))
#define WKV ((u16*)(ws + OFF_WKV))
#define MEMN ((u16*)(ws + OFF_MEMN))
#define HN ((u16*)(ws + OFF_HN))
#define BIG ((u16*)(ws + OFF_BIG))
#define X (p->out)

  if (gridDim.x == 0x7fffffffu) grid.sync();
  for (int rs_ = 0; rs_ < REP_SYNC; ++rs_) xcd_barrier(xb);

  for (int l = 0; l < 2; ++l) {
    int bid_l = blockIdx.x; asm volatile("" : "+s"(bid_l));
    const float* xin = (l == 0) ? p->in[I_X] : X;
    rmsnorm_phase<false>(xin, p->in[I_NFFN1] + l * DM, HN, T_, bid_l, nb);
    convert_phase(p->in[I_F1W1] + (size_t)l * DM * DFF, p->in[I_F1W3] + (size_t)l * DM * DFF, DM, 2 * DFF, 2 * DFF, WA, smem, bid_l, nb);
    convert_phase(p->in[I_F1W2] + (size_t)l * DFF * DM, nullptr, DFF, DM, DM, WB, smem, bid_l, nb);
    xcd_barrier(xb);
    for (int rep_ = 0; rep_ < REP_G1; ++rep_) {
      run_gemm(smem, HN, WA, T_, 2 * DFF, DM, pg8::EpiSwiglu{BIG, DFF}, bid_l, 0, nb);
      xcd_barrier(xb);
    }
    run_gemm(smem, BIG, WB, T_, DM, DFF, pg8::EpiResid{X, xin, 0.5f}, bid_l, 0, nb);
    xcd_barrier(xb);
    rmsnorm_phase<false>(X, p->in[I_NMIX] + l * DM, HN, T_, bid_l, nb);
    convert_phase(p->in[I_WIN] + (size_t)l * DM * INC, nullptr, DM, INC, INCP, WA, smem, bid_l, nb);
    convert_phase(p->in[I_WOUT] + (size_t)l * DM * DM, nullptr, DM, DM, DM, WB, smem, bid_l, nb);
    convert_phase(p->in[I_GLORA] + (size_t)l * 128 * 384, nullptr, 128, 384, 384, WKV, smem, (bid_l + 128) % nb, nb);
    xcd_barrier(xb);
    run_gemm(smem, HN, WA, T_, INCP, DM, pg8::EpiBf16{BIG, INC, INC}, bid_l, 0, nb);
    xcd_barrier(xb);
#define hy_own_prep (gridDim.x == 256u)
    if (!hy_own_prep) {
      hyprep_phase(p, l, smem, bid_l, nb);
      xcd_barrier(xb);
    }
    for (int rep_ = 0; rep_ < REP_MIX; ++rep_) {
      if (rep_ > 0) xcd_barrier(xb);
      const int t5 = otid();
      const int half = t5 >> 8, tl5 = t5 & 255;
      char* hsm = smem + half * SCAN_SMEM;
      int rb_ = bid_l; asm volatile("" : "+s"(rb_));
      for (int r = rb_; r < 256; r += nb) {
        if (r < 192) {
          const int q_ = (r < 96) ? r : r - 96;
          const int it_ = (((q_ >> 4) * 8 + (q_ & 7)) << 1) | ((q_ >> 3) & 1);
          if (r < 96) rwscan_pc_item(p, l, it_, smem);
          else {
            gdscan_pc_item(p, l, it_, smem);
            if (hy_own_prep) {
              const int gb = r - 96;
              u16* wk_t = (u16*)(ws + OFF_WKV + (2u << 20));
              u16* wv_t = (u16*)(ws + OFF_WKV + (4u << 20));
              __syncthreads();
              convert_phase(p->in[I_WK] + (size_t)l * DM * DM, nullptr, DM, DM, DM, wk_t, smem, gb, 96);
              convert_phase(p->in[I_WV] + (size_t)l * DM * DM, nullptr, DM, DM, DM, wv_t, smem, gb, 96);
              if (l == 0) rmsnorm_phase<false>(p->in[I_MEM], p->in[I_MEMNORM], MEMN, 1024, gb, 96);
              sub_barrier((unsigned*)(ws + OFF_BAR) + 3776 + 64 * l, 96u);
              run_gemm(smem, MEMN, wk_t, 1024, 1024, DM, pg8::EpiBf16{(u16*)(ws + OFF_KM) + (size_t)l * DM * DM, DM, DM}, gb, 0, 16);
              run_gemm(smem, wv_t, MEMN, 1024, 1024, DM, pg8::EpiBf16{(u16*)(ws + OFF_VT) + (size_t)l * DM * DM, DM, DM}, gb, 16, 16);
#pragma unroll 1
              for (int it = gb; it < 512; it += 96) post_gdn_item(p, l, it);
            }
          }
        }
        else if (EN_HY) {
          if (hy_own_prep) {
            hyfilter_phase(p, smem, r - 192, 64, l, OFF_YC);
            sub_barrier((unsigned*)(ws + OFF_BAR) + 3648 + 64 * l, 64u);
            hynorm_phase(p, smem, r - 192, 64, l, OFF_YC);
            hyprep_phase(p, l, smem, r - 192, 64);
            sub_barrier((unsigned*)(ws + OFF_BAR) + 3520 + 64 * l, 64u);
          }
          for (int c = r - 192; c < 256; c += 64) hyconv_item(p, l, c, smem);
        }
      }
    }
    xcd_barrier(xb);
    for (int rep_ = 0; rep_ < REP_POST; ++rep_) {
      for (int it = bid_l; it < 512; it += nb) post_tok_item(p, l, it, smem);
      xcd_barrier(xb);
    }
    run_gemm(smem, HN, WB, T_, DM, DM, pg8::EpiResid{X, X, 1.0f}, bid_l, 0, nb);
    xcd_barrier(xb);
    for (int rep_ = 0; rep_ < REP_NORM; ++rep_)
    rmsnorm_phase<false>(X, p->in[I_NXA] + l * DM, HN, T_, bid_l, nb);
    convert_phase(p->in[I_WQ] + (size_t)l * DM * DM, nullptr, DM, DM, DM, WA, smem, bid_l, nb);
    convert_phase(p->in[I_WO] + (size_t)l * DM * DM, nullptr, DM, DM, DM, WB, smem, bid_l, nb);
    xcd_barrier(xb);
#if EN_XA
    run_gemm(smem, HN, WA, T_, DM, DM, pg8::EpiBf16{BIG, DM, DM}, bid_l, 0, nb);
    xcd_barrier(xb);
    for (int rep_ = 0; rep_ < REP_ATT; ++rep_) {
      attn_phase(p, l, smem, bid_l, nb);
      xcd_barrier(xb);
    }
    run_gemm(smem, HN, WB, T_, DM, DM, pg8::EpiResid{X, X, 1.0f}, bid_l, 0, nb);
    xcd_barrier(xb);
#endif
    rmsnorm_phase<false>(X, p->in[I_NFFN2] + l * DM, HN, T_, bid_l, nb);
    convert_phase(p->in[I_F2W1] + (size_t)l * DM * DFF, p->in[I_F2W3] + (size_t)l * DM * DFF, DM, 2 * DFF, 2 * DFF, WA, smem, bid_l, nb);
    convert_phase(p->in[I_F2W2] + (size_t)l * DFF * DM, nullptr, DFF, DM, DM, WB, smem, bid_l, nb);
    xcd_barrier(xb);
    for (int rep_ = 0; rep_ < REP_G1; ++rep_) {
      run_gemm(smem, HN, WA, T_, 2 * DFF, DM, pg8::EpiSwiglu{BIG, DFF}, bid_l, 0, nb);
      xcd_barrier(xb);
    }
    run_gemm(smem, BIG, WB, T_, DM, DFF, pg8::EpiResid{X, X, 0.5f}, bid_l, 0, nb);
    xcd_barrier(xb);
  }
  rmsnorm_phase<true>(X, p->in[I_NFINAL], X, T_, bid, nb);
#undef p
#undef ws
#undef WA
#undef WB
#undef WKV
#undef MEMN
#undef HN
#undef BIG
#undef X
}

extern "C" void kernel_launch(void* const* d_in, const int* in_sizes, int n_in, void* d_out, int out_size, void* d_ws,
                              size_t ws_size, hipStream_t stream) {
  static int grid_blocks = 0;
  if (!grid_blocks) {
    int dev = 0, cus = 0, per_cu = 0;
    (void)hipGetDevice(&dev);
    (void)hipDeviceGetAttribute(&cus, hipDeviceAttributeMultiprocessorCount, dev);
    (void)hipOccupancyMaxActiveBlocksPerMultiprocessor(&per_cu, fwd_megakernel, NTHR, 0);
    if (per_cu != 1) per_cu = 1;
    grid_blocks = cus * per_cu;
  }
  Params p{};
  for (int i = 0; i < 46; ++i) p.in[i] = (const float*)d_in[i];
  p.out = (float*)d_out;
  p.ws = (char*)d_ws;
  (void)hipMemsetAsync((char*)d_ws + OFF_BAR, 0, 16384, stream);
  void* args[] = {&p};
  hipError_t e = hipLaunchCooperativeKernel((void*)fwd_megakernel, dim3(grid_blocks), dim3(NTHR), args, 0, stream);
  if (e != hipSuccess) fprintf(stderr, "cooperative launch failed: %s (grid %d)\n", hipGetErrorString(e), grid_blocks);
}
```

```cpp
#include <hip/hip_runtime.h>
#include <hip/hip_bf16.h>
#include <hip/hip_cooperative_groups.h>
#include <cstdio>
namespace cg = cooperative_groups;

typedef unsigned short u16;
using bf16x8 = __attribute__((ext_vector_type(8))) short;
using f32x4 = __attribute__((ext_vector_type(4))) float;

#define DEVI __device__ __forceinline__

constexpr int T_ = 32768, L_ = 8192, NB_ = 4, DM = 1024, DFF = 2816, INC = 3864, INCP = 4096;
constexpr int NTHR = 512, NWV = NTHR / 64;

constexpr size_t OFF_WA = 0;
constexpr size_t OFF_WB = OFF_WA + 11534336;
constexpr size_t OFF_WKV = OFF_WB + 5767168;
constexpr size_t OFF_MEMN = OFF_WKV + 8388608;
constexpr size_t OFF_KM = OFF_MEMN + 2097152;
constexpr size_t OFF_VT = OFF_KM + 4194304;
constexpr size_t OFF_RK = OFF_VT + 4194304;
constexpr size_t OFF_UB = OFF_RK + 16777216;
constexpr size_t OFF_YC = OFF_UB + 20971520;
constexpr size_t OFF_HN = OFF_YC + 16777216;
constexpr size_t OFF_YRW = OFF_HN + 67108864;
constexpr size_t OFF_YGD = OFF_YRW + 50331648;
constexpr size_t OFF_BIG = OFF_YGD + 50331648;
constexpr size_t OFF_BAR = OFF_BIG + 253231104;
constexpr size_t OFF_X0 = OFF_BAR + 16384;
constexpr int UBS = 10240;
constexpr int SCAN_SMEM = 75776;
constexpr int SMEM_BYTES = 2 * SCAN_SMEM;

struct Params {
  const float* in[46];
  float* out;
  char* ws;
};

typedef const __attribute__((address_space(4))) Params* KP;
DEVI KP opqk(KP k) { asm volatile("" : "+s"(k)); return k; }

enum {
  I_X = 0, I_MEM, I_NFFN1, I_F1W1, I_F1W3, I_F1W2, I_NMIX, I_WIN, I_WOUT, I_HYCW, I_HYCB, I_HYFREQ, I_HYW1, I_HYB1,
  I_HYW2, I_HYB2, I_HYW3, I_HYDEC, I_HYBIAS, I_MUP, I_MUN, I_WLORA, I_W0, I_ALORA, I_A0, I_GLORA, I_KK, I_KA, I_RK,
  I_GNW, I_GNB, I_GCW, I_GALOG, I_GDT, I_GNORM, I_NXA, I_WQ, I_WK, I_WV, I_WO, I_MEMNORM, I_NFFN2, I_F2W1, I_F2W3,
  I_F2W2, I_NFINAL
};

typedef __bf16 bf16x2_t __attribute__((ext_vector_type(2)));
DEVI unsigned cvtpk(float lo, float hi) { bf16x2_t v = {(__bf16)lo, (__bf16)hi}; return __builtin_bit_cast(unsigned, v); }
DEVI u16 f2bf(float f) { return (u16)(cvtpk(f, 0.f) & 0xffffu); }
DEVI float frcp(float x) { return __builtin_amdgcn_rcpf(x); }
DEVI float bf2f(u16 h) { return __uint_as_float(((unsigned)h) << 16); }
DEVI float bflo(unsigned v) { return __uint_as_float(v << 16); }
DEVI float bfhi(unsigned v) { return __uint_as_float(v & 0xffff0000u); }
DEVI unsigned pack2(float a, float b) { return cvtpk(a, b); }
DEVI float sigm(float x) { return frcp(1.f + __expf(-x)); }
DEVI float siluf(float x) { return x * frcp(1.f + __expf(-x)); }

DEVI void unpack8(uint4 v, float* f) {
  f[0] = bflo(v.x); f[1] = bfhi(v.x); f[2] = bflo(v.y); f[3] = bfhi(v.y);
  f[4] = bflo(v.z); f[5] = bfhi(v.z); f[6] = bflo(v.w); f[7] = bfhi(v.w);
}
DEVI uint4 pack8(const float* f) {
  uint4 v; v.x = pack2(f[0], f[1]); v.y = pack2(f[2], f[3]); v.z = pack2(f[4], f[5]); v.w = pack2(f[6], f[7]);
  return v;
}

template <int CTRL> DEVI float dppf(float x) {
  return __int_as_float(__builtin_amdgcn_update_dpp(0, __float_as_int(x), CTRL, 0xf, 0xf, true));
}
DEVI float allsum16(float x) {
  x += dppf<0xB1>(x);
  x += dppf<0x4E>(x);
  x += dppf<0x141>(x);
  x += dppf<0x140>(x);
  return x;
}
DEVI float allsum8(float x) {
  x += dppf<0xB1>(x);
  x += dppf<0x4E>(x);
  x += dppf<0x141>(x);
  return x;
}
DEVI int otid() { int t = threadIdx.x; asm volatile("" : "+v"(t)); return t; }
template <class Tp> DEVI const Tp* opq(const Tp* p) { asm volatile("" : "+v"(p)); return p; }
typedef float f32x2 __attribute__((ext_vector_type(2)));
DEVI float dot4(float s0, float s1, float s2, float s3, const float4& k) {
  f32x2 t = f32x2{s0, s1} * f32x2{k.x, k.y};
  t = __builtin_elementwise_fma(f32x2{s2, s3}, f32x2{k.z, k.w}, t);
  return t.x + t.y;
}
DEVI float wavesum(float x) {
  for (int o = 32; o > 0; o >>= 1) x += __shfl_xor(x, o, 64);
  return x;
}

DEVI void convert_phase(const float* __restrict__ W0, const float* __restrict__ W1, int K, int N, int Npad,
                              u16* __restrict__ Wt, char* smem, int bid, int nb) {
  float* tile = (float*)smem;
  const int tid = otid();
  const int kt = K / 64;
  const int ntiles = (Npad / 64) * kt;
  const int NW = W1 ? N / 2 : N;
  for (int t = bid; t < ntiles; t += nb) {
    const int n0 = (t / kt) * 64, k0 = (t % kt) * 64;
#pragma unroll 4
    for (int i = 0; i < 64 / NWV; ++i) {
      int kk = i * NWV + (tid >> 6), nn = tid & 63, R = n0 + nn;
      float v = 0.f;
      if (R < N) {
        if (W1) {
          int g = R >> 5, wi = R & 31;
          const float* src = (wi < 16) ? W0 : W1;
          v = src[(size_t)(k0 + kk) * NW + g * 16 + (wi & 15)];
        } else {
          v = W0[(size_t)(k0 + kk) * NW + R];
        }
      }
      tile[kk * 65 + nn] = v;
    }
    __syncthreads();
#pragma unroll 4
    for (int i = 0; i < 64 / NWV; ++i) {
      int nn = i * NWV + (tid >> 6), kk = tid & 63;
      Wt[(size_t)(n0 + nn) * K + k0 + kk] = f2bf(tile[kk * 65 + nn]);
    }
    __syncthreads();
  }
}

template <bool OUT_F32>
DEVI void rmsnorm_phase(const float* __restrict__ x, const float* __restrict__ g, void* outp, int rows, int bid,
                              int nb) {
  const int tid_ = otid();
  const int lane = tid_ & 63, wv = tid_ >> 6;
  for (int r = bid * NWV + wv; r < rows; r += nb * NWV) {
    const float* xr = x + (size_t)r * DM;
    float4 v[4];
    float ss = 0.f;
#pragma unroll
    for (int i = 0; i < 4; ++i) {
      v[i] = *(const float4*)(xr + i * 256 + lane * 4);
      ss += v[i].x * v[i].x + v[i].y * v[i].y + v[i].z * v[i].z + v[i].w * v[i].w;
    }
    ss = wavesum(ss);
    const float sc = rsqrtf(ss * (1.f / DM) + 1e-6f);
#pragma unroll
    for (int i = 0; i < 4; ++i) {
      float4 gg = *(const float4*)(g + i * 256 + lane * 4);
      float a = v[i].x * sc * gg.x, b = v[i].y * sc * gg.y, c = v[i].z * sc * gg.z, d = v[i].w * sc * gg.w;
      if (OUT_F32) {
        *(float4*)((float*)outp + (size_t)r * DM + i * 256 + lane * 4) = make_float4(a, b, c, d);
      } else {
        uint2 o; o.x = pack2(a, b); o.y = pack2(c, d);
        *(uint2*)((u16*)outp + (size_t)r * DM + i * 256 + lane * 4) = o;
      }
    }
  }
}

namespace pg8 {
#define PG8_LAS __attribute__((address_space(3)))
typedef unsigned u32x4 __attribute__((ext_vector_type(4)));
constexpr int BM = 256, BK = 64, HALF = 128, HTB = HALF * BK * 2, NXCD = 8, WGM = 8;
DEVI int lds_byte(int r, int c) { const int st = (r >> 4) * 2 + (c >> 5), rr = r & 15, cc = c & 31, ob = rr * 64 + cc * 2; return st * 1024 + (ob ^ (((ob >> 9) & 1) << 5)); }
DEVI void stage_rc(int b, int& R, int& C) { const int st = b / 1024, sb = b % 1024, swz = sb ^ (((sb >> 9) & 1) << 5); R = (st >> 1) * 16 + swz / 64; C = (st & 1) * 32 + (swz % 64) / 2; }
DEVI int perm32(int rho) { const int n = rho >> 4, i = rho & 15; return 8 * (i >> 2) + 4 * n + (i & 3); }
struct Unit { int pm, pn; };
struct Gemm { const u16* A; const u16* Bt; int M, N, K; };
struct StaticOrder {
  int nM, nN, nwg, G, c;
  DEVI void init(int M, int N, int G_, int c_) { nM = M / BM; nN = N / BM; nwg = nM * nN; G = G_; c = c_; }
  DEVI bool next(int i, Unit& u) const {
    const long L = (long)i * G + c; if (L >= nwg) return false;
    int wgid = (int)L; { const int q = nwg / NXCD, r = nwg % NXCD, xcd = wgid % NXCD, off = wgid / NXCD; wgid = (xcd < r ? xcd * (q + 1) : r * (q + 1) + (xcd - r) * q) + off; }
    const int nig = WGM * nN, gid = wgid / nig, fm = gid * WGM, gsz = (nM - fm) < WGM ? (nM - fm) : WGM;
    u.pm = fm + ((wgid % nig) % gsz); u.pn = (wgid % nig) / gsz; return true;
  }
};
DEVI unsigned cvt_pk_bf16(float lo, float hi) { return cvtpk(lo, hi); }

struct EpiBf16 {
  static constexpr bool PERM = true;
  u16* O; int ldc; int N;
  DEVI void operator()(const f32x4 (&acc)[2][2][4][2], const Unit& u, int wr, int wc, int fr, int fq) const {
    const int row0 = u.pm * BM + wr * 64 + fr, col0 = u.pn * BM + wc * 32 + 8 * fq;
#pragma unroll
    for (int ai = 0; ai < 2; ++ai)
#pragma unroll
      for (int m = 0; m < 4; ++m) {
        u16* rowp = O + (size_t)(row0 + ai * HALF + m * 16) * ldc + col0;
#pragma unroll
        for (int bj = 0; bj < 2; ++bj) {
          const f32x4 v0 = acc[ai][bj][m][0], v1 = acc[ai][bj][m][1];
          u32x4 w; w.x = cvt_pk_bf16(v0[0], v0[1]); w.y = cvt_pk_bf16(v0[2], v0[3]); w.z = cvt_pk_bf16(v1[0], v1[1]); w.w = cvt_pk_bf16(v1[2], v1[3]);
          if (col0 + bj * HALF < N) *(u32x4*)(rowp + bj * HALF) = w;
        }
      }
  }
};
struct EpiSwiglu {
  static constexpr bool PERM = false;
  u16* U; int ldu;
  DEVI void operator()(const f32x4 (&acc)[2][2][4][2], const Unit& u, int wr, int wc, int fr, int fq) const {
    const int row0 = u.pm * BM + wr * 64 + fr;
#pragma unroll
    for (int ai = 0; ai < 2; ++ai)
#pragma unroll
      for (int m = 0; m < 4; ++m) {
        u16* rowp = U + (size_t)(row0 + ai * HALF + m * 16) * ldu;
#pragma unroll
        for (int bj = 0; bj < 2; ++bj) {
          const int g32 = (u.pn * BM + bj * HALF + wc * 32) >> 5;
          const f32x4 a = acc[ai][bj][m][0], b = acc[ai][bj][m][1];
          uint2 w;
          w.x = cvt_pk_bf16(siluf(a[0]) * b[0], siluf(a[1]) * b[1]);
          w.y = cvt_pk_bf16(siluf(a[2]) * b[2], siluf(a[3]) * b[3]);
          *(uint2*)(rowp + g32 * 16 + 4 * fq) = w;
        }
      }
  }
};
struct EpiResid {
  static constexpr bool PERM = false;
  float* X; const float* Xin; float scale;
  DEVI void operator()(const f32x4 (&acc)[2][2][4][2], const Unit& u, int wr, int wc, int fr, int fq) const {
    const int row0 = u.pm * BM + wr * 64 + fr, col0 = u.pn * BM + wc * 32 + 4 * fq;
#pragma unroll
    for (int ai = 0; ai < 2; ++ai)
#pragma unroll
      for (int m = 0; m < 4; ++m) {
        const size_t ro = (size_t)(row0 + ai * HALF + m * 16) * DM + col0;
#pragma unroll
        for (int bj = 0; bj < 2; ++bj)
#pragma unroll
          for (int n = 0; n < 2; ++n) {
            const f32x4 xi = *(const f32x4*)(Xin + ro + bj * HALF + n * 16);
            *(f32x4*)(X + ro + bj * HALF + n * 16) = xi + acc[ai][bj][m][n] * scale;
          }
      }
  }
};

template <class Epi>
DEVI void gemm_phase(PG8_LAS unsigned char* lds, const Gemm g, const StaticOrder& S, const Epi& E) {
  const int tid = otid(), wid = __builtin_amdgcn_readfirstlane(tid >> 6), lane = tid & 63, wr = wid >> 2, wc = wid & 3, fr = lane & 15, fq = lane >> 4;
  const int K = g.K, nt = K / BK;
  unsigned voffA[2], voffB[2];
#pragma unroll
  for (int i = 0; i < 2; ++i) { int R, C; stage_rc(tid * 16 + i * 8192, R, C); const int Rb = Epi::PERM ? ((R & ~31) + perm32(R & 31)) : R;
    voffA[i] = (unsigned)(R * K + C) * 2u; voffB[i] = (unsigned)(Rb * K + C) * 2u; }
  const size_t kstep = (size_t)(BK * 2);
  const size_t hstep = (size_t)HALF * K * 2;
  const size_t tstep = 2 * hstep;
  const unsigned ldsw = (unsigned)wid * 1024u;
  const int aoff = lds_byte(wr * 64 + fr, fq * 8), boff = lds_byte(wc * 32 + fr, fq * 8);
#define PG8_SA(b, h) (((b) * 2 + (h)) * HTB)
#define PG8_SB(b, h) ((4 + (b) * 2 + (h)) * HTB)
#define PG8_STAGE(bufoff, gbase, voff) do { _Pragma("unroll") for (int _i = 0; _i < 2; ++_i) \
    __builtin_amdgcn_global_load_lds((const unsigned*)((const char*)(gbase) + (voff)[_i]), (PG8_LAS unsigned*)(lds + (bufoff) + ldsw + _i * 8192), 16, 0, 0); } while (0)
#define PG8_LDA(dst, b, h) do { _Pragma("unroll") for (int m = 0; m < 4; ++m) _Pragma("unroll") for (int k = 0; k < 2; ++k) dst[m][k] = *(const PG8_LAS bf16x8*)(lds + PG8_SA(b, h) + aoff + m * 2048 + k * 1024); } while (0)
#define PG8_LDB(dst, b, h) do { _Pragma("unroll") for (int n = 0; n < 2; ++n) _Pragma("unroll") for (int k = 0; k < 2; ++k) dst[n][k] = *(const PG8_LAS bf16x8*)(lds + PG8_SB(b, h) + boff + n * 2048 + k * 1024); } while (0)
#define PG8_MMA(ai, bj, At, Bt) do { __builtin_amdgcn_s_setprio(1); _Pragma("unroll") for (int m = 0; m < 4; ++m) _Pragma("unroll") for (int n = 0; n < 2; ++n) _Pragma("unroll") for (int k = 0; k < 2; ++k) \
    acc[ai][bj][m][n] = __builtin_amdgcn_mfma_f32_16x16x32_bf16(Bt[n][k], At[m][k], acc[ai][bj][m][n], 0, 0, 0); __builtin_amdgcn_s_setprio(0); } while (0)
#define PG8_WAIT_V(n) asm volatile("s_waitcnt vmcnt(" #n ")" ::: "memory")
#define PG8_WAIT_L(n) asm volatile("s_waitcnt lgkmcnt(" #n ")" ::: "memory")
#define PG8_BAR __builtin_amdgcn_s_barrier()
#define PG8_SCHED __builtin_amdgcn_sched_barrier(0)
  Unit cur, nxt; int ui = 0;
  if (!S.next(0, cur)) return;
  f32x4 acc[2][2][4][2];
#pragma unroll
  for (int a = 0; a < 2; ++a)
#pragma unroll
    for (int b = 0; b < 2; ++b)
#pragma unroll
      for (int m = 0; m < 4; ++m)
#pragma unroll
        for (int n = 0; n < 2; ++n) acc[a][b][m][n] = (f32x4){0.f, 0.f, 0.f, 0.f};
  bf16x8 At[4][2], B0[2][2], B1[2][2];
  const char* cA = (const char*)g.A + (size_t)cur.pm * tstep; const char* cB = (const char*)g.Bt + (size_t)cur.pn * tstep;
  PG8_STAGE(PG8_SB(0, 0), cB, voffB); PG8_STAGE(PG8_SA(0, 0), cA, voffA); PG8_STAGE(PG8_SB(0, 1), cB + hstep, voffB); PG8_STAGE(PG8_SA(0, 1), cA + hstep, voffA);
  if (wr == 1) PG8_BAR;
  PG8_WAIT_V(4); PG8_BAR;
  PG8_STAGE(PG8_SB(1, 0), cB + kstep, voffB); PG8_STAGE(PG8_SA(1, 0), cA + kstep, voffA); PG8_STAGE(PG8_SB(1, 1), cB + hstep + kstep, voffB);
  PG8_WAIT_V(6); PG8_BAR;
  for (;;) {
    const bool has_next = S.next(ui + 1, nxt);
    const char* nA = has_next ? (const char*)g.A + (size_t)nxt.pm * tstep : cA; const char* nB = has_next ? (const char*)g.Bt + (size_t)nxt.pn * tstep : cB;
    for (int t = 0; t < nt; t += 2) {
      const bool last = (t == nt - 2);
      const char* a1 = cA + (size_t)(t + 1) * kstep;
      const char* a2 = last ? nA : cA + (size_t)(t + 2) * kstep; const char* b2 = last ? nB : cB + (size_t)(t + 2) * kstep;
      const char* a3 = a2 + kstep; const char* b3 = b2 + kstep;
      PG8_LDB(B0, 0, 0); PG8_SCHED; PG8_LDA(At, 0, 0); PG8_STAGE(PG8_SA(1, 1), a1 + hstep, voffA);
      PG8_WAIT_L(8); PG8_BAR; PG8_WAIT_L(0); PG8_MMA(0, 0, At, B0); PG8_BAR; PG8_SCHED;
      PG8_LDB(B1, 0, 1); PG8_STAGE(PG8_SB(0, 0), b2, voffB);
      PG8_BAR; PG8_WAIT_L(0); PG8_MMA(0, 1, At, B1); PG8_BAR;
      PG8_LDA(At, 0, 1); PG8_STAGE(PG8_SA(0, 0), a2, voffA);
      PG8_BAR; PG8_WAIT_L(0); PG8_MMA(1, 0, At, B0); PG8_BAR; PG8_SCHED;
      PG8_STAGE(PG8_SB(0, 1), b2 + hstep, voffB);
      PG8_WAIT_V(6); PG8_BAR; PG8_MMA(1, 1, At, B1); PG8_BAR;
      PG8_LDB(B0, 1, 0); PG8_SCHED; PG8_LDA(At, 1, 0); PG8_STAGE(PG8_SA(0, 1), a2 + hstep, voffA);
      PG8_WAIT_L(8); PG8_BAR; PG8_WAIT_L(0); PG8_MMA(0, 0, At, B0); PG8_BAR; PG8_SCHED;
      PG8_LDB(B1, 1, 1); PG8_STAGE(PG8_SB(1, 0), b3, voffB);
      PG8_BAR; PG8_WAIT_L(0); PG8_MMA(0, 1, At, B1); PG8_BAR;
      PG8_LDA(At, 1, 1); PG8_STAGE(PG8_SA(1, 0), a3, voffA);
      PG8_BAR; PG8_WAIT_L(0); PG8_MMA(1, 0, At, B0); PG8_BAR; PG8_SCHED;
      PG8_STAGE(PG8_SB(1, 1), b3 + hstep, voffB);
      PG8_WAIT_V(6); PG8_BAR; PG8_MMA(1, 1, At, B1); PG8_BAR;
    }
    E(acc, cur, wr, wc, fr, fq);
    if (!has_next) break;
#pragma unroll
    for (int a = 0; a < 2; ++a)
#pragma unroll
      for (int b = 0; b < 2; ++b)
#pragma unroll
        for (int m = 0; m < 4; ++m)
#pragma unroll
          for (int n = 0; n < 2; ++n) acc[a][b][m][n] = (f32x4){0.f, 0.f, 0.f, 0.f};
    cur = nxt; cA = nA; cB = nB; ++ui;
  }
  PG8_WAIT_V(0);
  if (wr == 0) PG8_BAR;
  PG8_BAR;
#undef PG8_SA
#undef PG8_SB
#undef PG8_STAGE
#undef PG8_LDA
#undef PG8_LDB
#undef PG8_MMA
#undef PG8_WAIT_V
#undef PG8_WAIT_L
#undef PG8_BAR
#undef PG8_SCHED
}
}

template <class Epi>
DEVI void run_gemm(char* smem, const u16* A, const u16* Bt, int M, int N, int K, const Epi& E, int bid, int b0, int G) {
  pg8::StaticOrder S;
  asm volatile("" : "+s"(bid));
  const int c = (bid >= b0 && bid < b0 + G) ? (bid - b0) : (1 << 28);
  S.init(M, N, G, c);
  pg8::Gemm g{A, Bt, M, N, K};
  pg8::gemm_phase<Epi>((PG8_LAS unsigned char*)smem, g, S, E);
}

DEVI void hyfilter_phase(KP p, char* smem, int bid, int nb, int l_only = -1, size_t hoff = OFF_YRW) {
  constexpr int NP = 32;
  float* z = (float*)smem;
  float* h1 = z + NP * 33;
  float* h2 = h1 + NP * 64;
  float* HRAW = (float*)(p->ws + hoff);
  const int tid = otid();
  for (int it = bid; it < L_ / NP; it += nb) {
    const int l = l_only, t0 = it * NP;
    const int slot_ = 0;
    const float* freq = p->in[I_HYFREQ] + l * 64;
    const float* w1 = p->in[I_HYW1] + l * 33 * 64;
    const float* b1 = p->in[I_HYB1] + l * 64;
    const float* w2 = p->in[I_HYW2] + l * 64 * 64;
    const float* b2 = p->in[I_HYB2] + l * 64;
    const float* w3 = p->in[I_HYW3] + l * 64 * 512;
    const float* dec = p->in[I_HYDEC] + l * 512;
    for (int e = tid; e < NP * 33; e += NTHR) {
      int pos = e / 33, f = e % 33;
      int i = t0 + pos;
      float v;
      if (f == 0) {
        v = (float)i / (float)(L_ - 1);
      } else {
        int m = (f - 1) & 15;
        float band = 1e-4f + (float)m * ((15.f - 1e-4f) / 15.f);
        float ang = 6.283185307179586f * (float)i / (float)L_;
        float a = band * ang;
        v = (f <= 16) ? cosf(a) : -sinf(a);
      }
      z[pos * 33 + f] = v;
    }
    __syncthreads();
    {
      const int o = tid & 63;
      const float fo = freq[o], bo = b1[o];
#pragma unroll
      for (int i = 0; i < NP / NWV; ++i) {
        int pos = (tid >> 6) + NWV * i;
        float s = bo;
#pragma unroll 11
        for (int f = 0; f < 33; ++f) s += z[pos * 33 + f] * w1[f * 64 + o];
        h1[pos * 64 + o] = sinf(fo * s);
      }
    }
    __syncthreads();
    {
      const int o = tid & 63;
      const float fo = freq[o], bo = b2[o];
#pragma unroll
      for (int i = 0; i < NP / NWV; ++i) {
        int pos = (tid >> 6) + NWV * i;
        float s = bo;
#pragma unroll 16
        for (int f = 0; f < 64; ++f) s += h1[pos * 64 + f] * w2[f * 64 + o];
        h2[pos * 64 + o] = sinf(fo * s);
      }
    }
    __syncthreads();
#pragma unroll 1
    for (int cc = 0; cc < 512 / NTHR; ++cc) {
      const int ch = tid + NTHR * cc;
      float acc[NP];
#pragma unroll
      for (int q = 0; q < NP; ++q) acc[q] = 0.f;
#pragma unroll 8
      for (int o = 0; o < 64; ++o) {
        float w = w3[o * 512 + ch];
#pragma unroll
        for (int q = 0; q < NP; ++q) acc[q] += h2[q * 64 + o] * w;
      }
      const float dc = dec[ch];
      float* dst = HRAW + ((size_t)(slot_ * 512 + ch)) * L_ + t0;
#pragma unroll
      for (int q = 0; q < NP; ++q) {
        float tp = (float)(t0 + q) / (float)(L_ - 1);
        dst[q] = acc[q] * __expf(-tp * dc);
      }
    }
    __syncthreads();
  }
}

DEVI void hynorm_phase(KP p, char* smem, int bid, int nb, int l_only = -1, size_t hoff = OFF_YRW) {
  float* red = (float*)smem;
  const float* HRAW = (const float*)(p->ws + hoff);
  u16* RK = (u16*)(p->ws + OFF_RK);
  const int tid = otid();
  for (int it0_ = bid; it0_ < 256; it0_ += nb) {
    const int l = l_only, c = it0_;
    const int slot_ = 0;
    const int it = l * 256 + c;
    const float* hf = HRAW + ((size_t)(slot_ * 512 + c)) * L_;
    const float* hb = HRAW + ((size_t)(slot_ * 512 + 256 + c)) * L_;
    float s = 0.f;
    for (int t = tid; t < L_; t += NTHR) {
      s += fabsf(hf[t]);
      if (t > 0) s += fabsf(hb[t]);
    }
    s = wavesum(s);
    if ((tid & 63) == 0) red[tid >> 6] = s;
    __syncthreads();
    float tot = 0.f;
    for (int w = 0; w < NWV; ++w) tot += red[w];
    const float inv = 1.f / tot;
    u16* dst = RK + (size_t)it * 16384;
    for (int i = tid; i < 16384; i += NTHR) {
      int m = i - 8192;
      float v;
      if (m == -8192) v = 0.f;
      else if (m <= 0) v = hf[-m] * inv;
      else v = hb[m] * inv;
      dst[i] = f2bf(v);
    }
    __syncthreads();
  }
}

DEVI float ldP(const u16* P, int b, int t, int col) {
  return (t >= 0 && t < L_) ? bf2f(P[((size_t)(b * L_ + t)) * INC + col]) : 0.f;
}
DEVI uint4 ldrow8(const u16* P, int b, int t, int col);
DEVI void ld8f(const float* __restrict__ g, float* o);
DEVI void hyprep_phase(KP p, int l, char* smem, int bid, int nb) {
  float* tileU = (float*)smem;
  float* tileX = tileU + 64 * 65;
  const u16* P = (const u16*)(p->ws + OFF_BIG);
  u16* UB = (u16*)(p->ws + OFF_UB);
  u16* X0 = (u16*)(p->ws + OFF_X0);
  const float* cw = p->in[I_HYCW] + l * 3 * 768;
  const float* cb = p->in[I_HYCB] + l * 768;
  const int tid = otid();
  for (int it = bid; it < 2048; it += nb) {
    const int ct = it & 3, tt = (it >> 2) & 127, b = it >> 9;
    const int c0 = ct * 64, t0 = tt * 64;
    {
      const int tl = tid >> 3, cg = tid & 7, t = t0 + tl, c = c0 + cg * 8;
      float xs[3][8];
#pragma unroll
      for (int a3 = 0; a3 < 3; ++a3) {
        float pm[8], p0[8], pp[8], w0[8], w1[8], w2[8], bb[8];
        unpack8(ldrow8(P, b, t - 1, a3 * 256 + c), pm);
        unpack8(ldrow8(P, b, t, a3 * 256 + c), p0);
        unpack8(ldrow8(P, b, t + 1, a3 * 256 + c), pp);
        ld8f(cw + a3 * 256 + c, w0); ld8f(cw + 768 + a3 * 256 + c, w1); ld8f(cw + 1536 + a3 * 256 + c, w2);
        ld8f(cb + a3 * 256 + c, bb);
#pragma unroll
        for (int e = 0; e < 8; ++e) xs[a3][e] = w0[e] * pm[e] + w1[e] * p0[e] + w2[e] * pp[e] + bb[e];
      }
#pragma unroll
      for (int e = 0; e < 8; ++e) {
        tileU[tl * 65 + cg * 8 + e] = xs[1][e] * xs[2][e];
        tileX[tl * 65 + cg * 8 + e] = xs[0][e];
      }
    }
    __syncthreads();
    {
      const int cc = tid >> 3, tq = tid & 7;
      float u8[8], x8[8];
#pragma unroll
      for (int e = 0; e < 8; ++e) { u8[e] = tileU[(tq * 8 + e) * 65 + cc]; x8[e] = tileX[(tq * 8 + e) * 65 + cc]; }
      *(uint4*)(UB + ((size_t)((c0 + cc) * 4 + b)) * UBS + 1024 + t0 + tq * 8) = pack8(u8);
      *(uint4*)(X0 + ((size_t)((c0 + cc) * 4 + b)) * L_ + t0 + tq * 8) = pack8(x8);
    }
    if (tt == 0 || tt == 127) {
      const int poff = (tt == 0) ? 0 : (1024 + L_);
      for (int e = tid; e < 64 * 128; e += NTHR) {
        int cc = e >> 7, q = e & 127;
        *(uint4*)(UB + ((size_t)((c0 + cc) * 4 + b)) * UBS + poff + q * 8) = make_uint4(0, 0, 0, 0);
      }
    }
    __syncthreads();
  }
}

DEVI void hyconv_item(KP p, int l, int item, char* smem) {
  const int tid_ = otid();
  const int lane = tid_ & 63, wv = tid_ >> 6;
  const int fr = lane & 15, fq = lane >> 4;
  const int c = item, it32 = wv;
  const int a = it32 * 32;
  u16* sU = (u16*)smem;
  unsigned* sK = (unsigned*)(smem + 4 * UBS * 2);
  {
    const uint4* gu = (const uint4*)((const u16*)(p->ws + OFF_UB) + (size_t)(c * 4) * UBS);
    const uint4* gk = (const uint4*)((const u16*)(p->ws + OFF_RK) + (size_t)(l * 256 + c) * 16384);
    __syncthreads();
    for (int i = tid_; i < 4 * UBS / 8; i += NTHR) ((uint4*)sU)[i] = gu[i];
    for (int i = tid_; i < 16384 / 8; i += NTHR) ((uint4*)sK)[i] = gk[i];
    __syncthreads();
  }
  f32x4 acc[2][8];
#pragma unroll
  for (int m = 0; m < 2; ++m)
#pragma unroll
    for (int n = 0; n < 8; ++n) acc[m][n] = f32x4{0.f, 0.f, 0.f, 0.f};
#pragma unroll 1
  for (int D = a + 31; D >= a - 255; --D) {
    bf16x8 af[2];
#pragma unroll
    for (int mt = 0; mt < 2; ++mt) {
      int idx = fq * 8 - (mt * 16 + fr) - 32 * D + 8192;
      int bd = idx >> 1;
      unsigned sh = (idx & 1) * 16;
      unsigned d0 = sK[bd], d1 = sK[bd + 1], d2 = sK[bd + 2], d3 = sK[bd + 3], d4 = sK[bd + 4];
      union { unsigned u[4]; bf16x8 v; } cv;
      cv.u[0] = __builtin_amdgcn_alignbit(d1, d0, sh);
      cv.u[1] = __builtin_amdgcn_alignbit(d2, d1, sh);
      cv.u[2] = __builtin_amdgcn_alignbit(d3, d2, sh);
      cv.u[3] = __builtin_amdgcn_alignbit(d4, d3, sh);
      af[mt] = cv.v;
    }
#pragma unroll
    for (int n = 0; n < 8; ++n) {
      const int b = n >> 1, ct = n & 1;
      const int i1 = a + ct * 16 + fr;
      bf16x8 bf = *(const bf16x8*)(sU + b * UBS + 1024 + (i1 - D) * 32 + fq * 8);
      acc[0][n] = __builtin_amdgcn_mfma_f32_16x16x32_bf16(af[0], bf, acc[0][n], 0, 0, 0);
      acc[1][n] = __builtin_amdgcn_mfma_f32_16x16x32_bf16(af[1], bf, acc[1][n], 0, 0, 0);
    }
  }
  const u16* X0 = (const u16*)(p->ws + OFF_X0) + (size_t)(c * 4) * L_;
  u16* Yo = (u16*)(p->ws + OFF_HN);
  const float bias = p->in[I_HYBIAS][l * 256 + c];
#pragma unroll
  for (int n = 0; n < 8; ++n) {
    const int b = n >> 1, ct = n & 1;
    const int i1 = a + ct * 16 + fr;
#pragma unroll
    for (int mt = 0; mt < 2; ++mt) {
      const int t = i1 * 32 + mt * 16 + fq * 4;
      const uint2 xr = *(const uint2*)(X0 + (size_t)b * L_ + t);
      const uint2 ur = *(const uint2*)(sU + b * UBS + 1024 + t);
      const float x0[4] = {bflo(xr.x), bfhi(xr.x), bflo(xr.y), bfhi(xr.y)};
      const float uu[4] = {bflo(ur.x), bfhi(ur.x), bflo(ur.y), bfhi(ur.y)};
#pragma unroll
      for (int j = 0; j < 4; ++j)
        Yo[((size_t)(b * L_ + t + j)) * DM + c] = f2bf(x0[j] * (acc[mt][n][j] + bias * uu[j]));
    }
  }
}

DEVI uint4 ldrow8(const u16* P, int b, int t, int col) {
  if (t < 0 || t >= L_) return make_uint4(0, 0, 0, 0);
  return *(const uint4*)(P + ((size_t)(b * L_ + t)) * INC + col);
}
DEVI void shift8(uint4 pm, uint4 p0, uint4 pp, const float* __restrict__ mup, const float* __restrict__ mun,
                 float* out) {
  float a[8], u[8], n[8];
  unpack8(pm, a); unpack8(p0, u); unpack8(pp, n);
  float4 m0 = *(const float4*)mup, m1 = *(const float4*)(mup + 4);
  float4 n0 = *(const float4*)mun, n1 = *(const float4*)(mun + 4);
  float mp[8] = {m0.x, m0.y, m0.z, m0.w, m1.x, m1.y, m1.z, m1.w};
  float mn[8] = {n0.x, n0.y, n0.z, n0.w, n1.x, n1.y, n1.z, n1.w};
#pragma unroll
  for (int e = 0; e < 8; ++e) out[e] = u[e] + mp[e] * (a[e] - u[e]) + mn[e] * (n[e] - u[e]);
}
DEVI void ld8f(const float* __restrict__ g, float* o) {
  float4 a = *(const float4*)g, b = *(const float4*)(g + 4);
  o[0] = a.x; o[1] = a.y; o[2] = a.z; o[3] = a.w; o[4] = b.x; o[5] = b.y; o[6] = b.z; o[7] = b.w;
}
DEVI void st8f(float* s, const float* v) {
  *(float4*)s = make_float4(v[0], v[1], v[2], v[3]);
  *(float4*)(s + 4) = make_float4(v[4], v[5], v[6], v[7]);
}

DEVI float dot8(const f32x2 (&S)[4], const float4& a, const float4& b) {
  f32x2 t = S[0] * f32x2{a.x, a.y};
  f32x2 u = S[1] * f32x2{a.z, a.w};
  t = __builtin_elementwise_fma(S[2], f32x2{b.x, b.y}, t);
  u = __builtin_elementwise_fma(S[3], f32x2{b.z, b.w}, u);
  t += u;
  return t.x + t.y;
}

DEVI void rwscan_pc_item(KP p, int l, int item, char* smem) {
  const int tid = otid();
  const int lane = tid & 63, wv = tid >> 6;
  const bool cons = wv < 4;
  const int fr = lane & 15, fq = lane >> 4;
  const int rg2 = item & 1, d = (item >> 1) & 1, bh = item >> 2, h = bh % 6, b = bh / 6;
  constexpr int BUFF = 12352;
  float* s_buf = (float*)smem;
  float* s_a = s_buf + 2 * BUFF;
  u16* s_lw = (u16*)(s_a + 2048);
  u16* s_la = s_lw + 32 * 72;
  float* s_y = (float*)(s_la + 32 * 72);
  float* s_mu = s_y + 1024;
  const u16* P = (const u16*)(p->ws + OFF_BIG);
  u16* Yd = (u16*)(p->ws + OFF_YRW) + (size_t)d * T_ * 384;
  const float* mup = p->in[I_MUP] + l * 1536;
  const float* mun = p->in[I_MUN] + l * 1536;
  const int pt = tid & 255, tl = pt >> 3, jg = pt & 7, pw = wv & 3;
  const int cr = 768 + h * 64 + jg * 8, ck = 1152 + h * 64 + jg * 8, cvv = 1536 + h * 64 + jg * 8;
  const int clw = 1920 + d * 64 + jg * 8, cla = 2048 + d * 64 + jg * 8;
  bf16x8 fW[2], fA[2];
  {
    const float* Wl = p->in[I_WLORA] + (size_t)(l * 2 + d) * 64 * 384 + h * 64 + pw * 16 + fr;
    const float* Al = p->in[I_ALORA] + (size_t)(l * 2 + d) * 64 * 384 + h * 64 + pw * 16 + fr;
#pragma unroll
    for (int ks = 0; ks < 2; ++ks) {
#pragma unroll
      for (int e = 0; e < 8; ++e) {
        int r = ks * 32 + fq * 8 + e;
        fW[ks][e] = (short)f2bf(Wl[r * 384]);
        fA[ks][e] = (short)f2bf(Al[r * 384]);
      }
    }
  }
  const float w0v = p->in[I_W0][(l * 2 + d) * 384 + h * 64 + pw * 16 + fr];
  const float a0v = p->in[I_A0][(l * 2 + d) * 384 + h * 64 + pw * 16 + fr];
  for (int e = tid; e < 768; e += NTHR) {
    float v;
    if (e < 640) {
      const int a5 = (e % 320) >> 6, j = e & 63;
      const int base = (a5 < 3) ? (a5 * 384 + h * 64) : (1152 + (a5 - 3) * 128 + d * 64);
      v = ((e < 320) ? mup : mun)[base + j];
    } else {
      v = ((e < 704) ? p->in[I_KK] : p->in[I_KA])[l * 384 + h * 64 + (e & 63)];
    }
    s_mu[e] = v;
  }
  __syncthreads();
  const int row8 = lane >> 3, e8 = lane & 7;
  const int rowi = rg2 * 32 + pw * 8 + row8;
  const int j8 = e8 * 8;
  f32x2 S[4];
#pragma unroll
  for (int i = 0; i < 4; ++i) S[i] = f32x2{0.f, 0.f};

  uint4 q[15];
#pragma unroll
  for (int i = 0; i < 15; ++i) q[i] = make_uint4(0, 0, 0, 0);
  if (!cons) {
    int t = d ? (L_ - 1 - tl) : tl;
#pragma unroll
    for (int dt = 0; dt < 3; ++dt) {
      q[0 + dt] = ldrow8(P, b, t + dt - 1, cr);
      q[3 + dt] = ldrow8(P, b, t + dt - 1, ck);
      q[6 + dt] = ldrow8(P, b, t + dt - 1, cvv);
      q[9 + dt] = ldrow8(P, b, t + dt - 1, clw);
      q[12 + dt] = ldrow8(P, b, t + dt - 1, cla);
    }
  }
  float kv[8], kkn[8];
#pragma unroll
  for (int e = 0; e < 8; ++e) { kv[e] = 0.f; kkn[e] = 0.f; }
  float yacc = 0.f;

  struct RwOps { float4 ka, kb, ra, rb; float vi; float2 sc; };
  struct RwUpd { float4 da, db, ba, bb, wa, wb; };
  auto scan_seg = [&](const float* cb, int seg) {
    auto ldops = [&](int s) {
      RwOps r;
      const float* o = cb + 2048 + s * 64 + j8;
      r.ka = *(const float4*)(o); r.kb = *(const float4*)(o + 4);
      r.ra = *(const float4*)(o - 2048); r.rb = *(const float4*)(o - 2048 + 4);
      r.vi = cb[10240 + s * 64 + rowi];
      r.sc = *(const float2*)(cb + 12288 + s * 2);
      return r;
    };
    auto ldupd = [&](int s) {
      RwUpd r;
      const float* o = cb + 2048 + s * 64 + j8;
      r.da = *(const float4*)(o + 2048); r.db = *(const float4*)(o + 2048 + 4);
      r.ba = *(const float4*)(o + 4096); r.bb = *(const float4*)(o + 4096 + 4);
      r.wa = *(const float4*)(o + 6144); r.wb = *(const float4*)(o + 6144 + 4);
      return r;
    };
    RwOps cur = ldops(seg * 8);
#pragma unroll
    for (int i_ = 0; i_ < 8; ++i_) {
      const int s = seg * 8 + i_;
      const RwUpd up = ldupd(s);
      const RwOps nxt = ldops(seg * 8 + ((i_ + 1) & 7));
      float dA = dot8(S, cur.ka, cur.kb);
      float dB = dot8(S, cur.ra, cur.rb);
      const f32x2 vi2 = f32x2{cur.vi, cur.vi};
      const f32x2 A0 = __builtin_elementwise_fma(S[0], f32x2{up.wa.x, up.wa.y}, vi2 * f32x2{up.da.x, up.da.y});
      const f32x2 A1 = __builtin_elementwise_fma(S[1], f32x2{up.wa.z, up.wa.w}, vi2 * f32x2{up.da.z, up.da.w});
      const f32x2 A2 = __builtin_elementwise_fma(S[2], f32x2{up.wb.x, up.wb.y}, vi2 * f32x2{up.db.x, up.db.y});
      const f32x2 A3 = __builtin_elementwise_fma(S[3], f32x2{up.wb.z, up.wb.w}, vi2 * f32x2{up.db.z, up.db.w});
      const float sa = allsum8(dA);
      dB = allsum8(dB);
      const float y = dB + sa * cur.sc.x + cur.vi * cur.sc.y;
      const f32x2 sa2 = f32x2{sa, sa};
      S[0] = __builtin_elementwise_fma(sa2, f32x2{up.ba.x, up.ba.y}, A0);
      S[1] = __builtin_elementwise_fma(sa2, f32x2{up.ba.z, up.ba.w}, A1);
      S[2] = __builtin_elementwise_fma(sa2, f32x2{up.bb.x, up.bb.y}, A2);
      S[3] = __builtin_elementwise_fma(sa2, f32x2{up.bb.z, up.bb.w}, A3);
      yacc = (e8 == i_) ? y : yacc;
      cur = nxt;
    }
    s_y[(seg * 8 + e8) * 32 + pw * 8 + row8] = yacc;
  };

  constexpr int NC = L_ / 32;
  if (cons) {
    for (int c = 0; c <= NC; ++c) {
      const float* cb = s_buf + ((c + 1) & 1) * BUFF;
      const bool cact = c >= 1;
      if (cact) scan_seg(cb, 0);
      __syncthreads();
      if (cact) scan_seg(cb, 1);
      __syncthreads();
      if (cact) scan_seg(cb, 2);
      __syncthreads();
    if (cact) {
        scan_seg(cb, 3);
        const int t2 = lane >> 1, hf = lane & 1;
        const float4 o4 = *(const float4*)(s_y + t2 * 32 + pw * 8 + hf * 4);
        const int ts = (c - 1) * 32 + t2;
        const int t = d ? (L_ - 1 - ts) : ts;
        uint2 o; o.x = pack2(o4.x, o4.y); o.y = pack2(o4.z, o4.w);
        *(uint2*)(Yd + ((size_t)(b * L_ + t)) * 384 + h * 64 + rg2 * 32 + pw * 8 + hf * 4) = o;
      }
    __syncthreads();
    }
  } else {
    const float* mp_ = s_mu + jg * 8;
    const float* mn_ = s_mu + 320 + jg * 8;
    for (int c = 0; c <= NC; ++c) {
      float* pb = s_buf + (c & 1) * BUFF;
      const bool pact = c < NC;
      const bool pnext = c + 1 < NC;
      const int tn_ = (c + 1) * 32 + tl;
      const int tnx = d ? (L_ - 1 - tn_) : tn_;
      const u16* rw0_ = P + ((size_t)(b * L_ + tnx)) * INC;
      const u16* rk0 = rw0_ + (h * 64 + jg * 8);
      const u16* rl0 = rw0_ + (d * 64 + jg * 8);
      const bool edge = pnext && (c + 1 == NC - 1);
      const bool zm = edge && (tnx - 1 < 0), zp = edge && (tnx + 1 >= L_);
      const uint4 zero4 = make_uint4(0, 0, 0, 0);
      if (pact) {
        float rr[8], lw[8], la[8];
        shift8(q[9], q[10], q[11], mp_ + 192, mn_ + 192, lw);
        shift8(q[12], q[13], q[14], mp_ + 256, mn_ + 256, la);
        shift8(q[0], q[1], q[2], mp_, mn_, rr);
#pragma unroll
        for (int e = 0; e < 8; ++e) lw[e] = 1.f - 2.f * frcp(1.f + __expf(2.f * lw[e]));
        *(uint4*)(s_lw + tl * 72 + jg * 8) = pack8(lw);
        *(uint4*)(s_la + tl * 72 + jg * 8) = pack8(la);
        st8f(pb + tl * 64 + jg * 8, rr);
      }
      if (pnext) {
        q[9] = *(const uint4*)(rl0 + 1920 - INC); q[10] = *(const uint4*)(rl0 + 1920); q[11] = *(const uint4*)(rl0 + 1920 + INC);
        q[12] = *(const uint4*)(rl0 + 2048 - INC); q[13] = *(const uint4*)(rl0 + 2048); q[14] = *(const uint4*)(rl0 + 2048 + INC);
        q[0] = *(const uint4*)(rk0 + 768 - INC); q[1] = *(const uint4*)(rk0 + 768); q[2] = *(const uint4*)(rk0 + 768 + INC);
        if (edge) {
          if (zm) { q[9] = zero4; q[12] = zero4; q[0] = zero4; }
          if (zp) { q[11] = zero4; q[14] = zero4; q[2] = zero4; }
        }
      }
      __syncthreads();
      if (pact) {
#pragma unroll
        for (int mt = 0; mt < 2; ++mt) {
          f32x4 aw = {0.f, 0.f, 0.f, 0.f}, aa = {0.f, 0.f, 0.f, 0.f};
#pragma unroll
          for (int ks = 0; ks < 2; ++ks) {
            bf16x8 xw = *(const bf16x8*)(s_lw + (mt * 16 + fr) * 72 + ks * 32 + fq * 8);
            bf16x8 xa = *(const bf16x8*)(s_la + (mt * 16 + fr) * 72 + ks * 32 + fq * 8);
            aw = __builtin_amdgcn_mfma_f32_16x16x32_bf16(xw, fW[ks], aw, 0, 0, 0);
            aa = __builtin_amdgcn_mfma_f32_16x16x32_bf16(xa, fA[ks], aa, 0, 0, 0);
          }
#pragma unroll
          for (int j = 0; j < 4; ++j) {
            int t2 = mt * 16 + fq * 4 + j, jj = pw * 16 + fr;
            pb[8192 + t2 * 64 + jj] = __expf(-0.606531f * sigm(aw[j] + w0v));
            s_a[t2 * 64 + jj] = sigm(aa[j] + a0v);
          }
        }
        float vv[8];
        shift8(q[6], q[7], q[8], mp_ + 128, mn_ + 128, vv);
        st8f(pb + 10240 + tl * 64 + jg * 8, vv);
      }
      if (pnext) {
        q[6] = *(const uint4*)(rk0 + 1536 - INC); q[7] = *(const uint4*)(rk0 + 1536); q[8] = *(const uint4*)(rk0 + 1536 + INC);
        if (edge) { if (zm) q[6] = zero4; if (zp) q[8] = zero4; }
      }
      __syncthreads();
      if (pact) {
        shift8(q[3], q[4], q[5], mp_ + 64, mn_ + 64, kv);
        float kkc[8];
        ld8f(s_mu + 640 + jg * 8, kkc);
        float ss = 0.f;
#pragma unroll
        for (int e = 0; e < 8; ++e) { kkn[e] = kv[e] * kkc[e]; ss += kkn[e] * kkn[e]; }
        ss = allsum8(ss);
        const float inv = rsqrtf(ss + 1e-6f);
        float nk[8];
#pragma unroll
        for (int e = 0; e < 8; ++e) { kkn[e] *= inv; nk[e] = -kkn[e]; }
        st8f(pb + 2048 + tl * 64 + jg * 8, nk);
      }
      if (pnext) {
        q[3] = *(const uint4*)(rk0 + 1152 - INC); q[4] = *(const uint4*)(rk0 + 1152); q[5] = *(const uint4*)(rk0 + 1152 + INC);
        if (edge) { if (zm) q[3] = zero4; if (zp) q[5] = zero4; }
      }
      __syncthreads();
      if (pact) {
        float av[8], kac[8], kd[8], bb[8], rr[8], wv8[8];
        ld8f(s_a + tl * 64 + jg * 8, av);
        ld8f(pb + tl * 64 + jg * 8, rr);
        ld8f(pb + 8192 + tl * 64 + jg * 8, wv8);
        ld8f(s_mu + 704 + jg * 8, kac);
        float br = 0.f, kr = 0.f;
#pragma unroll
        for (int e = 0; e < 8; ++e) {
          kd[e] = kv[e] * (1.f + (av[e] - 1.f) * kac[e]);
          bb[e] = kkn[e] * av[e];
          br += bb[e] * rr[e];
          kr += kd[e] * rr[e];
          rr[e] *= wv8[e];
        }
        br = allsum8(br);
        kr = allsum8(kr);
        st8f(pb + 4096 + tl * 64 + jg * 8, kd);
        st8f(pb + 6144 + tl * 64 + jg * 8, bb);
        st8f(pb + tl * 64 + jg * 8, rr);
        if (jg == 0) *(float2*)(pb + 12288 + tl * 2) = make_float2(br, kr);
      }
      __syncthreads();
    }
  }
}

DEVI void gdscan_pc_item(KP p, int l, int item, char* smem) {
  const int tid = otid();
  const int lane = tid & 63, wv = tid >> 6;
  const bool cons = wv < 4;
  const int rg2 = item & 1, d = (item >> 1) & 1, bh = item >> 2, h = bh % 6, b = bh / 6;
  constexpr int BUFF = 6272;
  float* s_buf = (float*)smem;
  float* s_y = s_buf + 2 * BUFF;
  const u16* P = (const u16*)(p->ws + OFF_BIG);
  u16* Yd = (u16*)(p->ws + OFF_YGD) + (size_t)d * T_ * 384;
  const float* cw = p->in[I_GCW] + l * 3 * 1152;
  const int pt = tid & 255, tl = pt >> 3, jg = pt & 7, pw = wv & 3;
  const int lq = h * 64 + jg * 8, lk = 384 + lq, lv = 768 + lq;
  const float negA = -__expf(p->in[I_GALOG][(l * 2 + d) * 6 + h]);
  const float dtb = p->in[I_GDT][(l * 2 + d) * 6 + h];
  const int cag = 3840 + d * 6 + h, cbg = 3852 + d * 6 + h;
  const int row8 = lane >> 3, e8 = lane & 7;
  const int col_e = rg2 * 32 + pw * 8 + row8;
  const int j8 = e8 * 8;
  f32x2 S[4];
#pragma unroll
  for (int i = 0; i < 4; ++i) S[i] = f32x2{0.f, 0.f};
  float yacc = 0.f;

  uint4 q[9];
#pragma unroll
  for (int i = 0; i < 9; ++i) q[i] = make_uint4(0, 0, 0, 0);
  u16 rag = 0, rbg = 0;
  if (!cons) {
    int t = d ? (L_ - 1 - tl) : tl;
#pragma unroll
    for (int dt = 0; dt < 3; ++dt) {
      q[0 + dt] = ldrow8(P, b, t + dt - 1, 2304 + lq);
      q[3 + dt] = ldrow8(P, b, t + dt - 1, 2304 + lk);
      q[6 + dt] = ldrow8(P, b, t + dt - 1, 2304 + lv);
    }
    { const u16* pr_ = P + ((size_t)(b * L_ + t)) * INC; rag = pr_[cag]; rbg = pr_[cbg]; }
  }
  struct GdOps { float4 ka, kb, qa, qb, sc; float ve; };
  auto scan_seg = [&](const float* cb, int seg) {
    auto ldops = [&](int s) {
      GdOps r;
      const float* o = cb + 2048 + s * 64 + j8;
      r.ka = *(const float4*)(o); r.kb = *(const float4*)(o + 4);
      r.qa = *(const float4*)(o - 2048); r.qb = *(const float4*)(o - 2048 + 4);
      r.ve = cb[4096 + s * 64 + col_e];
      r.sc = *(const float4*)(cb + 6144 + s * 4);
      return r;
    };
    GdOps cur = ldops(seg * 16);
#pragma unroll
    for (int i_ = 0; i_ < 16; ++i_) {
      const int s = seg * 16 + i_;
      const GdOps nxt = ldops(seg * 16 + ((i_ + 1) & 15));
      const float al = cur.sc.x, be = cur.sc.y, qk = cur.sc.z, nab = cur.sc.w;
      float d1 = dot8(S, cur.ka, cur.kb);
      float d2 = dot8(S, cur.qa, cur.qb);
      const f32x2 al2 = f32x2{al, al};
      const f32x2 A0 = S[0] * al2, A1 = S[1] * al2, A2 = S[2] * al2, A3 = S[3] * al2;
      const float bv = be * cur.ve;
      d1 = allsum8(d1);
      d2 = allsum8(d2);
      const float vn = __builtin_fmaf(nab, d1, bv);
      const float ov = al * d2 + qk * vn;
      const f32x2 vn2 = f32x2{vn, vn};
      S[0] = __builtin_elementwise_fma(vn2, f32x2{cur.ka.x, cur.ka.y}, A0);
      S[1] = __builtin_elementwise_fma(vn2, f32x2{cur.ka.z, cur.ka.w}, A1);
      S[2] = __builtin_elementwise_fma(vn2, f32x2{cur.kb.x, cur.kb.y}, A2);
      S[3] = __builtin_elementwise_fma(vn2, f32x2{cur.kb.z, cur.kb.w}, A3);
      yacc = (e8 == (i_ & 7)) ? ov : yacc;
      if ((i_ & 7) == 7) s_y[(s - 7 + e8) * 32 + pw * 8 + row8] = yacc;
      cur = nxt;
    }
  };
  __syncthreads();
  constexpr int NC = L_ / 32;
  for (int c = 0; c <= NC; ++c) {
    float* pb = s_buf + (c & 1) * BUFF;
    const float* cb = s_buf + ((c + 1) & 1) * BUFF;
    const bool pact = !cons && c < NC, cact = cons && c >= 1;
    if (pact) {
      float qq[8], kk[8], vv[8];
#pragma unroll
      for (int arr = 0; arr < 3; ++arr) {
        float a[8], u[8], n[8], w0[8], w1[8], w2[8];
        unpack8(q[arr * 3 + 0], a); unpack8(q[arr * 3 + 1], u); unpack8(q[arr * 3 + 2], n);
        const int lc = (arr == 0) ? lq : (arr == 1 ? lk : lv);
        ld8f(cw + lc, w0); ld8f(cw + 1152 + lc, w1); ld8f(cw + 2304 + lc, w2);
        float* o = (arr == 0) ? qq : (arr == 1 ? kk : vv);
#pragma unroll
        for (int e = 0; e < 8; ++e) o[e] = siluf(w0[e] * a[e] + w1[e] * u[e] + w2[e] * n[e]);
      }
      float sq = 0.f, sk = 0.f;
#pragma unroll
      for (int e = 0; e < 8; ++e) { sq += qq[e] * qq[e]; sk += kk[e] * kk[e]; }
      sq = allsum8(sq); sk = allsum8(sk);
      const float iq = rsqrtf(sq + 1e-6f) * 0.125f, ik = rsqrtf(sk + 1e-6f);
      float qk = 0.f;
#pragma unroll
      for (int e = 0; e < 8; ++e) { qq[e] *= iq; kk[e] *= ik; qk += qq[e] * kk[e]; }
      qk = allsum8(qk);
      st8f(pb + tl * 64 + jg * 8, qq);
      st8f(pb + 2048 + tl * 64 + jg * 8, kk);
      st8f(pb + 4096 + tl * 64 + jg * 8, vv);
      if (jg == 0) {
        float x = bf2f(rag) + dtb;
        float sp = (x > 20.f) ? x : log1pf(__expf(x));
        const float al_ = __expf(negA * sp), be_ = sigm(bf2f(rbg));
        *(float4*)(pb + 6144 + tl * 4) = make_float4(al_, be_, qk, -al_ * be_);
      }
    }
    if (cact) scan_seg(cb, 0);
    __syncthreads();
    if (!cons && c + 1 < NC) {
      int tn = (c + 1) * 32 + tl;
      int t = d ? (L_ - 1 - tn) : tn;
#pragma unroll
      for (int dt = 0; dt < 3; ++dt) {
        q[0 + dt] = ldrow8(P, b, t + dt - 1, 2304 + lq);
        q[3 + dt] = ldrow8(P, b, t + dt - 1, 2304 + lk);
        q[6 + dt] = ldrow8(P, b, t + dt - 1, 2304 + lv);
      }
      { const u16* pr_ = P + ((size_t)(b * L_ + t)) * INC; rag = pr_[cag]; rbg = pr_[cbg]; }
    }
    if (cact) {
      scan_seg(cb, 1);
      const int t2 = lane >> 1, hf = lane & 1;
      const float4 o4 = *(const float4*)(s_y + t2 * 32 + pw * 8 + hf * 4);
      const int ts = (c - 1) * 32 + t2;
      const int t = d ? (L_ - 1 - ts) : ts;
      uint2 o; o.x = pack2(o4.x, o4.y); o.y = pack2(o4.z, o4.w);
      *(uint2*)(Yd + ((size_t)(b * L_ + t)) * 384 + h * 64 + rg2 * 32 + pw * 8 + hf * 4) = o;
    }
    __syncthreads();
  }
}

#define hy_gdn_post (gridDim.x == 256u)
DEVI void post_gdn_item(KP p, int l, int item) {
  const int tid = otid();
  const int tl = tid >> 3, jg = tid & 7;
  const u16* P = (const u16*)(p->ws + OFF_BIG);
  const u16* YG = (const u16*)(p->ws + OFF_YGD);
  u16* Yo = (u16*)(p->ws + OFF_HN);
  const int tok = item * 64 + tl;
  const int b = tok / L_, t = tok % L_;
#pragma unroll 2
  for (int h = 0; h < 6; ++h) {
    const int hc = h * 64 + jg * 8;
    {
      float o[8], nw[8], zg[8], ob8[8];
      unpack8(*(const uint4*)(YG + (size_t)tok * 384 + hc), o);
      unpack8(*(const uint4*)(YG + (size_t)(T_ + tok) * 384 + hc), ob8);
#pragma unroll
      for (int e = 0; e < 8; ++e) o[e] += ob8[e];
      float ms = 0.f;
#pragma unroll
      for (int e = 0; e < 8; ++e) ms += o[e] * o[e];
      const float rs = rsqrtf(allsum8(ms) * (1.f / 64.f) + 1e-6f);
      ld8f(p->in[I_GNORM] + l * 64 + jg * 8, nw);
      unpack8(ldrow8(P, b, t, 3456 + hc), zg);
#pragma unroll
      for (int e = 0; e < 8; ++e) o[e] = o[e] * rs * nw[e] * siluf(zg[e]);
      *(uint4*)(Yo + (size_t)tok * DM + 640 + hc) = pack8(o);
    }
  }
}

DEVI void post_tok_item(KP p, int l, int item, char* smem) {
  const int tid = otid();
  const int tl = tid >> 3, jg = tid & 7;
  u16* s_sg = (u16*)smem;
  float* s_gate = (float*)(smem + 64 * 136 * 2);
  const u16* P = (const u16*)(p->ws + OFF_BIG);
  const u16* YR = (const u16*)(p->ws + OFF_YRW);
  const u16* YG = (const u16*)(p->ws + OFF_YGD);
  u16* Yo = (u16*)(p->ws + OFF_HN);
  const float* mup = p->in[I_MUP] + l * 1536;
  const float* mun = p->in[I_MUN] + l * 1536;
  const int tok = item * 64 + tl;
  const int b = tok / L_, t = tok % L_;
#pragma unroll
  for (int half = 0; half < 2; ++half) {
    const int col = 2176 + jg * 16 + half * 8;
    float lg[8];
    shift8(ldrow8(P, b, t - 1, col), ldrow8(P, b, t, col), ldrow8(P, b, t + 1, col), mup + (col - 768),
           mun + (col - 768), lg);
#pragma unroll
    for (int e = 0; e < 8; ++e) lg[e] = sigm(lg[e]);
    *(uint4*)(s_sg + tl * 136 + jg * 16 + half * 8) = pack8(lg);
  }
  __syncthreads();
  {
    const int lane = tid & 63, wv = tid >> 6, fr = lane & 15, fq = lane >> 4;
    const u16* GT = (const u16*)(p->ws + OFF_WKV);
    f32x4 acc[4][3];
#pragma unroll
    for (int m = 0; m < 4; ++m)
#pragma unroll
      for (int n = 0; n < 3; ++n) acc[m][n] = f32x4{0.f, 0.f, 0.f, 0.f};
#pragma unroll
    for (int ks = 0; ks < 4; ++ks) {
      bf16x8 af[4], bfr[3];
#pragma unroll
      for (int m = 0; m < 4; ++m) af[m] = *(const bf16x8*)(s_sg + (m * 16 + fr) * 136 + ks * 32 + fq * 8);
#pragma unroll
      for (int n = 0; n < 3; ++n) bfr[n] = *(const bf16x8*)(GT + ((wv * 3 + n) * 16 + fr) * 128 + ks * 32 + fq * 8);
#pragma unroll
      for (int m = 0; m < 4; ++m)
#pragma unroll
        for (int n = 0; n < 3; ++n) acc[m][n] = __builtin_amdgcn_mfma_f32_16x16x32_bf16(af[m], bfr[n], acc[m][n], 0, 0, 0);
    }
#pragma unroll
    for (int m = 0; m < 4; ++m)
#pragma unroll
      for (int n = 0; n < 3; ++n)
#pragma unroll
        for (int j = 0; j < 4; ++j) s_gate[(m * 16 + fq * 4 + j) * 388 + (wv * 3 + n) * 16 + fr] = acc[m][n][j];
  }
  __syncthreads();
  for (int h = 0; h < 6; ++h) {
    const int hc = h * 64 + jg * 8;
    {
      float y[8], yb8[8];
      unpack8(*(const uint4*)(YR + (size_t)tok * 384 + hc), y);
      unpack8(*(const uint4*)(YR + (size_t)(T_ + tok) * 384 + hc), yb8);
#pragma unroll
      for (int e = 0; e < 8; ++e) y[e] += yb8[e];
      float s = 0.f;
#pragma unroll
      for (int e = 0; e < 8; ++e) s += y[e];
      const float mu = allsum8(s) * (1.f / 64.f);
      float vs = 0.f;
#pragma unroll
      for (int e = 0; e < 8; ++e) { y[e] -= mu; vs += y[e] * y[e]; }
      const float rstd = rsqrtf(allsum8(vs) * (1.f / 64.f) + 64e-5f);
      float gw[8], gb[8], rk[8], rr[8], kv[8], vv[8];
      ld8f(p->in[I_GNW] + l * 384 + hc, gw);
      ld8f(p->in[I_GNB] + l * 384 + hc, gb);
      ld8f(p->in[I_RK] + l * 384 + hc, rk);
      const int cr = 768 + hc, ck = 1152 + hc, cv = 1536 + hc;
      shift8(ldrow8(P, b, t - 1, cr), ldrow8(P, b, t, cr), ldrow8(P, b, t + 1, cr), mup + hc, mun + hc, rr);
      shift8(ldrow8(P, b, t - 1, ck), ldrow8(P, b, t, ck), ldrow8(P, b, t + 1, ck), mup + 384 + hc, mun + 384 + hc, kv);
      shift8(ldrow8(P, b, t - 1, cv), ldrow8(P, b, t, cv), ldrow8(P, b, t + 1, cv), mup + 768 + hc, mun + 768 + hc, vv);
      float bs = 0.f;
#pragma unroll
      for (int e = 0; e < 8; ++e) bs += rr[e] * kv[e] * rk[e];
      bs = allsum8(bs);
      float gate[8];
      ld8f(s_gate + tl * 388 + hc, gate);
      float o[8];
#pragma unroll
      for (int e = 0; e < 8; ++e) o[e] = (y[e] * rstd * gw[e] + gb[e] + bs * vv[e]) * gate[e];
      *(uint4*)(Yo + (size_t)tok * DM + 256 + hc) = pack8(o);
    }
    if (!hy_gdn_post) {
      float o[8], nw[8], zg[8], ob8[8];
      unpack8(*(const uint4*)(YG + (size_t)tok * 384 + hc), o);
      unpack8(*(const uint4*)(YG + (size_t)(T_ + tok) * 384 + hc), ob8);
#pragma unroll
      for (int e = 0; e < 8; ++e) o[e] += ob8[e];
      float ms = 0.f;
#pragma unroll
      for (int e = 0; e < 8; ++e) ms += o[e] * o[e];
      const float rs = rsqrtf(allsum8(ms) * (1.f / 64.f) + 1e-6f);
      ld8f(p->in[I_GNORM] + l * 64 + jg * 8, nw);
      unpack8(ldrow8(P, b, t, 3456 + hc), zg);
#pragma unroll
      for (int e = 0; e < 8; ++e) o[e] = o[e] * rs * nw[e] * siluf(zg[e]);
      *(uint4*)(Yo + (size_t)tok * DM + 640 + hc) = pack8(o);
    }
  }
  __syncthreads();
}

DEVI void attn_phase(KP p, int l, char* smem, int bid, int nb) {
  u16* sKV = (u16*)smem;
  u16* sP = sKV + 64 * 264;
  const int tid = otid(), lane = tid & 63, wv = tid >> 6, fr = lane & 15, fq = lane >> 4;
  const u16* Q = (const u16*)(p->ws + OFF_BIG);
  const u16* KM = (const u16*)(p->ws + OFF_KM) + (size_t)l * 1024 * 1024;
  const u16* VT = (const u16*)(p->ws + OFF_VT) + (size_t)l * 1024 * 1024;
  u16* O = (u16*)(p->ws + OFF_HN);
  u16* myP = sP + wv * 16 * 264;
  for (int it = bid; it < 1024; it += nb) {
    const int h = it & 3, qt = (it >> 2) & 63, b = it >> 8;
    const int tok0 = b * L_ + qt * 128 + wv * 16;
    uint4 R0, R1, R2, R3;
    const int lrow = tid >> 5, lc = (tid & 31) * 8;
    const u16* kbase = KM + (size_t)(b * 256 + lrow) * DM + h * 256 + lc;
    const u16* vbase = VT + (size_t)(h * 256 + lrow) * 1024 + b * 256 + lc;
#define ATT_LDK(ch_) do { const u16* g_ = kbase + (size_t)(ch_) * 64 * DM; R0 = *(const uint4*)(g_); R1 = *(const uint4*)(g_ + 16 * DM); \
      R2 = *(const uint4*)(g_ + 32 * DM); R3 = *(const uint4*)(g_ + 48 * DM); } while (0)
#define ATT_LDV(dc_) do { const u16* g_ = vbase + (size_t)(dc_) * 64 * 1024; R0 = *(const uint4*)(g_); R1 = *(const uint4*)(g_ + 16 * 1024); \
      R2 = *(const uint4*)(g_ + 32 * 1024); R3 = *(const uint4*)(g_ + 48 * 1024); } while (0)
#define ATT_ST() do { u16* d_ = sKV + lrow * 264 + lc; *(uint4*)(d_) = R0; *(uint4*)(d_ + 16 * 264) = R1; \
      *(uint4*)(d_ + 32 * 264) = R2; *(uint4*)(d_ + 48 * 264) = R3; } while (0)
    ATT_LDK(0);
    bf16x8 qf[8];
#pragma unroll
    for (int ks = 0; ks < 8; ++ks)
      qf[ks] = *(const bf16x8*)(Q + (size_t)(tok0 + fr) * DM + h * 256 + ks * 32 + fq * 8);
    f32x4 sc[16];
#pragma unroll
    for (int i = 0; i < 16; ++i) sc[i] = f32x4{0.f, 0.f, 0.f, 0.f};
#pragma unroll
    for (int ch = 0; ch < 4; ++ch) {
      __syncthreads();
      ATT_ST();
      __syncthreads();
      if (ch < 3) ATT_LDK(ch + 1); else ATT_LDV(0);
#pragma unroll
      for (int nt = 0; nt < 4; ++nt) {
#pragma unroll
        for (int ks = 0; ks < 8; ++ks) {
          bf16x8 kf = *(const bf16x8*)(sKV + (nt * 16 + fr) * 264 + ks * 32 + fq * 8);
          sc[ch * 4 + nt] = __builtin_amdgcn_mfma_f32_16x16x32_bf16(qf[ks], kf, sc[ch * 4 + nt], 0, 0, 0);
        }
      }
    }
#pragma unroll
    for (int j = 0; j < 4; ++j) {
      float mx = -1e30f;
#pragma unroll
      for (int i = 0; i < 16; ++i) mx = fmaxf(mx, sc[i][j]);
#pragma unroll
      for (int o = 1; o < 16; o <<= 1) mx = fmaxf(mx, __shfl_xor(mx, o, 64));
      float sum = 0.f;
#pragma unroll
      for (int i = 0; i < 16; ++i) {
        float e = __expf((sc[i][j] - mx) * 0.0625f);
        sc[i][j] = e;
        sum += e;
      }
      sum = allsum16(sum);
      const float inv = frcp(sum);
#pragma unroll
      for (int i = 0; i < 16; ++i) myP[(fq * 4 + j) * 264 + i * 16 + fr] = f2bf(sc[i][j] * inv);
    }
#pragma unroll
    for (int dc = 0; dc < 4; ++dc) {
      __syncthreads();
      ATT_ST();
      __syncthreads();
      if (dc < 3) ATT_LDV(dc + 1);
      f32x4 oa[4];
#pragma unroll
      for (int nt = 0; nt < 4; ++nt) oa[nt] = f32x4{0.f, 0.f, 0.f, 0.f};
#pragma unroll
      for (int ks = 0; ks < 8; ++ks) {
        bf16x8 pf = *(const bf16x8*)(myP + fr * 264 + ks * 32 + fq * 8);
#pragma unroll
        for (int nt = 0; nt < 4; ++nt) {
          bf16x8 vf = *(const bf16x8*)(sKV + (nt * 16 + fr) * 264 + ks * 32 + fq * 8);
          oa[nt] = __builtin_amdgcn_mfma_f32_16x16x32_bf16(pf, vf, oa[nt], 0, 0, 0);
        }
      }
#pragma unroll
      for (int nt = 0; nt < 4; ++nt)
#pragma unroll
        for (int j = 0; j < 4; ++j)
          O[(size_t)(tok0 + fq * 4 + j) * DM + h * 256 + dc * 64 + nt * 16 + fr] = f2bf(oa[nt][j]);
    }
    __syncthreads();
#undef ATT_LDK
#undef ATT_LDV
#undef ATT_ST
  }
}


#define XB_TMO      128
#define XB_XCNT(j)  (256  + 64 * (j))
#define XB_XSUB(j)  (1280 + 64 * (j))
#define XB_XGEN(j)  (2304 + 64 * (j))
#define XB_TOP      3328
#define XB_TOPGEN   3392
#define XCD_BAR_WORDS 3456
#define XB_SPIN_CAP (1u << 24)
#define LAS __attribute__((address_space(3)))
DEVI unsigned xb_ld(unsigned* p) { return __hip_atomic_load(p, __ATOMIC_RELAXED, __HIP_MEMORY_SCOPE_AGENT); }
DEVI unsigned xb_add(unsigned* p, unsigned v) { return __hip_atomic_fetch_add(p, v, __ATOMIC_RELAXED, __HIP_MEMORY_SCOPE_AGENT); }
DEVI unsigned xb_xcc_id() { return (unsigned)__builtin_amdgcn_s_getreg((3 << 11) | 20) & 0xFu; }
#define XB_SPIN(cond, bar) do { unsigned _sp = 0; while (cond) { __builtin_amdgcn_s_sleep(1); \
    if ((++_sp & 255u) == 0u) { if (xb_ld(&(bar)[XB_TMO])) break; if (_sp > XB_SPIN_CAP) { atomicAdd(&(bar)[XB_TMO], 1u); break; } } } } while (0)
struct XcdBarrier { unsigned* bar; unsigned x; volatile LAS unsigned* st; };
DEVI XcdBarrier xcd_barrier_post(unsigned* bar, volatile LAS unsigned* st) {
  XcdBarrier b; b.bar = bar; b.x = xb_xcc_id(); b.st = st;
  if (threadIdx.x == 0) (void)xb_add(&bar[XB_XCNT(b.x)], 1u);
  return b;
}
DEVI void xcd_barrier_complete(unsigned* bar, unsigned x, unsigned& nloc, unsigned& nx) {
  const unsigned G = gridDim.x * gridDim.y * gridDim.z;
  unsigned sum, cnt, mine, sp = 0u;
  for (;;) {
    sum = 0u; cnt = 0u; mine = 0u;
#pragma unroll
    for (unsigned j = 0; j < 16; ++j) { const unsigned c = xb_ld(&bar[XB_XCNT(j)]); sum += c; cnt += (c > 0u) ? 1u : 0u; mine = (j == x) ? c : mine; }
    if (sum == G) break;
    __builtin_amdgcn_s_sleep(1);
    if ((++sp & 255u) == 0u) { if (xb_ld(&bar[XB_TMO])) break; if (sp > XB_SPIN_CAP) { atomicAdd(&bar[XB_TMO], 1u); break; } }
  }
  nloc = mine > 0u ? mine : 1u; nx = cnt > 0u ? cnt : 1u;
}
DEVI void xcd_barrier(const XcdBarrier& b) {
  asm volatile("s_waitcnt vmcnt(0)" ::: "memory");
  __syncthreads();
  if (threadIdx.x == 0) {
    unsigned* bar = b.bar;
    __builtin_amdgcn_s_waitcnt(0);
    unsigned nloc = b.st[0], nx = b.st[1];
    if (nloc == 0u) { xcd_barrier_complete(bar, b.x, nloc, nx); b.st[0] = nloc; b.st[1] = nx; }
    const unsigned old = xb_add(&bar[XB_XSUB(b.x)], 1u);
    const unsigned gen = old / nloc;
    if (old + 1u == (gen + 1u) * nloc) {
      __builtin_amdgcn_fence(__ATOMIC_RELEASE, "agent");
      asm volatile("s_waitcnt vmcnt(0)" ::: "memory");
      const unsigned og = xb_add(&bar[XB_TOP], 1u);
      const unsigned tg = og / nx;
      if (og + 1u == (tg + 1u) * nx) xb_add(&bar[XB_TOPGEN], 1u);
      else XB_SPIN(xb_ld(&bar[XB_TOPGEN]) == tg, bar);
      __builtin_amdgcn_fence(__ATOMIC_ACQUIRE, "agent");
      xb_add(&bar[XB_XGEN(b.x)], 1u);
      asm volatile("s_waitcnt vmcnt(0)" ::: "memory");
    } else {
      XB_SPIN(xb_ld(&bar[XB_XGEN(b.x)]) == gen, bar);
      __builtin_amdgcn_fence(__ATOMIC_ACQUIRE, "agent");
      asm volatile("s_waitcnt vmcnt(0)" ::: "memory");
    }
  }
  __syncthreads();
}

DEVI void sub_barrier(unsigned* word, unsigned expected) {
  asm volatile("s_waitcnt vmcnt(0)" ::: "memory");
  __syncthreads();
  if (threadIdx.x == 0) {
    __builtin_amdgcn_fence(__ATOMIC_RELEASE, "agent");
    asm volatile("s_waitcnt vmcnt(0)" ::: "memory");
    xb_add(word, 1u);
    unsigned sp = 0;
    while (xb_ld(word) < expected) { __builtin_amdgcn_s_sleep(1); if (++sp > XB_SPIN_CAP) break; }
    __builtin_amdgcn_fence(__ATOMIC_ACQUIRE, "agent");
    asm volatile("s_waitcnt vmcnt(0)" ::: "memory");
  }
  __syncthreads();
}

#ifndef PROBE_RW
#define PROBE_RW 0
#endif
#ifndef PROBE_GD
#define PROBE_GD 0
#endif
#ifndef PROBE_HY
#define PROBE_HY 0
#endif
#ifndef REP_HYPREP
#define REP_HYPREP 1
#endif
#ifndef REP_POST
#define REP_POST 1
#endif
#ifndef REP_ATT
#define REP_ATT 1
#endif
#ifndef REP_NORM
#define REP_NORM 1
#endif
#ifndef REP_P0
#define REP_P0 1
#endif
#ifndef REP_SYNC
#define REP_SYNC 0
#endif
#ifndef REP_MIX
#define REP_MIX 1
#endif
#ifndef REP_G1
#define REP_G1 1
#endif
#ifndef EN_HY
#define EN_HY 1
#endif
#ifndef EN_RW
#define EN_RW 1
#endif
#ifndef EN_GD
#define EN_GD 1
#endif
#ifndef EN_XA
#define EN_XA 1
#endif

__global__ void __launch_bounds__(NTHR, 2) fwd_megakernel(Params p_unused) {
  __shared__ __attribute__((aligned(16))) char smem[SMEM_BYTES];
  const KP kp0 = (KP)__builtin_amdgcn_kernarg_segment_ptr();
#define p (opqk(kp0))
  cg::grid_group grid = cg::this_grid();
  __shared__ uint4 xb_words;
  if (threadIdx.x == 0) xb_words = make_uint4(0u, 0u, 0u, 0u);
  __syncthreads();
  const XcdBarrier xb = xcd_barrier_post((unsigned*)(kp0->ws + OFF_BAR), (volatile LAS unsigned*)&xb_words);
  const int bid = blockIdx.x, nb = gridDim.x;
#define ws (p->ws)
#define WA ((u16*)(ws + OFF_WA))
#define WB ((u16*)(ws + OFF_WB))
#define WKV ((u16*)(ws + OFF_WKV))
#define MEMN ((u16*)(ws + OFF_MEMN))
#define HN ((u16*)(ws + OFF_HN))
#define BIG ((u16*)(ws + OFF_BIG))
#define X (p->out)

  if (gridDim.x == 0x7fffffffu) grid.sync();
  for (int rs_ = 0; rs_ < REP_SYNC; ++rs_) xcd_barrier(xb);

  for (int l = 0; l < 2; ++l) {
    int bid_l = blockIdx.x; asm volatile("" : "+s"(bid_l));
    const float* xin = (l == 0) ? p->in[I_X] : X;
    rmsnorm_phase<false>(xin, p->in[I_NFFN1] + l * DM, HN, T_, bid_l, nb);
    convert_phase(p->in[I_F1W1] + (size_t)l * DM * DFF, p->in[I_F1W3] + (size_t)l * DM * DFF, DM, 2 * DFF, 2 * DFF, WA, smem, bid_l, nb);
    convert_phase(p->in[I_F1W2] + (size_t)l * DFF * DM, nullptr, DFF, DM, DM, WB, smem, bid_l, nb);
    xcd_barrier(xb);
    for (int rep_ = 0; rep_ < REP_G1; ++rep_) {
      run_gemm(smem, HN, WA, T_, 2 * DFF, DM, pg8::EpiSwiglu{BIG, DFF}, bid_l, 0, nb);
      xcd_barrier(xb);
    }
    run_gemm(smem, BIG, WB, T_, DM, DFF, pg8::EpiResid{X, xin, 0.5f}, bid_l, 0, nb);
    xcd_barrier(xb);
    rmsnorm_phase<false>(X, p->in[I_NMIX] + l * DM, HN, T_, bid_l, nb);
    convert_phase(p->in[I_WIN] + (size_t)l * DM * INC, nullptr, DM, INC, INCP, WA, smem, bid_l, nb);
    convert_phase(p->in[I_WOUT] + (size_t)l * DM * DM, nullptr, DM, DM, DM, WB, smem, bid_l, nb);
    convert_phase(p->in[I_GLORA] + (size_t)l * 128 * 384, nullptr, 128, 384, 384, WKV, smem, (bid_l + 128) % nb, nb);
    xcd_barrier(xb);
    run_gemm(smem, HN, WA, T_, INCP, DM, pg8::EpiBf16{BIG, INC, INC}, bid_l, 0, nb);
    xcd_barrier(xb);
#define hy_own_prep (gridDim.x == 256u)
    if (!hy_own_prep) {
      hyprep_phase(p, l, smem, bid_l, nb);
      xcd_barrier(xb);
    }
    for (int rep_ = 0; rep_ < REP_MIX; ++rep_) {
      if (rep_ > 0) xcd_barrier(xb);
      const int t5 = otid();
      const int half = t5 >> 8, tl5 = t5 & 255;
      char* hsm = smem + half * SCAN_SMEM;
      int rb_ = bid_l; asm volatile("" : "+s"(rb_));
      for (int r = rb_; r < 256; r += nb) {
        if (r < 192) {
          const int q_ = (r < 96) ? r : r - 96;
          const int it_ = (((q_ >> 4) * 8 + (q_ & 7)) << 1) | ((q_ >> 3) & 1);
          if (r < 96) rwscan_pc_item(p, l, it_, smem);
          else {
            gdscan_pc_item(p, l, it_, smem);
            if (hy_own_prep) {
              const int gb = r - 96;
              u16* wk_t = (u16*)(ws + OFF_WKV + (2u << 20));
              u16* wv_t = (u16*)(ws + OFF_WKV + (4u << 20));
              __syncthreads();
              convert_phase(p->in[I_WK] + (size_t)l * DM * DM, nullptr, DM, DM, DM, wk_t, smem, gb, 96);
              convert_phase(p->in[I_WV] + (size_t)l * DM * DM, nullptr, DM, DM, DM, wv_t, smem, gb, 96);
              if (l == 0) rmsnorm_phase<false>(p->in[I_MEM], p->in[I_MEMNORM], MEMN, 1024, gb, 96);
              sub_barrier((unsigned*)(ws + OFF_BAR) + 3776 + 64 * l, 96u);
              run_gemm(smem, MEMN, wk_t, 1024, 1024, DM, pg8::EpiBf16{(u16*)(ws + OFF_KM) + (size_t)l * DM * DM, DM, DM}, gb, 0, 16);
              run_gemm(smem, wv_t, MEMN, 1024, 1024, DM, pg8::EpiBf16{(u16*)(ws + OFF_VT) + (size_t)l * DM * DM, DM, DM}, gb, 16, 16);
#pragma unroll 1
              for (int it = gb; it < 512; it += 96) post_gdn_item(p, l, it);
            }
          }
        }
        else if (EN_HY) {
          if (hy_own_prep) {
            hyfilter_phase(p, smem, r - 192, 64, l, OFF_YC);
            sub_barrier((unsigned*)(ws + OFF_BAR) + 3648 + 64 * l, 64u);
            hynorm_phase(p, smem, r - 192, 64, l, OFF_YC);
            hyprep_phase(p, l, smem, r - 192, 64);
            sub_barrier((unsigned*)(ws + OFF_BAR) + 3520 + 64 * l, 64u);
          }
          for (int c = r - 192; c < 256; c += 64) hyconv_item(p, l, c, smem);
        }
      }
    }
    xcd_barrier(xb);
    for (int rep_ = 0; rep_ < REP_POST; ++rep_) {
      for (int it = bid_l; it < 512; it += nb) post_tok_item(p, l, it, smem);
      xcd_barrier(xb);
    }
    run_gemm(smem, HN, WB, T_, DM, DM, pg8::EpiResid{X, X, 1.0f}, bid_l, 0, nb);
    xcd_barrier(xb);
    for (int rep_ = 0; rep_ < REP_NORM; ++rep_)
    rmsnorm_phase<false>(X, p->in[I_NXA] + l * DM, HN, T_, bid_l, nb);
    convert_phase(p->in[I_WQ] + (size_t)l * DM * DM, nullptr, DM, DM, DM, WA, smem, bid_l, nb);
    convert_phase(p->in[I_WO] + (size_t)l * DM * DM, nullptr, DM, DM, DM, WB, smem, bid_l, nb);
    xcd_barrier(xb);
#if EN_XA
    run_gemm(smem, HN, WA, T_, DM, DM, pg8::EpiBf16{BIG, DM, DM}, bid_l, 0, nb);
    xcd_barrier(xb);
    for (int rep_ = 0; rep_ < REP_ATT; ++rep_) {
      attn_phase(p, l, smem, bid_l, nb);
      xcd_barrier(xb);
    }
    run_gemm(smem, HN, WB, T_, DM, DM, pg8::EpiResid{X, X, 1.0f}, bid_l, 0, nb);
    xcd_barrier(xb);
#endif
    rmsnorm_phase<false>(X, p->in[I_NFFN2] + l * DM, HN, T_, bid_l, nb);
    convert_phase(p->in[I_F2W1] + (size_t)l * DM * DFF, p->in[I_F2W3] + (size_t)l * DM * DFF, DM, 2 * DFF, 2 * DFF, WA, smem, bid_l, nb);
    convert_phase(p->in[I_F2W2] + (size_t)l * DFF * DM, nullptr, DFF, DM, DM, WB, smem, bid_l, nb);
    xcd_barrier(xb);
    for (int rep_ = 0; rep_ < REP_G1; ++rep_) {
      run_gemm(smem, HN, WA, T_, 2 * DFF, DM, pg8::EpiSwiglu{BIG, DFF}, bid_l, 0, nb);
      xcd_barrier(xb);
    }
    run_gemm(smem, BIG, WB, T_, DM, DFF, pg8::EpiResid{X, X, 0.5f}, bid_l, 0, nb);
    xcd_barrier(xb);
  }
  rmsnorm_phase<true>(X, p->in[I_NFINAL], X, T_, bid, nb);
#undef p
#undef ws
#undef WA
#undef WB
#undef WKV
#undef MEMN
#undef HN
#undef BIG
#undef X
}

extern "C" void kernel_launch(void* const* d_in, const int* in_sizes, int n_in, void* d_out, int out_size, void* d_ws,
                              size_t ws_size, hipStream_t stream) {
  static int grid_blocks = 0;
  if (!grid_blocks) {
    int dev = 0, cus = 0, per_cu = 0;
    (void)hipGetDevice(&dev);
    (void)hipDeviceGetAttribute(&cus, hipDeviceAttributeMultiprocessorCount, dev);
    (void)hipOccupancyMaxActiveBlocksPerMultiprocessor(&per_cu, fwd_megakernel, NTHR, 0);
    if (per_cu != 1) per_cu = 1;
    grid_blocks = cus * per_cu;
  }
  Params p{};
  for (int i = 0; i < 46; ++i) p.in[i] = (const float*)d_in[i];
  p.out = (float*)d_out;
  p.ws = (char*)d_ws;
  (void)hipMemsetAsync((char*)d_ws + OFF_BAR, 0, 16384, stream);
  void* args[] = {&p};
  hipError_t e = hipLaunchCooperativeKernel((void*)fwd_megakernel, dim3(grid_blocks), dim3(NTHR), args, 0, stream);
  if (e != hipSuccess) fprintf(stderr, "cooperative launch failed: %s (grid %d)\n", hipGetErrorString(e), grid_blocks);
}
```
